# Optimizing an MI355X kernel written in HIP

```python
import math
import jax, jax.numpy as jnp
from jax import lax
import numpy as np

D_MODEL = 1024
BATCH = 8
SEQ = 2048
DEPTH = 4
DEC_BATCH = 128
DEC_SEQ = 1
PAST_LEN = 16384
PAGE_SIZE = 128

CONV_WIDTH = D_MODEL // 2
CONV_HEADS = 8
CONV_K = 3
SSM_WIDTH = D_MODEL // 2
SSM_GROUP = 16
SSM_GROUPS = SSM_WIDTH // SSM_GROUP
SSM_STATE = 64
_FF_RAW = (8 * D_MODEL + 2) // 3
D_FF = ((_FF_RAW + 255) // 256) * 256
N_IN = 3 * CONV_WIDTH + SSM_WIDTH + 2 * D_MODEL
RMS_EPS = 1e-6
DT_MIN = 1e-3
DT_MAX = 1e-1

kernel_name = "gated_conv_s5_hybrid_step"


def _rmsnorm(x, g):
    xf = x.astype(jnp.float32)
    y = xf * lax.rsqrt(jnp.mean(xf * xf, axis=-1, keepdims=True) + RMS_EPS)
    return (y * g.astype(jnp.float32)).astype(x.dtype)


def _conv_causal(cin, buf, w, b):
    if buf is None:
        pad = jnp.pad(cin, ((0, 0), (CONV_K - 1, 0), (0, 0)))
    else:
        pad = jnp.concatenate([buf.astype(cin.dtype), cin], axis=1)
    L = cin.shape[1]
    out = b
    for k in range(CONV_K):
        out = out + w[k] * pad[:, k:k + L]
    return out, pad[:, pad.shape[1] - (CONV_K - 1):]


def _cmul(ar, ai, br, bi):
    return ar * br - ai * bi, ar * bi + ai * br


def _ssm_combine(e1, e2):
    a1r, a1i, b1r, b1i = e1
    a2r, a2i, b2r, b2i = e2
    ar, ai = _cmul(a2r, a2i, a1r, a1i)
    br, bi = _cmul(a2r, a2i, b1r, b1i)
    return ar, ai, br + b2r, bi + b2i


def _s5(u, h0_re, h0_im, lam_re, lam_im, log_dt, b_re, b_im, c_re, c_im, d_skip):
    N, L, _ = u.shape
    f32 = jnp.float32
    uf = u.astype(f32).reshape(N, L, SSM_GROUPS, SSM_GROUP)
    dt = jnp.exp(log_dt.astype(f32))[:, None]
    lr = lam_re.astype(f32)
    li = lam_im.astype(f32)
    mag = jnp.exp(lr * dt)
    ang = li * dt
    abar_r = mag * jnp.cos(ang)
    abar_i = mag * jnp.sin(ang)
    nr = abar_r - 1.0
    ni = abar_i
    den = lr * lr + li * li
    fr = ((nr * lr + ni * li) / den)[..., None]
    fi = ((ni * lr - nr * li) / den)[..., None]
    br = b_re.astype(f32)
    bi = b_im.astype(f32)
    bbar_r = fr * br - fi * bi
    bbar_i = fr * bi + fi * br
    bu_r = jnp.einsum('blgc,gpc->blgp', uf, bbar_r)
    bu_i = jnp.einsum('blgc,gpc->blgp', uf, bbar_i)
    a_r = jnp.broadcast_to(abar_r, bu_r.shape)
    a_i = jnp.broadcast_to(abar_i, bu_i.shape)
    A_r, A_i, h_r, h_i = lax.associative_scan(_ssm_combine, (a_r, a_i, bu_r, bu_i), axis=1)
    if h0_re is not None:
        pr, pi = _cmul(A_r, A_i, h0_re.astype(f32)[:, None], h0_im.astype(f32)[:, None])
        h_r = h_r + pr
        h_i = h_i + pi
    y = (jnp.einsum('blgp,gcp->blgc', h_r, c_re.astype(f32))
         - jnp.einsum('blgp,gcp->blgc', h_i, c_im.astype(f32)))
    y = y + d_skip.astype(f32).reshape(SSM_GROUPS, SSM_GROUP) * uf
    return (y.reshape(N, L, SSM_WIDTH).astype(u.dtype),
            h_r[:, L - 1].astype(u.dtype), h_i[:, L - 1].astype(u.dtype))


def _layer(x, conv_buf, h0_re, h0_im, norm1_g, w_in, conv_w, conv_b, lam_re, lam_im, log_dt,
           b_re, b_im, c_re, c_im, d_skip, w_glu, b_glu, w_branch, w_out, norm2_g, w_gate_up, w_down):
    h = _rmsnorm(x, norm1_g)
    z = h @ w_in
    cuts = [CONV_WIDTH, 2 * CONV_WIDTH, 3 * CONV_WIDTH, 3 * CONV_WIDTH + SSM_WIDTH,
            3 * CONV_WIDTH + SSM_WIDTH + D_MODEL]
    zb, zc, zv, zu, ga, gs = jnp.split(z, cuts, axis=-1)
    conv_out, new_buf = _conv_causal(zc * zv, conv_buf, conv_w, conv_b)
    ya = zb * conv_out
    ys, hr, hi = _s5(zu, h0_re, h0_im, lam_re, lam_im, log_dt, b_re, b_im, c_re, c_im, d_skip)
    gy = jax.nn.gelu(ys, approximate=False)
    ys = gy * jax.nn.sigmoid(gy @ w_glu + b_glu)
    oa = ya @ w_branch[:CONV_WIDTH]
    ob = ys @ w_branch[CONV_WIDTH:]
    m = jax.nn.sigmoid(ga) * oa + jax.nn.sigmoid(gs) * ob
    x = x + m @ w_out
    h2 = _rmsnorm(x, norm2_g)
    gate, up = jnp.split(h2 @ w_gate_up, [D_FF], axis=-1)
    x = x + (jax.nn.silu(gate) * up) @ w_down
    return x, new_buf, hr, hi


def _trunk(x, st_conv, st_re, st_im, norm1_g, w_in, conv_w, conv_b, ssm_lam_re, ssm_lam_im,
           ssm_log_dt, ssm_b_re, ssm_b_im, ssm_c_re, ssm_c_im, ssm_d, w_glu, b_glu, w_branch,
           w_out, norm2_g, w_gate_up, w_down, final_g):
    bufs, res, ims = [], [], []
    for l in range(DEPTH):
        cb = None if st_conv is None else st_conv[l]
        hr0 = None if st_re is None else st_re[l]
        hi0 = None if st_im is None else st_im[l]
        x, nb, nr, ni = _layer(x, cb, hr0, hi0, norm1_g[l], w_in[l], conv_w[l], conv_b[l],
                               ssm_lam_re[l], ssm_lam_im[l], ssm_log_dt[l], ssm_b_re[l], ssm_b_im[l],
                               ssm_c_re[l], ssm_c_im[l], ssm_d[l], w_glu[l], b_glu[l], w_branch[l],
                               w_out[l], norm2_g[l], w_gate_up[l], w_down[l])
        bufs.append(nb)
        res.append(nr)
        ims.append(ni)
    return _rmsnorm(x, final_g), jnp.stack(bufs), jnp.stack(res), jnp.stack(ims)


def setup_inputs(seed: int = 0) -> dict:
    key = jax.random.key(seed)
    ks = jax.random.split(key, 32)
    f32 = jnp.float32
    nrm = lambda k, s, sc: jax.random.normal(k, s, f32) * sc
    lam_im_base = jnp.pi * jnp.arange(SSM_STATE, dtype=f32)
    return {
        "x_prompt": nrm(ks[0], (BATCH, SEQ, D_MODEL), 1.0),
        "x_sample": nrm(ks[1], (DEC_BATCH, DEC_SEQ, D_MODEL), 1.0),
        "state_conv": nrm(ks[2], (DEPTH, DEC_BATCH, CONV_K - 1, CONV_WIDTH), 1.0),
        "state_ssm_re": nrm(ks[3], (DEPTH, DEC_BATCH, SSM_GROUPS, SSM_STATE), 0.5),
        "state_ssm_im": nrm(ks[4], (DEPTH, DEC_BATCH, SSM_GROUPS, SSM_STATE), 0.5),
        "norm1_g": 1.0 + nrm(ks[5], (DEPTH, D_MODEL), 0.02),
        "w_in": nrm(ks[6], (DEPTH, D_MODEL, N_IN), D_MODEL ** -0.5),
        "conv_w": nrm(ks[7], (DEPTH, CONV_K, CONV_WIDTH), CONV_K ** -0.5),
        "conv_b": nrm(ks[8], (DEPTH, CONV_WIDTH), 0.01),
        "ssm_lam_re": -0.5 + nrm(ks[9], (DEPTH, SSM_GROUPS, SSM_STATE), 0.01),
        "ssm_lam_im": lam_im_base + nrm(ks[10], (DEPTH, SSM_GROUPS, SSM_STATE), 0.01),
        "ssm_log_dt": jax.random.uniform(ks[11], (DEPTH, SSM_GROUPS), f32,
                                         math.log(DT_MIN), math.log(DT_MAX)),
        "ssm_b_re": nrm(ks[12], (DEPTH, SSM_GROUPS, SSM_STATE, SSM_GROUP), (2 * SSM_GROUP) ** -0.5),
        "ssm_b_im": nrm(ks[13], (DEPTH, SSM_GROUPS, SSM_STATE, SSM_GROUP), (2 * SSM_GROUP) ** -0.5),
        "ssm_c_re": nrm(ks[14], (DEPTH, SSM_GROUPS, SSM_GROUP, SSM_STATE), SSM_STATE ** -0.5),
        "ssm_c_im": nrm(ks[15], (DEPTH, SSM_GROUPS, SSM_GROUP, SSM_STATE), SSM_STATE ** -0.5),
        "ssm_d": nrm(ks[16], (DEPTH, SSM_WIDTH), 1.0),
        "w_glu": nrm(ks[17], (DEPTH, SSM_WIDTH, SSM_WIDTH), SSM_WIDTH ** -0.5),
        "b_glu": nrm(ks[18], (DEPTH, SSM_WIDTH), 0.01),
        "w_branch": nrm(ks[19], (DEPTH, CONV_WIDTH + SSM_WIDTH, D_MODEL), (D_MODEL // 2) ** -0.5),
        "w_out": nrm(ks[20], (DEPTH, D_MODEL, D_MODEL), (2 * DEPTH * D_MODEL) ** -0.5),
        "norm2_g": 1.0 + nrm(ks[21], (DEPTH, D_MODEL), 0.02),
        "w_gate_up": nrm(ks[22], (DEPTH, D_MODEL, 2 * D_FF), D_MODEL ** -0.5),
        "w_down": nrm(ks[23], (DEPTH, D_FF, D_MODEL), (2 * DEPTH * D_FF) ** -0.5),
        "final_g": 1.0 + nrm(ks[24], (D_MODEL,), 0.02),
    }


def reference(x_prompt, x_sample, state_conv, state_ssm_re, state_ssm_im, norm1_g, w_in, conv_w,
              conv_b, ssm_lam_re, ssm_lam_im, ssm_log_dt, ssm_b_re, ssm_b_im, ssm_c_re, ssm_c_im,
              ssm_d, w_glu, b_glu, w_branch, w_out, norm2_g, w_gate_up, w_down, final_g):
    y_prompt, prompt_conv, prompt_ssm_re, prompt_ssm_im = _trunk(
        x_prompt, None, None, None, norm1_g, w_in, conv_w, conv_b, ssm_lam_re, ssm_lam_im,
        ssm_log_dt, ssm_b_re, ssm_b_im, ssm_c_re, ssm_c_im, ssm_d, w_glu, b_glu, w_branch,
        w_out, norm2_g, w_gate_up, w_down, final_g)
    y_sample, sample_conv, sample_ssm_re, sample_ssm_im = _trunk(
        x_sample, state_conv, state_ssm_re, state_ssm_im, norm1_g, w_in, conv_w, conv_b,
        ssm_lam_re, ssm_lam_im, ssm_log_dt, ssm_b_re, ssm_b_im, ssm_c_re, ssm_c_im, ssm_d,
        w_glu, b_glu, w_branch, w_out, norm2_g, w_gate_up, w_down, final_g)
    return (y_prompt, y_sample, prompt_conv, prompt_ssm_re, prompt_ssm_im,
            sample_conv, sample_ssm_re, sample_ssm_im)
```

```cpp
#include <hip/hip_runtime.h>
#include <hip/hip_cooperative_groups.h>
#include <cstdio>
namespace cg = cooperative_groups;
namespace pg8 {
#define PG8_LAS __attribute__((address_space(3)))
typedef unsigned short bf16_t;
typedef short bf16x8 __attribute__((ext_vector_type(8)));
typedef float f32x4 __attribute__((ext_vector_type(4)));
typedef unsigned u32x4 __attribute__((ext_vector_type(4)));
constexpr int BM = 256, BK = 64, HALF = 128, HTB = HALF * BK * 2  , STAGE_BYTES = 8 * HTB, NXCD = 8, WGM = 8;

__host__ __device__ __forceinline__ int lds_byte(int r, int c) { const int st = (r >> 4) * 2 + (c >> 5), rr = r & 15, cc = c & 31, ob = rr * 64 + cc * 2; return st * 1024 + (ob ^ (((ob >> 9) & 1) << 5)); }
__host__ __device__ __forceinline__ void stage_rc(int b, int& R, int& C) { const int st = b / 1024, sb = b % 1024, swz = sb ^ (((sb >> 9) & 1) << 5); R = (st >> 1) * 16 + swz / 64; C = (st & 1) * 32 + (swz % 64) / 2; }
__host__ __device__ __forceinline__ int perm32(int rho) { const int n = rho >> 4, i = rho & 15; return 8 * (i >> 2) + 4 * n + (i & 3); }

struct Unit { int pm, pn; };
struct Gemm { const bf16_t* A; const bf16_t* Bt; int M, N, K; };

struct StaticOrder {
    int nM, nN, nwg, G, c;
    __host__ __device__ void init(int M, int N, int G_, int c_) { nM = M / BM; nN = N / BM; nwg = nM * nN; G = G_; c = c_; }
    __host__ __device__ bool next(int i, Unit& u) const {
        const long L = (long)i * G + c; if (L >= nwg) return false;
        int wgid = (int)L; { const int q = nwg / NXCD, r = nwg % NXCD, xcd = wgid % NXCD, off = wgid / NXCD; wgid = (xcd < r ? xcd * (q + 1) : r * (q + 1) + (xcd - r) * q) + off; }
        const int nig = WGM * nN, gid = wgid / nig, fm = gid * WGM, gsz = (nM - fm) < WGM ? (nM - fm) : WGM;
        u.pm = fm + ((wgid % nig) % gsz); u.pn = (wgid % nig) / gsz; return true;
    }
    __device__ __forceinline__ void a_ready(const Unit&) const {}
    __device__ __forceinline__ void done(const Unit&) const {}
};
__device__ __forceinline__ unsigned cvt_pk_bf16(float lo, float hi) { unsigned r; asm volatile("v_cvt_pk_bf16_f32 %0, %1, %2" : "=v"(r) : "v"(lo), "v"(hi)); return r; }
typedef float f32x2 __attribute__((ext_vector_type(2)));
__device__ __forceinline__ f32x2 gelu_pk(f32x2 v) {
    const f32x2 av = __builtin_elementwise_abs(v), d = av * 0.2316418882f + 1.0f;
    f32x2 t; t.x = __builtin_amdgcn_rcpf(d.x); t.y = __builtin_amdgcn_rcpf(d.y);
    f32x2 q = t * 0.5307027145f + (-0.7265760135f); q = q * t + 0.7107068705f; q = q * t + (-0.142248368f); q = q * t + 0.127414796f; q = q * t;
    const f32x2 s = (v * v) * (-0.72134752044f);
    f32x2 e; e.x = __builtin_amdgcn_exp2f(s.x); e.y = __builtin_amdgcn_exp2f(s.y);
    const f32x2 m = v * (q * e), r = v - m;
    f32x2 o; o.x = v.x < 0.f ? m.x : r.x; o.y = v.y < 0.f ? m.y : r.y; return o;
}

template <class Epi, class Sched, bool STAMP = false>
__device__ __forceinline__ void gemm_phase(PG8_LAS unsigned char* lds, const Gemm g, const Sched& S, const Epi& E, unsigned long long* stamps) {
    int tid_ = threadIdx.x; asm volatile("" : "+v"(tid_));
    const int tid = tid_, wid = __builtin_amdgcn_readfirstlane(tid >> 6), lane = tid & 63, wr = wid >> 2, wc = wid & 3, fr = lane & 15, fq = lane >> 4;
    const int K = g.K, nt = K / BK;
    int ts_lo = 0, ts_hi = 0, nts = 0; const unsigned long long rt_entry = STAMP ? (unsigned long long)wall_clock64() : 0ull;
#define PG8_STAMP() do { if (STAMP && wid == 0 && nts < 64) { const unsigned long long _c = (unsigned long long)clock64(); \
        ts_lo = (lane == nts) ? (int)(unsigned)_c : ts_lo; ts_hi = (lane == nts) ? (int)(unsigned)(_c >> 32) : ts_hi; ++nts; } } while (0)
    PG8_STAMP();
    unsigned voffA[2], voffB[2];
#pragma unroll
    for (int i = 0; i < 2; ++i) { int R, C; stage_rc(tid * 16 + i * 8192, R, C); const int Rb = Epi::PERM ? ((R & ~31) + perm32(R & 31)) : R;
        voffA[i] = (unsigned)(R * K + C) * 2u; voffB[i] = (unsigned)(Rb * K + C) * 2u; }
    const size_t kstep = (size_t)(BK * 2);
    const size_t hstep = (size_t)HALF * K * 2;
    const size_t tstep = 2 * hstep;
    const unsigned ldsw = (unsigned)wid * 1024u;
    const int aoff = lds_byte(wr * 64 + fr, fq * 8), boff = lds_byte(wc * 32 + fr, fq * 8);
#define PG8_SA(b, h) (((b) * 2 + (h)) * HTB)
#define PG8_SB(b, h) ((4 + (b) * 2 + (h)) * HTB)
#define PG8_STAGE(bufoff, gbase, voff) do { _Pragma("unroll") for (int _i = 0; _i < 2; ++_i) \
        __builtin_amdgcn_global_load_lds((const unsigned*)((const char*)(gbase) + (voff)[_i]), (PG8_LAS unsigned*)(lds + (bufoff) + ldsw + _i * 8192), 16, 0, 0); } while (0)
#define PG8_LDA(dst, b, h) do { _Pragma("unroll") for (int m = 0; m < 4; ++m) _Pragma("unroll") for (int k = 0; k < 2; ++k) dst[m][k] = *(const PG8_LAS bf16x8*)(lds + PG8_SA(b, h) + aoff + m * 2048 + k * 1024); } while (0)
#define PG8_LDB(dst, b, h) do { _Pragma("unroll") for (int n = 0; n < 2; ++n) _Pragma("unroll") for (int k = 0; k < 2; ++k) dst[n][k] = *(const PG8_LAS bf16x8*)(lds + PG8_SB(b, h) + boff + n * 2048 + k * 1024); } while (0)
#define PG8_MMA(ai, bj, At, Bt) do { __builtin_amdgcn_s_setprio(1); _Pragma("unroll") for (int m = 0; m < 4; ++m) _Pragma("unroll") for (int n = 0; n < 2; ++n) _Pragma("unroll") for (int k = 0; k < 2; ++k) \
        acc[ai][bj][m][n] = __builtin_amdgcn_mfma_f32_16x16x32_bf16(Bt[n][k], At[m][k], acc[ai][bj][m][n], 0, 0, 0); __builtin_amdgcn_s_setprio(0); } while (0)
#define PG8_WAIT_V(n) asm volatile("s_waitcnt vmcnt(" #n ")" ::: "memory")
#define PG8_WAIT_L(n) asm volatile("s_waitcnt lgkmcnt(" #n ")" ::: "memory")
#define PG8_BAR __builtin_amdgcn_s_barrier()
#define PG8_SCHED __builtin_amdgcn_sched_barrier(0)
    Unit cur, nxt; int ui = 0;
    if (!S.next(0, cur)) return;
    f32x4 acc[2][2][4][2];
#pragma unroll
    for (int a = 0; a < 2; ++a)
#pragma unroll
        for (int b = 0; b < 2; ++b)
#pragma unroll
            for (int m = 0; m < 4; ++m)
#pragma unroll
                for (int n = 0; n < 2; ++n) acc[a][b][m][n] = (f32x4){0.f, 0.f, 0.f, 0.f};
    bf16x8 At[4][2], B0[2][2], B1[2][2];
    const char* cA = (const char*)g.A + (size_t)cur.pm * tstep; const char* cB = (const char*)g.Bt + (size_t)cur.pn * tstep;
    S.a_ready(cur);
    PG8_STAGE(PG8_SB(0, 0), cB, voffB); PG8_STAGE(PG8_SA(0, 0), cA, voffA); PG8_STAGE(PG8_SB(0, 1), cB + hstep, voffB); PG8_STAGE(PG8_SA(0, 1), cA + hstep, voffA);
    if (wr == 1) PG8_BAR;
    PG8_WAIT_V(4); PG8_BAR;
    PG8_STAGE(PG8_SB(1, 0), cB + kstep, voffB); PG8_STAGE(PG8_SA(1, 0), cA + kstep, voffA); PG8_STAGE(PG8_SB(1, 1), cB + hstep + kstep, voffB);
    PG8_WAIT_V(6); PG8_BAR;
    PG8_STAMP();
    for (;;) {
        const bool has_next = S.next(ui + 1, nxt);
        const char* nA = has_next ? (const char*)g.A + (size_t)nxt.pm * tstep : cA; const char* nB = has_next ? (const char*)g.Bt + (size_t)nxt.pn * tstep : cB;
        for (int t = 0; t < nt; t += 2) {
            const bool last = (t == nt - 2);
            const char* a1 = cA + (size_t)(t + 1) * kstep;
            const char* a2 = last ? nA : cA + (size_t)(t + 2) * kstep; const char* b2 = last ? nB : cB + (size_t)(t + 2) * kstep;
            const char* a3 = a2 + kstep; const char* b3 = b2 + kstep;
            if (last && has_next) S.a_ready(nxt);
            PG8_LDB(B0, 0, 0); PG8_SCHED; PG8_LDA(At, 0, 0); PG8_STAGE(PG8_SA(1, 1), a1 + hstep, voffA);
            PG8_WAIT_L(8); PG8_BAR; PG8_WAIT_L(0); PG8_MMA(0, 0, At, B0); PG8_BAR; PG8_SCHED;
            PG8_LDB(B1, 0, 1); PG8_STAGE(PG8_SB(0, 0), b2, voffB);
            PG8_BAR; PG8_WAIT_L(0); PG8_MMA(0, 1, At, B1); PG8_BAR;
            PG8_LDA(At, 0, 1); PG8_STAGE(PG8_SA(0, 0), a2, voffA);
            PG8_BAR; PG8_WAIT_L(0); PG8_MMA(1, 0, At, B0); PG8_BAR; PG8_SCHED;
            PG8_STAGE(PG8_SB(0, 1), b2 + hstep, voffB);
            PG8_WAIT_V(6); PG8_BAR; PG8_MMA(1, 1, At, B1); PG8_BAR;
            PG8_LDB(B0, 1, 0); PG8_SCHED; PG8_LDA(At, 1, 0); PG8_STAGE(PG8_SA(0, 1), a2 + hstep, voffA);
            PG8_WAIT_L(8); PG8_BAR; PG8_WAIT_L(0); PG8_MMA(0, 0, At, B0); PG8_BAR; PG8_SCHED;
            PG8_LDB(B1, 1, 1); PG8_STAGE(PG8_SB(1, 0), b3, voffB);
            PG8_BAR; PG8_WAIT_L(0); PG8_MMA(0, 1, At, B1); PG8_BAR;
            PG8_LDA(At, 1, 1); PG8_STAGE(PG8_SA(1, 0), a3, voffA);
            PG8_BAR; PG8_WAIT_L(0); PG8_MMA(1, 0, At, B0); PG8_BAR; PG8_SCHED;
            PG8_STAGE(PG8_SB(1, 1), b3 + hstep, voffB);
            PG8_WAIT_V(6); PG8_BAR; PG8_MMA(1, 1, At, B1); PG8_BAR;
        }
        PG8_STAMP();
        if constexpr (!Epi::AFTER_DRAIN) { E(acc, cur, wr, wc, fr, fq); S.done(cur); }
        PG8_STAMP();
        if (!has_next) break;
#pragma unroll
        for (int a = 0; a < 2; ++a)
#pragma unroll
            for (int b = 0; b < 2; ++b)
#pragma unroll
                for (int m = 0; m < 4; ++m)
#pragma unroll
                    for (int n = 0; n < 2; ++n) acc[a][b][m][n] = (f32x4){0.f, 0.f, 0.f, 0.f};
        cur = nxt; cA = nA; cB = nB; ++ui;
    }
    PG8_WAIT_V(0);
    if (wr == 0) PG8_BAR;
    PG8_BAR;
    if constexpr (Epi::AFTER_DRAIN) { E.fused(acc, cur, wr, wc, fr, fq, lds, wid, lane); S.done(cur); }
    PG8_STAMP();
    if (STAMP && wid == 0) { stamps[lane] = lane < nts ? (((unsigned long long)(unsigned)ts_hi << 32) | (unsigned)ts_lo) : 0ull;
        if (lane == 62) stamps[62] = rt_entry; if (lane == 63) stamps[63] = (unsigned long long)wall_clock64(); }
#undef PG8_STAMP
#undef PG8_SA
#undef PG8_SB
#undef PG8_STAGE
#undef PG8_LDA
#undef PG8_LDB
#undef PG8_MMA
#undef PG8_WAIT_V
#undef PG8_WAIT_L
#undef PG8_BAR
#undef PG8_SCHED
}
}
using pg8::bf16_t; using pg8::f32x4; using pg8::u32x4; using pg8::Unit; using pg8::cvt_pk_bf16;
typedef unsigned u32x2 __attribute__((ext_vector_type(2)));
constexpr int D = 1024, TP = 16384, TS = 128, T = TP + TS, MP = 16640, NL = 4, CW = 512, NG = 32, NP = 64, DFF = 2816, SEQ = 2048, NB = 8, LC = 128, NCH = SEQ / LC;
constexpr float EPS = 1e-6f;
constexpr size_t O_YP = 0, O_YS = (size_t)TP * D, O_PC = O_YS + (size_t)TS * D, O_PRE = O_PC + (size_t)NL * NB * 2 * CW, O_PIM = O_PRE + (size_t)NL * NB * NG * NP,
                 O_SC = O_PIM + (size_t)NL * NB * NG * NP, O_SRE = O_SC + (size_t)NL * TS * 2 * CW, O_SIM = O_SRE + (size_t)NL * TS * NG * NP, O_END = O_SIM + (size_t)NL * TS * NG * NP;
constexpr size_t SZ_WIN = (size_t)4096 * 1024 * 2, SZ_WGLU = (size_t)512 * 512 * 2, SZ_WB = (size_t)1024 * 512 * 2, SZ_WOUT = (size_t)1024 * 1024 * 2, SZ_WGU = (size_t)5632 * 1024 * 2, SZ_WDN = (size_t)1024 * 2816 * 2;
constexpr size_t WS_WIN = 0, WS_WGLU = WS_WIN + NL * SZ_WIN, WS_WBA = WS_WGLU + NL * SZ_WGLU, WS_WBB = WS_WBA + NL * SZ_WB, WS_WOUT = WS_WBB + NL * SZ_WB, WS_WGU = WS_WOUT + NL * SZ_WOUT,
                 WS_WDN = WS_WGU + NL * SZ_WGU, WS_XB = WS_WDN + NL * SZ_WDN;
constexpr size_t SZ_H = (size_t)MP * 512 * 2, SZ_F = (size_t)MP * 1024 * 2;
constexpr size_t WS_ZB = WS_XB + SZ_F, WS_CV = WS_ZB + SZ_H, WS_U = WS_CV + SZ_H, WS_SGA = WS_U + SZ_H, WS_SGS = WS_SGA + SZ_F, WS_GY = WS_SGS + SZ_F, WS_YS2 = WS_GY + SZ_H, WS_ZEND = WS_YS2 + SZ_H;
constexpr size_t WS_FF = WS_ZB;
static_assert((size_t)MP * DFF * 2 <= WS_ZEND - WS_ZB, "F alias");
constexpr size_t WS_ROWSS = WS_ZEND, SZ_ROWSS = (size_t)MP * 4, WS_ABAR = WS_ROWSS + 9 * SZ_ROWSS, WS_APOW = WS_ABAR + (size_t)NL * NG * NP * 8, WS_BBAR = WS_APOW + (size_t)NL * NG * NP * 8,
                 WS_E = WS_BBAR + (size_t)NL * NG * NP * 32 * 4, WS_END = WS_E + (size_t)NB * NG * NCH * NP * 8;

__device__ __forceinline__ float bf_lo(unsigned w) { return __uint_as_float(w << 16); }
__device__ __forceinline__ float bf_hi(unsigned w) { return __uint_as_float(w & 0xffff0000u); }
__device__ __forceinline__ float sigm(float x) { return __builtin_amdgcn_rcpf(1.0f + __expf(-x)); }
__device__ __forceinline__ u32x4 pack8(const f32x4 a, const f32x4 b) { u32x4 w; w.x = cvt_pk_bf16(a[0], a[1]); w.y = cvt_pk_bf16(a[2], a[3]); w.z = cvt_pk_bf16(b[0], b[1]); w.w = cvt_pk_bf16(b[2], b[3]); return w; }
__device__ __forceinline__ void unpack8(const u32x4 w, f32x4& a, f32x4& b) { a = (f32x4){bf_lo(w.x), bf_hi(w.x), bf_lo(w.y), bf_hi(w.y)}; b = (f32x4){bf_lo(w.z), bf_hi(w.z), bf_lo(w.w), bf_hi(w.w)}; }

#define EPI_ROWS(...) _Pragma("unroll") for (int ai = 0; ai < 2; ++ai) _Pragma("unroll") for (int m = 0; m < 4; ++m) { const int row = row0 + ai * 128 + m * 16; __VA_ARGS__ }
struct EpiIn {
    static constexpr bool PERM = true, AFTER_DRAIN = false;
    bf16_t *ZB, *CV, *U, *SGA, *SGS; const float* rowss;
    __device__ __forceinline__ void operator()(const f32x4 (&acc)[2][2][4][2], const Unit& u, int wr, int wc, int fr, int fq) const {
        const int row0 = u.pm * 256 + wr * 64 + fr, pn = u.pn, cw = wc * 32 + 8 * fq;
        if (pn >= 2 && pn < 6) {
            bf16_t* base = CV + (pn - 2) * 128 + cw;
            EPI_ROWS( const float rs = rsqrtf(rowss[row] * (1.0f / 1024.0f) + EPS), rs2 = rs * rs;
                      *(u32x4*)(base + (size_t)row * 512) = pack8(acc[ai][0][m][0] * acc[ai][1][m][0] * rs2, acc[ai][0][m][1] * acc[ai][1][m][1] * rs2); )
        } else {
            bf16_t* base; int ldc; const bool sg = pn >= 8;
            if (pn < 2) { base = ZB + pn * 256; ldc = 512; } else if (pn < 8) { base = U + (pn - 6) * 256; ldc = 512; } else if (pn < 12) { base = SGA + (pn - 8) * 256; ldc = 1024; } else { base = SGS + (pn - 12) * 256; ldc = 1024; }
            base += cw;
            EPI_ROWS( const float rs = rsqrtf(rowss[row] * (1.0f / 1024.0f) + EPS);
                      _Pragma("unroll") for (int bj = 0; bj < 2; ++bj) { f32x4 v0 = acc[ai][bj][m][0] * rs, v1 = acc[ai][bj][m][1] * rs;
                          if (sg) { _Pragma("unroll") for (int j = 0; j < 4; ++j) { v0[j] = sigm(v0[j]); v1[j] = sigm(v1[j]); } }
                          *(u32x4*)(base + (size_t)row * ldc + bj * 128) = pack8(v0, v1); } )
        }
    }
};
struct EpiGU {
    static constexpr bool PERM = true, AFTER_DRAIN = false;
    bf16_t* F; const float* rowss;
    __device__ __forceinline__ void operator()(const f32x4 (&acc)[2][2][4][2], const Unit& u, int wr, int wc, int fr, int fq) const {
        const int row0 = u.pm * 256 + wr * 64 + fr; bf16_t* base = F + u.pn * 128 + wc * 32 + 8 * fq;
        EPI_ROWS( const float rs = rsqrtf(rowss[row] * (1.0f / 1024.0f) + EPS); f32x4 o[2];
                  _Pragma("unroll") for (int n = 0; n < 2; ++n) { const f32x4 g = acc[ai][0][m][n] * rs, up = acc[ai][1][m][n] * rs;
                      _Pragma("unroll") for (int j = 0; j < 4; ++j) o[n][j] = g[j] * sigm(g[j]) * up[j]; }
                  *(u32x4*)(base + (size_t)row * DFF) = pack8(o[0], o[1]); )
    }
};
struct EpiGlu {
    static constexpr bool PERM = true, AFTER_DRAIN = false;
    const bf16_t* GY; bf16_t* YS2; const float* bias;
    __device__ __forceinline__ void operator()(const f32x4 (&acc)[2][2][4][2], const Unit& u, int wr, int wc, int fr, int fq) const {
        const int row0 = u.pm * 256 + wr * 64 + fr, col0 = u.pn * 256 + wc * 32 + 8 * fq;
        f32x4 bv[2][2];
        _Pragma("unroll") for (int bj = 0; bj < 2; ++bj) { bv[bj][0] = *(const f32x4*)(bias + col0 + bj * 128); bv[bj][1] = *(const f32x4*)(bias + col0 + bj * 128 + 4); }
        EPI_ROWS( _Pragma("unroll") for (int bj = 0; bj < 2; ++bj) { const size_t off = (size_t)row * 512 + col0 + bj * 128; f32x4 g0, g1; unpack8(*(const u32x4*)(GY + off), g0, g1);
                      f32x4 v0 = acc[ai][bj][m][0] + bv[bj][0], v1 = acc[ai][bj][m][1] + bv[bj][1];
                      _Pragma("unroll") for (int j = 0; j < 4; ++j) { v0[j] = g0[j] * sigm(v0[j]); v1[j] = g1[j] * sigm(v1[j]); }
                      *(u32x4*)(YS2 + off) = pack8(v0, v1); } )
    }
};
template <bool SECOND> struct EpiBr {
    static constexpr bool PERM = true, AFTER_DRAIN = false;
    bf16_t *SGA, *SGS;
    __device__ __forceinline__ void operator()(const f32x4 (&acc)[2][2][4][2], const Unit& u, int wr, int wc, int fr, int fq) const {
        const int row0 = u.pm * 256 + wr * 64 + fr, col0 = u.pn * 256 + wc * 32 + 8 * fq;
        EPI_ROWS( _Pragma("unroll") for (int bj = 0; bj < 2; ++bj) { const size_t off = (size_t)row * 1024 + col0 + bj * 128; f32x4 s0, s1;
                      if (!SECOND) { unpack8(*(const u32x4*)(SGA + off), s0, s1); *(u32x4*)(SGA + off) = pack8(s0 * acc[ai][bj][m][0], s1 * acc[ai][bj][m][1]); }
                      else { f32x4 t0, t1; unpack8(*(const u32x4*)(SGS + off), s0, s1); unpack8(*(const u32x4*)(SGA + off), t0, t1); *(u32x4*)(SGS + off) = pack8(t0 + s0 * acc[ai][bj][m][0], t1 + s1 * acc[ai][bj][m][1]); } } )
    }
};
struct EpiRes {
    static constexpr bool PERM = true, AFTER_DRAIN = false;
    float* X; bf16_t* XB; float* rowss_out;
    __device__ __forceinline__ void operator()(const f32x4 (&acc)[2][2][4][2], const Unit& u, int wr, int wc, int fr, int fq) const {
        const int row0 = u.pm * 256 + wr * 64 + fr, col0 = u.pn * 256 + wc * 32 + 8 * fq;
        EPI_ROWS( float ss = 0.f; const bool ok = row < T;
                  _Pragma("unroll") for (int bj = 0; bj < 2; ++bj) { const size_t off = (size_t)row * 1024 + col0 + bj * 128;
                      f32x4 x0 = (f32x4){0.f, 0.f, 0.f, 0.f}, x1 = x0; if (ok) { x0 = *(const f32x4*)(X + off); x1 = *(const f32x4*)(X + off + 4); }
                      x0 += acc[ai][bj][m][0]; x1 += acc[ai][bj][m][1];
                      if (ok) { *(f32x4*)(X + off) = x0; *(f32x4*)(X + off + 4) = x1; }
                      *(u32x4*)(XB + off) = pack8(x0, x1);
                      ss += (x0[0] * x0[0] + x0[1] * x0[1]) + (x0[2] * x0[2] + x0[3] * x0[3]) + (x1[0] * x1[0] + x1[1] * x1[1]) + (x1[2] * x1[2] + x1[3] * x1[3]); }
                  ss += __shfl_xor(ss, 16); ss += __shfl_xor(ss, 32);
                  if (fq == 0) atomicAdd(rowss_out + row, ss); )
    }
};
struct Args { const float* in[25]; float* out; unsigned char* ws; int ph_lo, ph_hi; };
enum { I_XP = 0, I_XS, I_SCONV, I_SRE, I_SIM, I_N1G, I_WIN, I_CONVW, I_CONVB, I_LRE, I_LIM, I_LDT, I_BRE, I_BIM, I_CRE, I_CIM, I_SD, I_WGLU, I_BGLU, I_WBR, I_WOUT, I_N2G, I_WGU, I_WDN, I_FG };

__device__ __forceinline__ int perm_in(int n0) { if (n0 < 512 || n0 >= 1536) return n0; const int q = n0 - 512, tl = q >> 8, rr = q & 255; return rr < 128 ? 512 + tl * 128 + rr : 1024 + tl * 128 + (rr - 128); }
__device__ __forceinline__ int perm_gu(int n0) { const int tl = n0 >> 8, rr = n0 & 255; return rr < 128 ? tl * 128 + rr : DFF + tl * 128 + (rr - 128); }

__device__ __forceinline__ void p0_weights(const Args& a, float* tile) {
    constexpr int PER = 1024 + 64 + 128 + 128 + 256 + 1408 + 704;
    unsigned char* ws = a.ws; int tid = threadIdx.x; asm volatile("" : "+v"(tid));
    for (int it = blockIdx.x; it < NL * PER; it += gridDim.x) {
        const int l = it / PER; int r = it % PER;
        const float* src; const float* gs = nullptr; bf16_t* dst; int ldn, K, n0, k0, sn0;
        if (r < 1024) { n0 = (r >> 4) * 64; k0 = (r & 15) * 64; src = a.in[I_WIN] + (size_t)l * 1024 * 4096; ldn = 4096; K = 1024; dst = (bf16_t*)(ws + WS_WIN + l * SZ_WIN); gs = a.in[I_N1G] + l * 1024; sn0 = perm_in(n0); }
        else if ((r -= 1024) < 64) { n0 = (r >> 3) * 64; k0 = (r & 7) * 64; src = a.in[I_WGLU] + (size_t)l * 512 * 512; ldn = 512; K = 512; dst = (bf16_t*)(ws + WS_WGLU + l * SZ_WGLU); sn0 = n0; }
        else if ((r -= 64) < 128) { n0 = (r >> 3) * 64; k0 = (r & 7) * 64; src = a.in[I_WBR] + (size_t)l * 1024 * 1024; ldn = 1024; K = 512; dst = (bf16_t*)(ws + WS_WBA + l * SZ_WB); sn0 = n0; }
        else if ((r -= 128) < 128) { n0 = (r >> 3) * 64; k0 = (r & 7) * 64; src = a.in[I_WBR] + (size_t)l * 1024 * 1024 + (size_t)512 * 1024; ldn = 1024; K = 512; dst = (bf16_t*)(ws + WS_WBB + l * SZ_WB); sn0 = n0; }
        else if ((r -= 128) < 256) { n0 = (r >> 4) * 64; k0 = (r & 15) * 64; src = a.in[I_WOUT] + (size_t)l * 1024 * 1024; ldn = 1024; K = 1024; dst = (bf16_t*)(ws + WS_WOUT + l * SZ_WOUT); sn0 = n0; }
        else if ((r -= 256) < 1408) { n0 = (r >> 4) * 64; k0 = (r & 15) * 64; src = a.in[I_WGU] + (size_t)l * 1024 * 5632; ldn = 5632; K = 1024; dst = (bf16_t*)(ws + WS_WGU + l * SZ_WGU); gs = a.in[I_N2G] + l * 1024; sn0 = perm_gu(n0); }
        else { r -= 1408; n0 = (r / 44) * 64; k0 = (r % 44) * 64; src = a.in[I_WDN] + (size_t)l * DFF * 1024; ldn = 1024; K = DFF; dst = (bf16_t*)(ws + WS_WDN + l * SZ_WDN); sn0 = n0; }
        __syncthreads();
#pragma unroll
        for (int j = 0; j < 8; ++j) { const int idx = tid + 512 * j, k = idx >> 6, n = idx & 63; float v = src[(size_t)(k0 + k) * ldn + sn0 + n]; if (gs) v *= gs[k0 + k]; tile[k * 65 + n] = v; }
        __syncthreads();
#pragma unroll
        for (int j = 0; j < 4; ++j) { const int idx = tid + 512 * j, n = idx >> 5, kp = idx & 31; *(unsigned*)(dst + (size_t)(n0 + n) * K + k0 + 2 * kp) = cvt_pk_bf16(tile[(2 * kp) * 65 + n], tile[(2 * kp + 1) * 65 + n]); }
    }
}
__device__ __forceinline__ void p0_ssm(const Args& a) {
    float* ABAR = (float*)(a.ws + WS_ABAR); float* APOW = (float*)(a.ws + WS_APOW); float* BBAR = (float*)(a.ws + WS_BBAR);
    for (int i = blockIdx.x * 512 + threadIdx.x; i < NL * NG * NP; i += gridDim.x * 512) {
        const int lg = i >> 6;
        const float dt = expf(a.in[I_LDT][lg]), lr = a.in[I_LRE][i], li = a.in[I_LIM][i];
        const float mag = expf(lr * dt), ang = li * dt; float sn, cs; sincosf(ang, &sn, &cs);
        const float ar = mag * cs, ai = mag * sn, nr = ar - 1.0f, ni = ai, den = lr * lr + li * li, fr = (nr * lr + ni * li) / den, fi = (ni * lr - nr * li) / den;
        ABAR[2 * i] = ar; ABAR[2 * i + 1] = ai;
        float pr = ar, pi = ai;
#pragma unroll
        for (int s = 0; s < 7; ++s) { const float tr = pr * pr - pi * pi, ti = 2.0f * pr * pi; pr = tr; pi = ti; }
        APOW[2 * i] = pr; APOW[2 * i + 1] = pi;
        for (int c = 0; c < 16; ++c) { const float br = a.in[I_BRE][(size_t)i * 16 + c], bi = a.in[I_BIM][(size_t)i * 16 + c]; BBAR[(size_t)i * 32 + c] = fr * br - fi * bi; BBAR[(size_t)i * 32 + 16 + c] = fr * bi + fi * br; }
    }
}
__device__ __forceinline__ void p0_x(const Args& a) {
    float* X = a.out; bf16_t* XB = (bf16_t*)(a.ws + WS_XB); float* RS = (float*)(a.ws + WS_ROWSS);
    int tx_ = threadIdx.x; asm volatile("" : "+v"(tx_)); const int lane = tx_ & 63, gw = blockIdx.x * 8 + (tx_ >> 6), nw = gridDim.x * 8;
    for (int i = blockIdx.x * 512 + threadIdx.x; i < 9 * MP; i += gridDim.x * 512) if (i >= T) RS[i] = 0.f;
    for (int row = gw; row < T; row += nw) {
        const float* src = row < TP ? a.in[I_XP] + (size_t)row * D : a.in[I_XS] + (size_t)(row - TP) * D; float ss = 0.f;
#pragma unroll
        for (int j = 0; j < 2; ++j) { const int c = j * 512 + lane * 8; const f32x4 v0 = *(const f32x4*)(src + c), v1 = *(const f32x4*)(src + c + 4);
            *(f32x4*)(X + (size_t)row * D + c) = v0; *(f32x4*)(X + (size_t)row * D + c + 4) = v1; *(u32x4*)(XB + (size_t)row * D + c) = pack8(v0, v1);
            ss += (v0[0] * v0[0] + v0[1] * v0[1]) + (v0[2] * v0[2] + v0[3] * v0[3]) + (v1[0] * v1[0] + v1[1] * v1[1]) + (v1[2] * v1[2] + v1[3] * v1[3]); }
#pragma unroll
        for (int o = 32; o >= 1; o >>= 1) ss += __shfl_xor(ss, o);
        if (lane == 0) RS[row] = ss;
    }
}
__device__ __forceinline__ void final_norm(const Args& a) {
    float* X = a.out; const float* RS = (const float*)(a.ws + WS_ROWSS) + 8 * (size_t)MP; const float* g = a.in[I_FG];
    int tx_ = threadIdx.x; asm volatile("" : "+v"(tx_)); const int lane = tx_ & 63, gw = blockIdx.x * 8 + (tx_ >> 6), nw = gridDim.x * 8;
    for (int row = gw; row < T; row += nw) { const float rs = rsqrtf(RS[row] * (1.0f / 1024.0f) + EPS);
#pragma unroll
        for (int j = 0; j < 4; ++j) { const int c = j * 256 + lane * 4; f32x4 v = *(const f32x4*)(X + (size_t)row * D + c); const f32x4 gg = *(const f32x4*)(g + c); v = v * rs * gg; *(f32x4*)(X + (size_t)row * D + c) = v; } }
}
__device__ __forceinline__ void conv_phase(const Args& a, int l) {
    bf16_t* ZB = (bf16_t*)(a.ws + WS_ZB); const bf16_t* CV = (const bf16_t*)(a.ws + WS_CV);
    const float* cw = a.in[I_CONVW] + (size_t)l * 3 * CW; const float* cb = a.in[I_CONVB] + (size_t)l * CW; const float* sc = a.in[I_SCONV] + (size_t)l * TS * 2 * CW;
    for (int idx = blockIdx.x * 512 + threadIdx.x; idx < T * 64; idx += gridDim.x * 512) {
        const int row = idx >> 6, c8 = (idx & 63) * 8; const size_t off = (size_t)row * 512 + c8;
        f32x4 z0, z1, x0a, x0b, x1a, x1b, x2a, x2b; const f32x4 zero = (f32x4){0.f, 0.f, 0.f, 0.f};
        unpack8(*(const u32x4*)(ZB + off), z0, z1); unpack8(*(const u32x4*)(CV + off), x0a, x0b);
        if (row < TP) { const int t = row & (SEQ - 1);
            if (t >= 1) unpack8(*(const u32x4*)(CV + off - 512), x1a, x1b); else { x1a = zero; x1b = zero; }
            if (t >= 2) unpack8(*(const u32x4*)(CV + off - 1024), x2a, x2b); else { x2a = zero; x2b = zero; }
            if (t >= SEQ - 2) { float* o = a.out + O_PC + ((size_t)(l * NB + (row >> 11)) * 2 + (t - (SEQ - 2))) * CW + c8; *(f32x4*)o = x0a; *(f32x4*)(o + 4) = x0b; }
        } else { const int b = row - TP; const float* s0 = sc + (size_t)b * 2 * CW + c8;
            x2a = *(const f32x4*)s0; x2b = *(const f32x4*)(s0 + 4); x1a = *(const f32x4*)(s0 + CW); x1b = *(const f32x4*)(s0 + CW + 4);
            float* o = a.out + O_SC + (size_t)(l * TS + b) * 2 * CW + c8; *(f32x4*)o = x1a; *(f32x4*)(o + 4) = x1b; *(f32x4*)(o + CW) = x0a; *(f32x4*)(o + CW + 4) = x0b; }
        const f32x4 w0a = *(const f32x4*)(cw + c8), w0b = *(const f32x4*)(cw + c8 + 4), w1a = *(const f32x4*)(cw + CW + c8), w1b = *(const f32x4*)(cw + CW + c8 + 4),
                    w2a = *(const f32x4*)(cw + 2 * CW + c8), w2b = *(const f32x4*)(cw + 2 * CW + c8 + 4), ba = *(const f32x4*)(cb + c8), bb = *(const f32x4*)(cb + c8 + 4);
        const f32x4 oa = z0 * (ba + w0a * x2a + w1a * x1a + w2a * x0a), ob = z1 * (bb + w0b * x2b + w1b * x1b + w2b * x0b);
        *(u32x4*)(ZB + off) = pack8(oa, ob);
    }
}
struct SsmW { float ar, ai; float bbr[16], bbi[16]; };
template <bool OUT> __device__ __forceinline__ void ssm_run(const bf16_t* U, bf16_t* GY, int row0, int ntok, int g, float& hr, float& hi, const float ar, const float ai,
                                                            const float (&bbr)[16], const float (&bbi)[16], const float (&cr)[16], const float (&ci)[16], const float (&dl)[16], int lane) {
    for (int t0 = 0; t0 < ntok; t0 += 64) {
        const int nt = (ntok - t0) < 64 ? (ntok - t0) : 64;
        u32x4 w0 = (u32x4){0u, 0u, 0u, 0u}, w1 = w0;
        if (lane < nt) { const u32x4* up = (const u32x4*)(U + (size_t)(row0 + t0 + lane) * 512 + g * 16); w0 = up[0]; w1 = up[1]; }
        for (int j = 0; j < nt; ++j) {
            unsigned ws_[8]; ws_[0] = __builtin_amdgcn_readlane(w0.x, j); ws_[1] = __builtin_amdgcn_readlane(w0.y, j); ws_[2] = __builtin_amdgcn_readlane(w0.z, j); ws_[3] = __builtin_amdgcn_readlane(w0.w, j);
            ws_[4] = __builtin_amdgcn_readlane(w1.x, j); ws_[5] = __builtin_amdgcn_readlane(w1.y, j); ws_[6] = __builtin_amdgcn_readlane(w1.z, j); ws_[7] = __builtin_amdgcn_readlane(w1.w, j);
            float uu[16];
#pragma unroll
            for (int q = 0; q < 8; ++q) { uu[2 * q] = bf_lo(ws_[q]); uu[2 * q + 1] = bf_hi(ws_[q]); }
            float bur = 0.f, bui = 0.f;
#pragma unroll
            for (int c = 0; c < 16; ++c) { bur = fmaf(bbr[c], uu[c], bur); bui = fmaf(bbi[c], uu[c], bui); }
            const float nhr = ar * hr - ai * hi + bur, nhi = ar * hi + ai * hr + bui; hr = nhr; hi = nhi;
            if (OUT) {
                float v[16];
#pragma unroll
                for (int c = 0; c < 16; ++c) v[c] = fmaf(dl[c], uu[c], cr[c] * hr - ci[c] * hi);
                float w8[8], w4[4], w2[2], w1_;
                { const bool up = lane & 32;
#pragma unroll
                  for (int k = 0; k < 8; ++k) { const float send = up ? v[k] : v[k + 8], keep = up ? v[k + 8] : v[k]; w8[k] = keep + __shfl_xor(send, 32); } }
                { const bool up = lane & 16;
#pragma unroll
                  for (int k = 0; k < 4; ++k) { const float send = up ? w8[k] : w8[k + 4], keep = up ? w8[k + 4] : w8[k]; w4[k] = keep + __shfl_xor(send, 16); } }
                { const bool up = lane & 8;
#pragma unroll
                  for (int k = 0; k < 2; ++k) { const float send = up ? w4[k] : w4[k + 2], keep = up ? w4[k + 2] : w4[k]; w2[k] = keep + __shfl_xor(send, 8); } }
                { const bool up = lane & 4; const float send = up ? w2[0] : w2[1], keep = up ? w2[1] : w2[0]; w1_ = keep + __shfl_xor(send, 4); }
                w1_ += __shfl_xor(w1_, 2); w1_ += __shfl_xor(w1_, 1);
                const float gy = 0.5f * w1_ * (1.0f + erff(w1_ * 0.70710678118f));
                if ((lane & 3) == 0) GY[(size_t)(row0 + t0 + j) * 512 + g * 16 + (lane >> 2)] = (bf16_t)(cvt_pk_bf16(gy, gy) & 0xffffu);
            }
        }
    }
}
template <bool PASS2> __device__ __forceinline__ void ssm_phase(const Args& a, int l) {
    const bf16_t* U = (const bf16_t*)(a.ws + WS_U); bf16_t* GY = (bf16_t*)(a.ws + WS_GY);
    const float* ABAR = (const float*)(a.ws + WS_ABAR); const float* APOW = (const float*)(a.ws + WS_APOW); const float* BBAR = (const float*)(a.ws + WS_BBAR); float* E = (float*)(a.ws + WS_E);
    int tx_ = threadIdx.x; asm volatile("" : "+v"(tx_)); const int lane = tx_ & 63, gw = blockIdx.x * 8 + (tx_ >> 6), nw = gridDim.x * 8;
    const int nitems = PASS2 ? NB * NG * NCH : NB * NG * NCH + TS * NG;
    for (int item = gw; item < nitems; item += nw) {
        const bool samp = item >= NB * NG * NCH;
        int b, g, ch; if (!samp) { b = item >> 9; g = (item >> 4) & 31; ch = item & 15; } else { const int q = item - NB * NG * NCH; b = q >> 5; g = q & 31; ch = 0; }
        const int i = (l * NG + g) * NP + lane;
        const float ar = ABAR[2 * i], ai = ABAR[2 * i + 1];
        float bbr[16], bbi[16], cr[16], ci[16], dl[16];
#pragma unroll
        for (int c = 0; c < 16; ++c) { bbr[c] = BBAR[(size_t)i * 32 + c]; bbi[c] = BBAR[(size_t)i * 32 + 16 + c]; }
        const bool out = PASS2 || samp;
#pragma unroll
        for (int c = 0; c < 16; ++c) { cr[c] = 0.f; ci[c] = 0.f; dl[c] = 0.f; }
        if (out) {
#pragma unroll
            for (int c = 0; c < 16; ++c) { const size_t ci_ = ((size_t)(l * NG + g) * 16 + c) * NP + lane; cr[c] = a.in[I_CRE][ci_]; ci[c] = a.in[I_CIM][ci_]; dl[c] = lane == 0 ? a.in[I_SD][(size_t)l * 512 + g * 16 + c] : 0.f; }
        }
        float hr = 0.f, hi = 0.f;
        if (samp) {
            const size_t si = ((size_t)(l * TS + b) * NG + g) * NP + lane; hr = a.in[I_SRE][si]; hi = a.in[I_SIM][si];
            ssm_run<true>(U, GY, TP + b, 1, g, hr, hi, ar, ai, bbr, bbi, cr, ci, dl, lane);
            a.out[O_SRE + si] = hr; a.out[O_SIM + si] = hi;
        } else if (!PASS2) {
            ssm_run<false>(U, GY, b * SEQ + ch * LC, LC, g, hr, hi, ar, ai, bbr, bbi, cr, ci, dl, lane);
            const size_t ei = (((size_t)(b * NG + g) * NCH + ch) * NP + lane) * 2; E[ei] = hr; E[ei + 1] = hi;
        } else {
            const float pr = APOW[2 * i], pi = APOW[2 * i + 1];
            for (int j = 0; j < ch; ++j) { const size_t ei = (((size_t)(b * NG + g) * NCH + j) * NP + lane) * 2; const float er = E[ei], ej = E[ei + 1]; const float tr = pr * hr - pi * hi + er, ti = pr * hi + pi * hr + ej; hr = tr; hi = ti; }
            ssm_run<true>(U, GY, b * SEQ + ch * LC, LC, g, hr, hi, ar, ai, bbr, bbi, cr, ci, dl, lane);
            if (ch == NCH - 1) { const size_t oi = ((size_t)(l * NB + b) * NG + g) * NP + lane; a.out[O_PRE + oi] = hr; a.out[O_PIM + oi] = hi; }
        }
    }
}
#ifndef PM
#define PM 511
#endif
#ifndef ONE_LAUNCH
#define ONE_LAUNCH 1
#endif
constexpr int LDS_BYTES = pg8::STAGE_BYTES;
constexpr int N_PHASES = 2 + 8 * NL;

__global__ void __launch_bounds__(512, 2) mk_fwd(Args a) {
    extern __shared__ __attribute__((aligned(16))) unsigned char lds_raw[];
    PG8_LAS unsigned char* lds = (PG8_LAS unsigned char*)lds_raw;
    for (int ph = a.ph_lo; ph < a.ph_hi; ++ph) {
        unsigned char* ws = a.ws; int G = gridDim.x, bx = blockIdx.x; asm volatile("" : "+s"(ws), "+s"(G), "+s"(bx));
        bf16_t* XB = (bf16_t*)(ws + WS_XB); bf16_t* ZB = (bf16_t*)(ws + WS_ZB); bf16_t* CVb = (bf16_t*)(ws + WS_CV); bf16_t* Ub = (bf16_t*)(ws + WS_U); bf16_t* SGA = (bf16_t*)(ws + WS_SGA); bf16_t* SGS = (bf16_t*)(ws + WS_SGS);
        bf16_t* GY = (bf16_t*)(ws + WS_GY); bf16_t* YS2 = (bf16_t*)(ws + WS_YS2); bf16_t* FF = (bf16_t*)(ws + WS_FF); float* RS = (float*)(ws + WS_ROWSS);
        if ((PM & 1) && ph == 0) { p0_weights(a, (float*)lds_raw); p0_ssm(a); p0_x(a); }
        else if ((PM & 2) && ph == N_PHASES - 1) { final_norm(a); }
        else {
            const int l = (ph - 1) >> 3, s = (ph - 1) & 7;
            if ((PM & 4) && s == 0) {
                pg8::Gemm g{XB, (const bf16_t*)(ws + WS_WIN + l * SZ_WIN), MP, 4096, 1024}; pg8::StaticOrder S; S.init(MP, 4096, G, bx);
                EpiIn E{ZB, CVb, Ub, SGA, SGS, RS + (size_t)(2 * l) * MP};
                pg8::gemm_phase<EpiIn, pg8::StaticOrder, false>(lds, g, S, E, nullptr);
            } else if ((PM & 8) && s == 1) { conv_phase(a, l); ssm_phase<false>(a, l); }
            else if ((PM & 16) && s == 2) { ssm_phase<true>(a, l); }
            else if ((PM & 32) && s == 3) {
                { pg8::Gemm g{ZB, (const bf16_t*)(ws + WS_WBA + l * SZ_WB), MP, 1024, 512}; pg8::StaticOrder S; S.init(MP, 1024, G, bx);
                  EpiBr<false> E{SGA, SGS}; pg8::gemm_phase<EpiBr<false>, pg8::StaticOrder, false>(lds, g, S, E, nullptr); }
                { pg8::Gemm g{GY, (const bf16_t*)(ws + WS_WGLU + l * SZ_WGLU), MP, 512, 512}; pg8::StaticOrder S; S.init(MP, 512, G, (bx + G - 8) % G);
                  EpiGlu E{GY, YS2, a.in[I_BGLU] + (size_t)l * 512}; pg8::gemm_phase<EpiGlu, pg8::StaticOrder, false>(lds, g, S, E, nullptr); }
            } else if ((PM & 64) && s == 4) {
                pg8::Gemm g{YS2, (const bf16_t*)(ws + WS_WBB + l * SZ_WB), MP, 1024, 512}; pg8::StaticOrder S; S.init(MP, 1024, G, bx);
                EpiBr<true> E{SGA, SGS}; pg8::gemm_phase<EpiBr<true>, pg8::StaticOrder, false>(lds, g, S, E, nullptr);
            } else if ((PM & 128) && (s == 5 || s == 7)) {
                const bool dn = s == 7;
                pg8::Gemm g{dn ? FF : SGS, (const bf16_t*)(dn ? ws + WS_WDN + l * SZ_WDN : ws + WS_WOUT + l * SZ_WOUT), MP, 1024, dn ? DFF : 1024}; pg8::StaticOrder S; S.init(MP, 1024, G, bx);
                EpiRes E{a.out, XB, RS + (size_t)(2 * l + (dn ? 2 : 1)) * MP};
                pg8::gemm_phase<EpiRes, pg8::StaticOrder, false>(lds, g, S, E, nullptr);
            } else if (PM & 256) {
                pg8::Gemm g{XB, (const bf16_t*)(ws + WS_WGU + l * SZ_WGU), MP, 2 * DFF, 1024}; pg8::StaticOrder S; S.init(MP, 2 * DFF, G, bx);
                EpiGU E{FF, RS + (size_t)(2 * l + 1) * MP};
                pg8::gemm_phase<EpiGU, pg8::StaticOrder, false>(lds, g, S, E, nullptr);
            }
        }
        if (ph + 1 < a.ph_hi) { __syncthreads(); cg::this_grid().sync(); }
    }
}

extern "C" void kernel_launch(void* const* d_in, const int* in_sizes, int n_in, void* d_out, int out_size, void* d_ws, size_t ws_size, hipStream_t stream) {
    static int grid = 0;
    if (grid == 0) {
        if (n_in != 25 || (size_t)out_size != O_END || ws_size < WS_END) { fprintf(stderr, "kernel_launch: unexpected shapes: n_in %d out %d ws %zu (need %zu)\n", n_in, out_size, ws_size, (size_t)WS_END); grid = -1; return; }
        int dev = 0, cus = 0, per_cu = 0;
        hipGetDevice(&dev); hipDeviceGetAttribute(&cus, hipDeviceAttributeMultiprocessorCount, dev);
        if (hipFuncSetAttribute((const void*)mk_fwd, hipFuncAttributeMaxDynamicSharedMemorySize, LDS_BYTES) != hipSuccess) { fprintf(stderr, "kernel_launch: hipFuncSetAttribute failed\n"); grid = -1; return; }
        if (hipOccupancyMaxActiveBlocksPerMultiprocessor(&per_cu, (const void*)mk_fwd, 512, LDS_BYTES) != hipSuccess || per_cu < 1) { fprintf(stderr, "kernel_launch: occupancy query says %d\n", per_cu); per_cu = 1; }
        (void)hipGetLastError();
        grid = cus * 1;
    }
    if (grid < 0) return;
    Args a{};
    for (int i = 0; i < 25; ++i) a.in[i] = (const float*)d_in[i];
    a.out = (float*)d_out; a.ws = (unsigned char*)d_ws;
#if ONE_LAUNCH
    a.ph_lo = 0; a.ph_hi = N_PHASES;
    void* args[] = {&a};
    hipError_t e = hipLaunchCooperativeKernel((const void*)mk_fwd, dim3(grid), dim3(512), args, LDS_BYTES, stream);
    if (e != hipSuccess) fprintf(stderr, "cooperative launch failed: %s (grid %d)\n", hipGetErrorString(e), grid);
#else
    for (int ph = 0; ph < N_PHASES; ++ph) { a.ph_lo = ph; a.ph_hi = ph + 1; hipLaunchKernelGGL(mk_fwd, dim3(grid), dim3(512), LDS_BYTES, stream, a); }
#endif
}
```

```cpp
#include <hip/hip_runtime.h>
#include <hip/hip_cooperative_groups.h>
#include <cstdio>
namespace cg = cooperative_groups;
namespace pg8 {
#define PG8_LAS __attribute__((address_space(3)))
typedef unsigned short bf16_t;
typedef short bf16x8 __attribute__((ext_vector_type(8)));
typedef float f32x4 __attribute__((ext_vector_type(4)));
typedef unsigned u32x4 __attribute__((ext_vector_type(4)));
constexpr int BM = 256, BK = 64, HALF = 128, HTB = HALF * BK * 2  , STAGE_BYTES = 8 * HTB, NXCD = 8, WGM = 8;

__host__ __device__ __forceinline__ int lds_byte(int r, int c) { const int st = (r >> 4) * 2 + (c >> 5), rr = r & 15, cc = c & 31, ob = rr * 64 + cc * 2; return st * 1024 + (ob ^ (((ob >> 9) & 1) << 5)); }
__host__ __device__ __forceinline__ void stage_rc(int b, int& R, int& C) { const int st = b / 1024, sb = b % 1024, swz = sb ^ (((sb >> 9) & 1) << 5); R = (st >> 1) * 16 + swz / 64; C = (st & 1) * 32 + (swz % 64) / 2; }
__host__ __device__ __forceinline__ int perm32(int rho) { const int n = rho >> 4, i = rho & 15; return 8 * (i >> 2) + 4 * n + (i & 3); }

struct Unit { int pm, pn; };
struct Gemm { const bf16_t* A; const bf16_t* Bt; int M, N, K; };

struct StaticOrder {
    int nM, nN, nwg, G, c;
    __host__ __device__ void init(int M, int N, int G_, int c_) { nM = M / BM; nN = N / BM; nwg = nM * nN; G = G_; c = c_; }
    __host__ __device__ bool next(int i, Unit& u) const {
        const long L = (long)i * G + c; if (L >= nwg) return false;
        int wgid = (int)L; { const int q = nwg / NXCD, r = nwg % NXCD, xcd = wgid % NXCD, off = wgid / NXCD; wgid = (xcd < r ? xcd * (q + 1) : r * (q + 1) + (xcd - r) * q) + off; }
        const int nig = WGM * nN, gid = wgid / nig, fm = gid * WGM, gsz = (nM - fm) < WGM ? (nM - fm) : WGM;
        u.pm = fm + ((wgid % nig) % gsz); u.pn = (wgid % nig) / gsz; return true;
    }
    __device__ __forceinline__ void a_ready(const Unit&) const {}
    __device__ __forceinline__ void done(const Unit&) const {}
};
__device__ __forceinline__ unsigned cvt_pk_bf16(float lo, float hi) { unsigned r; asm volatile("v_cvt_pk_bf16_f32 %0, %1, %2" : "=v"(r) : "v"(lo), "v"(hi)); return r; }
typedef float f32x2 __attribute__((ext_vector_type(2)));
__device__ __forceinline__ f32x2 gelu_pk(f32x2 v) {
    const f32x2 av = __builtin_elementwise_abs(v), d = av * 0.2316418882f + 1.0f;
    f32x2 t; t.x = __builtin_amdgcn_rcpf(d.x); t.y = __builtin_amdgcn_rcpf(d.y);
    f32x2 q = t * 0.5307027145f + (-0.7265760135f); q = q * t + 0.7107068705f; q = q * t + (-0.142248368f); q = q * t + 0.127414796f; q = q * t;
    const f32x2 s = (v * v) * (-0.72134752044f);
    f32x2 e; e.x = __builtin_amdgcn_exp2f(s.x); e.y = __builtin_amdgcn_exp2f(s.y);
    const f32x2 m = v * (q * e), r = v - m;
    f32x2 o; o.x = v.x < 0.f ? m.x : r.x; o.y = v.y < 0.f ? m.y : r.y; return o;
}

template <class Epi, class Sched, bool STAMP = false>
__device__ __forceinline__ void gemm_phase(PG8_LAS unsigned char* lds, const Gemm g, const Sched& S, const Epi& E, unsigned long long* stamps) {
    int tid_ = threadIdx.x; asm volatile("" : "+v"(tid_));
    const int tid = tid_, wid = __builtin_amdgcn_readfirstlane(tid >> 6), lane = tid & 63, wr = wid >> 2, wc = wid & 3, fr = lane & 15, fq = lane >> 4;
    const int K = g.K, nt = K / BK;
    int ts_lo = 0, ts_hi = 0, nts = 0; const unsigned long long rt_entry = STAMP ? (unsigned long long)wall_clock64() : 0ull;
#define PG8_STAMP() do { if (STAMP && wid == 0 && nts < 64) { const unsigned long long _c = (unsigned long long)clock64(); \
        ts_lo = (lane == nts) ? (int)(unsigned)_c : ts_lo; ts_hi = (lane == nts) ? (int)(unsigned)(_c >> 32) : ts_hi; ++nts; } } while (0)
    PG8_STAMP();
    unsigned voffA[2], voffB[2];
#pragma unroll
    for (int i = 0; i < 2; ++i) { int R, C; stage_rc(tid * 16 + i * 8192, R, C); const int Rb = Epi::PERM ? ((R & ~31) + perm32(R & 31)) : R;
        voffA[i] = (unsigned)(R * K + C) * 2u; voffB[i] = (unsigned)(Rb * K + C) * 2u; }
    const size_t kstep = (size_t)(BK * 2);
    const size_t hstep = (size_t)HALF * K * 2;
    const size_t tstep = 2 * hstep;
    const unsigned ldsw = (unsigned)wid * 1024u;
    const int aoff = lds_byte(wr * 64 + fr, fq * 8), boff = lds_byte(wc * 32 + fr, fq * 8);
#define PG8_SA(b, h) (((b) * 2 + (h)) * HTB)
#define PG8_SB(b, h) ((4 + (b) * 2 + (h)) * HTB)
#define PG8_STAGE(bufoff, gbase, voff) do { _Pragma("unroll") for (int _i = 0; _i < 2; ++_i) \
        __builtin_amdgcn_global_load_lds((const unsigned*)((const char*)(gbase) + (voff)[_i]), (PG8_LAS unsigned*)(lds + (bufoff) + ldsw + _i * 8192), 16, 0, 0); } while (0)
#define PG8_LDA(dst, b, h) do { _Pragma("unroll") for (int m = 0; m < 4; ++m) _Pragma("unroll") for (int k = 0; k < 2; ++k) dst[m][k] = *(const PG8_LAS bf16x8*)(lds + PG8_SA(b, h) + aoff + m * 2048 + k * 1024); } while (0)
#define PG8_LDB(dst, b, h) do { _Pragma("unroll") for (int n = 0; n < 2; ++n) _Pragma("unroll") for (int k = 0; k < 2; ++k) dst[n][k] = *(const PG8_LAS bf16x8*)(lds + PG8_SB(b, h) + boff + n * 2048 + k * 1024); } while (0)
#define PG8_MMA(ai, bj, At, Bt) do { __builtin_amdgcn_s_setprio(1); _Pragma("unroll") for (int m = 0; m < 4; ++m) _Pragma("unroll") for (int n = 0; n < 2; ++n) _Pragma("unroll") for (int k = 0; k < 2; ++k) \
        acc[ai][bj][m][n] = __builtin_amdgcn_mfma_f32_16x16x32_bf16(Bt[n][k], At[m][k], acc[ai][bj][m][n], 0, 0, 0); __builtin_amdgcn_s_setprio(0); } while (0)
#define PG8_WAIT_V(n) asm volatile("s_waitcnt vmcnt(" #n ")" ::: "memory")
#define PG8_WAIT_L(n) asm volatile("s_waitcnt lgkmcnt(" #n ")" ::: "memory")
#define PG8_BAR __builtin_amdgcn_s_barrier()
#define PG8_SCHED __builtin_amdgcn_sched_barrier(0)
    Unit cur, nxt; int ui = 0;
    if (!S.next(0, cur)) return;
    f32x4 acc[2][2][4][2];
#pragma unroll
    for (int a = 0; a < 2; ++a)
#pragma unroll
        for (int b = 0; b < 2; ++b)
#pragma unroll
            for (int m = 0; m < 4; ++m)
#pragma unroll
                for (int n = 0; n < 2; ++n) acc[a][b][m][n] = (f32x4){0.f, 0.f, 0.f, 0.f};
    bf16x8 At[4][2], B0[2][2], B1[2][2];
    const char* cA = (const char*)g.A + (size_t)cur.pm * tstep; const char* cB = (const char*)g.Bt + (size_t)cur.pn * tstep;
    S.a_ready(cur);
    PG8_STAGE(PG8_SB(0, 0), cB, voffB); PG8_STAGE(PG8_SA(0, 0), cA, voffA); PG8_STAGE(PG8_SB(0, 1), cB + hstep, voffB); PG8_STAGE(PG8_SA(0, 1), cA + hstep, voffA);
    if (wr == 1) PG8_BAR;
    PG8_WAIT_V(4); PG8_BAR;
    PG8_STAGE(PG8_SB(1, 0), cB + kstep, voffB); PG8_STAGE(PG8_SA(1, 0), cA + kstep, voffA); PG8_STAGE(PG8_SB(1, 1), cB + hstep + kstep, voffB);
    PG8_WAIT_V(6); PG8_BAR;
    PG8_STAMP();
    for (;;) {
        const bool has_next = S.next(ui + 1, nxt);
        const char* nA = has_next ? (const char*)g.A + (size_t)nxt.pm * tstep : cA; const char* nB = has_next ? (const char*)g.Bt + (size_t)nxt.pn * tstep : cB;
        for (int t = 0; t < nt; t += 2) {
            const bool last = (t == nt - 2);
            const char* a1 = cA + (size_t)(t + 1) * kstep;
            const char* a2 = last ? nA : cA + (size_t)(t + 2) * kstep; const char* b2 = last ? nB : cB + (size_t)(t + 2) * kstep;
            const char* a3 = a2 + kstep; const char* b3 = b2 + kstep;
            if (last && has_next) S.a_ready(nxt);
            if constexpr (Epi::PREFETCH) { if (last) E.prefetch(cur, wid, lane); }
            PG8_LDB(B0, 0, 0); PG8_SCHED; PG8_LDA(At, 0, 0); PG8_STAGE(PG8_SA(1, 1), a1 + hstep, voffA);
            PG8_WAIT_L(8); PG8_BAR; PG8_WAIT_L(0); PG8_MMA(0, 0, At, B0); PG8_BAR; PG8_SCHED;
            PG8_LDB(B1, 0, 1); PG8_STAGE(PG8_SB(0, 0), b2, voffB);
            PG8_BAR; PG8_WAIT_L(0); PG8_MMA(0, 1, At, B1); PG8_BAR;
            PG8_LDA(At, 0, 1); PG8_STAGE(PG8_SA(0, 0), a2, voffA);
            PG8_BAR; PG8_WAIT_L(0); PG8_MMA(1, 0, At, B0); PG8_BAR; PG8_SCHED;
            PG8_STAGE(PG8_SB(0, 1), b2 + hstep, voffB);
            PG8_WAIT_V(6); PG8_BAR; PG8_MMA(1, 1, At, B1); PG8_BAR;
            PG8_LDB(B0, 1, 0); PG8_SCHED; PG8_LDA(At, 1, 0); PG8_STAGE(PG8_SA(0, 1), a2 + hstep, voffA);
            PG8_WAIT_L(8); PG8_BAR; PG8_WAIT_L(0); PG8_MMA(0, 0, At, B0); PG8_BAR; PG8_SCHED;
            PG8_LDB(B1, 1, 1); PG8_STAGE(PG8_SB(1, 0), b3, voffB);
            PG8_BAR; PG8_WAIT_L(0); PG8_MMA(0, 1, At, B1); PG8_BAR;
            PG8_LDA(At, 1, 1); PG8_STAGE(PG8_SA(1, 0), a3, voffA);
            PG8_BAR; PG8_WAIT_L(0); PG8_MMA(1, 0, At, B0); PG8_BAR; PG8_SCHED;
            PG8_STAGE(PG8_SB(1, 1), b3 + hstep, voffB);
            PG8_WAIT_V(6); PG8_BAR; PG8_MMA(1, 1, At, B1); PG8_BAR;
        }
        PG8_STAMP();
        if constexpr (!Epi::AFTER_DRAIN) { E(acc, cur, wr, wc, fr, fq); S.done(cur); }
        PG8_STAMP();
        if (!has_next) break;
#pragma unroll
        for (int a = 0; a < 2; ++a)
#pragma unroll
            for (int b = 0; b < 2; ++b)
#pragma unroll
                for (int m = 0; m < 4; ++m)
#pragma unroll
                    for (int n = 0; n < 2; ++n) acc[a][b][m][n] = (f32x4){0.f, 0.f, 0.f, 0.f};
        cur = nxt; cA = nA; cB = nB; ++ui;
    }
    PG8_WAIT_V(0);
    if (wr == 0) PG8_BAR;
    PG8_BAR;
    if constexpr (Epi::AFTER_DRAIN) { E.fused(acc, cur, wr, wc, fr, fq, lds, wid, lane); S.done(cur); }
    PG8_STAMP();
    if (STAMP && wid == 0) { stamps[lane] = lane < nts ? (((unsigned long long)(unsigned)ts_hi << 32) | (unsigned)ts_lo) : 0ull;
        if (lane == 62) stamps[62] = rt_entry; if (lane == 63) stamps[63] = (unsigned long long)wall_clock64(); }
#undef PG8_STAMP
#undef PG8_SA
#undef PG8_SB
#undef PG8_STAGE
#undef PG8_LDA
#undef PG8_LDB
#undef PG8_MMA
#undef PG8_WAIT_V
#undef PG8_WAIT_L
#undef PG8_BAR
#undef PG8_SCHED
}
}
using pg8::bf16_t; using pg8::f32x4; using pg8::u32x4; using pg8::Unit; using pg8::cvt_pk_bf16;
typedef unsigned u32x2 __attribute__((ext_vector_type(2)));
constexpr int D = 1024, TP = 16384, TS = 128, T = TP + TS, MP = 16640, NL = 4, CW = 512, NG = 32, NP = 64, DFF = 2816, SEQ = 2048, NB = 8, LC = 64, NCH = SEQ / LC;
constexpr float EPS = 1e-6f;
constexpr size_t O_YP = 0, O_YS = (size_t)TP * D, O_PC = O_YS + (size_t)TS * D, O_PRE = O_PC + (size_t)NL * NB * 2 * CW, O_PIM = O_PRE + (size_t)NL * NB * NG * NP,
                 O_SC = O_PIM + (size_t)NL * NB * NG * NP, O_SRE = O_SC + (size_t)NL * TS * 2 * CW, O_SIM = O_SRE + (size_t)NL * TS * NG * NP, O_END = O_SIM + (size_t)NL * TS * NG * NP;
constexpr size_t SZ_WIN = (size_t)4096 * 1024 * 2, SZ_WGLU = (size_t)512 * 512 * 2, SZ_WB = (size_t)1024 * 512 * 2, SZ_WOUT = (size_t)1024 * 1024 * 2, SZ_WGU = (size_t)5632 * 1024 * 2, SZ_WDN = (size_t)1024 * 2816 * 2;
constexpr size_t WS_WIN = 0, WS_WGLU = WS_WIN + NL * SZ_WIN, WS_WBA = WS_WGLU + NL * SZ_WGLU, WS_WBB = WS_WBA + NL * SZ_WB, WS_WOUT = WS_WBB + NL * SZ_WB, WS_WGU = WS_WOUT + NL * SZ_WOUT,
                 WS_WDN = WS_WGU + NL * SZ_WGU, WS_XB = WS_WDN + NL * SZ_WDN;
constexpr size_t SZ_H = (size_t)MP * 512 * 2, SZ_F = (size_t)MP * 1024 * 2;
constexpr size_t WS_ZB = WS_XB + SZ_F, WS_CV = WS_ZB + SZ_H, WS_U = WS_CV + SZ_H, WS_SGA = WS_U + SZ_H, WS_SGS = WS_SGA + SZ_F, WS_GY = WS_SGS + SZ_F, WS_YS2 = WS_GY + SZ_H, WS_ZEND = WS_YS2 + SZ_H;
constexpr size_t WS_FF = WS_ZB;
static_assert((size_t)MP * DFF * 2 <= WS_ZEND - WS_ZB, "F alias");
constexpr size_t WS_ROWSS = WS_ZEND, SZ_ROWSS = (size_t)MP * 4, WS_ABAR = WS_ROWSS + 9 * SZ_ROWSS, WS_APOW = WS_ABAR + (size_t)NL * NG * NP * 8, WS_BBAR = WS_APOW + (size_t)NL * NG * NP * 8,
                 WS_E = WS_BBAR + (size_t)NL * NG * NP * 32 * 4, WS_BBF = WS_E + (size_t)NB * NG * NCH * NP * 8, WS_CMF = WS_BBF + (size_t)NL * NG * 4 * 64 * 16, WS_END = WS_CMF + (size_t)NL * NG * 5 * 64 * 16;

__device__ __forceinline__ float bf_lo(unsigned w) { return __uint_as_float(w << 16); }
__device__ __forceinline__ float bf_hi(unsigned w) { return __uint_as_float(w & 0xffff0000u); }
__device__ __forceinline__ float sigm(float x) { return __builtin_amdgcn_rcpf(1.0f + __expf(-x)); }
__device__ __forceinline__ u32x4 pack8(const f32x4 a, const f32x4 b) { u32x4 w; w.x = cvt_pk_bf16(a[0], a[1]); w.y = cvt_pk_bf16(a[2], a[3]); w.z = cvt_pk_bf16(b[0], b[1]); w.w = cvt_pk_bf16(b[2], b[3]); return w; }
__device__ __forceinline__ void unpack8(const u32x4 w, f32x4& a, f32x4& b) { a = (f32x4){bf_lo(w.x), bf_hi(w.x), bf_lo(w.y), bf_hi(w.y)}; b = (f32x4){bf_lo(w.z), bf_hi(w.z), bf_lo(w.w), bf_hi(w.w)}; }

__device__ __forceinline__ float nr_rcp(float d) { float r = __uint_as_float(0x7EF311C7u - __float_as_uint(d)); r = r * fmaf(-d, r, 2.0f); r = r * fmaf(-d, r, 2.0f); return r; }
#define WT_FLAGS 0x00020000
__device__ __forceinline__ void wt16s(const __amdgpu_buffer_rsrc_t r, const void* base, const void* p, const u32x4 v) { __builtin_amdgcn_raw_buffer_store_b128(v, r, (unsigned)((const char*)p - (const char*)base), 0, 16); }
__device__ __forceinline__ void wt16(const __amdgpu_buffer_rsrc_t r, const void* base, const void* p, const u32x4 v) { (void)r; (void)base; *(u32x4*)p = v; }
#define EPI_FENCE asm volatile("" ::: "memory")
#define EPI_G(g) const int ai = (g) >> 2, m = (g) & 3, row = row0 + ai * 128 + m * 16
struct EpiIn {
    static constexpr bool PERM = true, AFTER_DRAIN = false, PREFETCH = true;
    unsigned char* ws; const float* rowss; PG8_LAS unsigned char* ldsx;
    __device__ __forceinline__ void prefetch(const Unit& u, int wid, int lane) const { const float* src = rowss + u.pm * 256 + (wid >> 2) * 64 + lane;
        __builtin_amdgcn_global_load_lds((const unsigned*)src, (PG8_LAS unsigned*)(ldsx + wid * 512), 4, 0, 0); __builtin_amdgcn_global_load_lds((const unsigned*)(src + 128), (PG8_LAS unsigned*)(ldsx + wid * 512 + 256), 4, 0, 0); }
    __device__ __forceinline__ void operator()(const f32x4 (&acc)[2][2][4][2], const Unit& u, int wr, int wc, int fr, int fq) const {
        bf16_t* const ZB = (bf16_t*)(ws + WS_ZB); bf16_t* const CV = (bf16_t*)(ws + WS_CV); bf16_t* const U = (bf16_t*)(ws + WS_U); bf16_t* const SGA = (bf16_t*)(ws + WS_SGA); bf16_t* const SGS = (bf16_t*)(ws + WS_SGS);
        const int row0 = u.pm * 256 + wr * 64 + fr, pn = u.pn, cw = wc * 32 + 8 * fq;
        const __amdgpu_buffer_rsrc_t rw = __builtin_amdgcn_make_buffer_rsrc(ws, 0, (int)WS_ZEND, WT_FLAGS);
        float rs[8];
#pragma unroll
        for (int g = 0; g < 8; ++g) { EPI_G(g); (void)row; rs[g] = *(const PG8_LAS float*)(ldsx + (wr * 4 + wc) * 512 + ai * 256 + (16 * m + fr) * 4); }
#pragma unroll
        for (int g = 0; g < 8; ++g) rs[g] = rsqrtf(rs[g] * (1.0f / 1024.0f) + EPS);
        if (pn >= 2 && pn < 6) {
            bf16_t* base = CV + (pn - 2) * 128 + cw;
#pragma unroll
            for (int g = 0; g < 8; ++g) { EPI_G(g); const float rs2 = rs[g] * rs[g];
                wt16(rw, ws, base + (size_t)row * 512, pack8(acc[ai][0][m][0] * acc[ai][1][m][0] * rs2, acc[ai][0][m][1] * acc[ai][1][m][1] * rs2)); }
        } else {
            bf16_t* base; int ldc; const bool sg = pn >= 8;
            if (pn < 2) { base = ZB + pn * 256; ldc = 512; } else if (pn < 8) { base = U + (pn - 6) * 256; ldc = 512; } else if (pn < 12) { base = SGA + (pn - 8) * 256; ldc = 1024; } else { base = SGS + (pn - 12) * 256; ldc = 1024; }
            base += cw;
#pragma unroll
            for (int g = 0; g < 8; ++g) { EPI_G(g);
#pragma unroll
                for (int bj = 0; bj < 2; ++bj) { f32x4 v0, v1;
                    if (sg) { const float rl = rs[g] * -1.4426950408889634f; const f32x4 e0 = acc[ai][bj][m][0] * rl, e1 = acc[ai][bj][m][1] * rl;
#pragma unroll
                        for (int j = 0; j < 4; ++j) { v0[j] = __builtin_amdgcn_rcpf(1.0f + __builtin_amdgcn_exp2f(e0[j])); v1[j] = __builtin_amdgcn_rcpf(1.0f + __builtin_amdgcn_exp2f(e1[j])); } }
                    else { v0 = acc[ai][bj][m][0] * rs[g]; v1 = acc[ai][bj][m][1] * rs[g]; }
                    wt16(rw, ws, base + (size_t)row * ldc + bj * 128, pack8(v0, v1)); } }
        }
    }
};
#ifndef PROBE
#define PROBE 0
#endif
struct EpiGU {
    static constexpr bool PERM = true, AFTER_DRAIN = false, PREFETCH = (PROBE != 24);
    unsigned char* ws; const float* rowss; PG8_LAS unsigned char* ldsx;
    __device__ __forceinline__ void prefetch(const Unit& u, int wid, int lane) const { const float* src = rowss + u.pm * 256 + (wid >> 2) * 64 + lane;
        __builtin_amdgcn_global_load_lds((const unsigned*)src, (PG8_LAS unsigned*)(ldsx + wid * 512), 4, 0, 0); __builtin_amdgcn_global_load_lds((const unsigned*)(src + 128), (PG8_LAS unsigned*)(ldsx + wid * 512 + 256), 4, 0, 0); }
    __device__ __forceinline__ void operator()(const f32x4 (&acc)[2][2][4][2], const Unit& u, int wr, int wc, int fr, int fq) const {
        const int row0 = u.pm * 256 + wr * 64 + fr; bf16_t* base = (bf16_t*)(ws + WS_FF) + u.pn * 128 + wc * 32 + 8 * fq;
        const __amdgpu_buffer_rsrc_t rw = __builtin_amdgcn_make_buffer_rsrc(ws, 0, (int)WS_ZEND, WT_FLAGS);
        float rs[8];
#pragma unroll
        for (int g = 0; g < 8; ++g) { EPI_G(g); rs[g] = PREFETCH ? *(const PG8_LAS float*)(ldsx + (wr * 4 + wc) * 512 + ai * 256 + (16 * m + fr) * 4) : rowss[row]; }
        EPI_FENCE;
#pragma unroll
        for (int g = 0; g < 8; ++g) { EPI_G(g); const float r = rsqrtf(rs[g] * (1.0f / 1024.0f) + EPS), r2 = r * r, rl = r * -1.4426950408889634f; f32x4 o[2];
#pragma unroll
            for (int n = 0; n < 2; ++n) { const f32x4 t = acc[ai][0][m][n] * acc[ai][1][m][n] * r2, xe = acc[ai][0][m][n] * rl;
#pragma unroll
                for (int j = 0; j < 4; ++j) o[n][j] = t[j] * __builtin_amdgcn_rcpf(1.0f + __builtin_amdgcn_exp2f(xe[j])); }
            wt16(rw, ws, base + (size_t)row * DFF, pack8(o[0], o[1])); }
    }
};
struct EpiGlu {
    static constexpr bool PERM = true, AFTER_DRAIN = false, PREFETCH = false;
    unsigned char* ws; const float* bias;
    __device__ __forceinline__ void operator()(const f32x4 (&acc)[2][2][4][2], const Unit& u, int wr, int wc, int fr, int fq) const {
        const bf16_t* const GY = (const bf16_t*)(ws + WS_GY); bf16_t* const YS2 = (bf16_t*)(ws + WS_YS2);
        const int row0 = u.pm * 256 + wr * 64 + fr, col0 = u.pn * 256 + wc * 32 + 8 * fq;
        const __amdgpu_buffer_rsrc_t rw = __builtin_amdgcn_make_buffer_rsrc(ws, 0, (int)WS_ZEND, WT_FLAGS);
        f32x4 bv[2][2];
#pragma unroll
        for (int bj = 0; bj < 2; ++bj) { bv[bj][0] = *(const f32x4*)(bias + col0 + bj * 128); bv[bj][1] = *(const f32x4*)(bias + col0 + bj * 128 + 4); }
        u32x4 buf[4][2];
#define GLU_LOAD(g) { EPI_G(g); (void)ai; (void)m; buf[(g) & 3][0] = *(const u32x4*)(GY + (size_t)row * 512 + col0); buf[(g) & 3][1] = *(const u32x4*)(GY + (size_t)row * 512 + col0 + 128); }
        GLU_LOAD(0) GLU_LOAD(1) GLU_LOAD(2)
#pragma unroll
        for (int g = 0; g < 8; ++g) { if (g + 3 < 8) GLU_LOAD(g + 3)
            EPI_FENCE; EPI_G(g);
#pragma unroll
            for (int bj = 0; bj < 2; ++bj) { f32x4 g0, g1; unpack8(buf[g & 3][bj], g0, g1); f32x4 v0 = acc[ai][bj][m][0] + bv[bj][0], v1 = acc[ai][bj][m][1] + bv[bj][1];
#pragma unroll
                for (int j = 0; j < 4; ++j) { v0[j] = g0[j] * sigm(v0[j]); v1[j] = g1[j] * sigm(v1[j]); }
                wt16(rw, ws, YS2 + (size_t)row * 512 + col0 + bj * 128, pack8(v0, v1)); } }
#undef GLU_LOAD
    }
};
template <bool SECOND> struct EpiBr {
    static constexpr bool PERM = true, AFTER_DRAIN = false, PREFETCH = false;
    unsigned char* ws;
    __device__ __forceinline__ void operator()(const f32x4 (&acc)[2][2][4][2], const Unit& u, int wr, int wc, int fr, int fq) const {
        bf16_t* const SGA = (bf16_t*)(ws + WS_SGA); bf16_t* const SGS = (bf16_t*)(ws + WS_SGS);
        const int row0 = u.pm * 256 + wr * 64 + fr, col0 = u.pn * 256 + wc * 32 + 8 * fq;
        const __amdgpu_buffer_rsrc_t rw = __builtin_amdgcn_make_buffer_rsrc(ws, 0, (int)WS_ZEND, WT_FLAGS);
        constexpr int DP = SECOND ? 3 : 4;
        u32x4 sb[DP][2], tb[SECOND ? DP : 1][2];
#define BR_LOAD(g) { EPI_G(g); (void)ai; (void)m; const size_t off = (size_t)row * 1024 + col0; sb[(g) % DP][0] = *(const u32x4*)((SECOND ? SGS : SGA) + off); sb[(g) % DP][1] = *(const u32x4*)((SECOND ? SGS : SGA) + off + 128); \
            if (SECOND) { tb[(g) % DP][0] = *(const u32x4*)(SGA + off); tb[(g) % DP][1] = *(const u32x4*)(SGA + off + 128); } }
        BR_LOAD(0) BR_LOAD(1) if (DP > 3) BR_LOAD(2)
#pragma unroll
        for (int g = 0; g < 8; ++g) { if (g + DP - 1 < 8) BR_LOAD(g + DP - 1)
            EPI_FENCE; EPI_G(g);
#pragma unroll
            for (int bj = 0; bj < 2; ++bj) { const size_t off = (size_t)row * 1024 + col0 + bj * 128; f32x4 s0, s1; unpack8(sb[g % DP][bj], s0, s1);
                if (!SECOND) wt16(rw, ws, SGA + off, pack8(s0 * acc[ai][bj][m][0], s1 * acc[ai][bj][m][1]));
                else { f32x4 t0, t1; unpack8(tb[g % DP][bj], t0, t1); wt16(rw, ws, SGS + off, pack8(t0 + s0 * acc[ai][bj][m][0], t1 + s1 * acc[ai][bj][m][1])); } } }
#undef BR_LOAD
    }
};
struct EpiRes {
    static constexpr bool PERM = true, AFTER_DRAIN = false, PREFETCH = false;
    float* X; unsigned char* ws; float* rowss_out;
    __device__ __forceinline__ void operator()(const f32x4 (&acc)[2][2][4][2], const Unit& u, int wr, int wc, int fr, int fq) const {
        const int row0 = u.pm * 256 + wr * 64 + fr, col0 = u.pn * 256 + wc * 32 + 8 * fq; bf16_t* const XB = (bf16_t*)(ws + WS_XB);
        const __amdgpu_buffer_rsrc_t rw = __builtin_amdgcn_make_buffer_rsrc(ws, 0, (int)WS_ZEND, WT_FLAGS), ro = __builtin_amdgcn_make_buffer_rsrc(X, 0, (int)((size_t)T * D * 4), WT_FLAGS);
        f32x4 xb[3][2][2];
#define RES_LOAD(g) { EPI_G(g); (void)ai; (void)m; const size_t off = (size_t)row * 1024 + col0; xb[(g) % 3][0][0] = *(const f32x4*)(X + off); xb[(g) % 3][0][1] = *(const f32x4*)(X + off + 4); \
            xb[(g) % 3][1][0] = *(const f32x4*)(X + off + 128); xb[(g) % 3][1][1] = *(const f32x4*)(X + off + 132); }
        RES_LOAD(0) RES_LOAD(1)
#pragma unroll
        for (int g = 0; g < 8; ++g) { if (g + 2 < 8) RES_LOAD(g + 2)
            EPI_FENCE; EPI_G(g); float ss = 0.f;
#pragma unroll
            for (int bj = 0; bj < 2; ++bj) { const size_t off = (size_t)row * 1024 + col0 + bj * 128;
                const f32x4 x0 = xb[g % 3][bj][0] + acc[ai][bj][m][0], x1 = xb[g % 3][bj][1] + acc[ai][bj][m][1];
                wt16(ro, X, X + off, __builtin_bit_cast(u32x4, x0)); wt16(ro, X, X + off + 4, __builtin_bit_cast(u32x4, x1)); wt16(rw, ws, XB + off, pack8(x0, x1));
                ss += (x0[0] * x0[0] + x0[1] * x0[1]) + (x0[2] * x0[2] + x0[3] * x0[3]) + (x1[0] * x1[0] + x1[1] * x1[1]) + (x1[2] * x1[2] + x1[3] * x1[3]); }
            ss += __shfl_xor(ss, 16); ss += __shfl_xor(ss, 32);
            if (fq == 0) atomicAdd(rowss_out + row, ss); }
#undef RES_LOAD
    }
};
template <bool PAIRED, int NTB, class F> __device__ __forceinline__ void skinny_unit(PG8_LAS unsigned char* lds, const bf16_t* Act, const bf16_t* Bt, int K, int n0, int n1, int tok0, int tid, const F& epi) {
    const int lane = tid & 63, w = __builtin_amdgcn_readfirstlane(tid >> 6), r16 = lane & 15, q = lane >> 4, ks = K >> 3;
    const bf16_t* wp0 = Bt + (size_t)(n0 + r16) * K + w * ks + 8 * q;
    const bf16_t* wp1 = Bt + (size_t)(n1 + r16) * K + w * ks + 8 * q;
    const bf16_t* ap = Act + (size_t)(tok0 + r16) * K + w * ks + 8 * q;
    f32x4 acc0[NTB], acc1[NTB];
#pragma unroll
    for (int tb = 0; tb < NTB; ++tb) { acc0[tb] = (f32x4){0.f, 0.f, 0.f, 0.f}; acc1[tb] = acc0[tb]; }
#pragma unroll (NTB > 4 ? 2 : 4)
    for (int k0 = 0; k0 < ks; k0 += 32) {
        const pg8::bf16x8 wf0 = __builtin_bit_cast(pg8::bf16x8, *(const u32x4*)(wp0 + k0));
        pg8::bf16x8 wf1 = wf0; if (PAIRED) wf1 = __builtin_bit_cast(pg8::bf16x8, *(const u32x4*)(wp1 + k0));
        pg8::bf16x8 af[NTB];
#pragma unroll
        for (int tb = 0; tb < NTB; ++tb) af[tb] = __builtin_bit_cast(pg8::bf16x8, *(const u32x4*)(ap + (size_t)(tb * 16) * K + k0));
#pragma unroll
        for (int tb = 0; tb < NTB; ++tb) { acc0[tb] = __builtin_amdgcn_mfma_f32_16x16x32_bf16(wf0, af[tb], acc0[tb], 0, 0, 0);
            if (PAIRED) acc1[tb] = __builtin_amdgcn_mfma_f32_16x16x32_bf16(wf1, af[tb], acc1[tb], 0, 0, 0); }
    }
    __syncthreads();
#pragma unroll
    for (int tb = 0; tb < NTB; ++tb) { *(PG8_LAS f32x4*)(lds + ((w * NTB + tb) * 64 + lane) * 16) = acc0[tb]; if (PAIRED) *(PG8_LAS f32x4*)(lds + 65536 + ((w * NTB + tb) * 64 + lane) * 16) = acc1[tb]; }
    __syncthreads();
    if (w < NTB) {
        f32x4 s0 = (f32x4){0.f, 0.f, 0.f, 0.f}, s1 = s0;
#pragma unroll
        for (int ww = 0; ww < 8; ++ww) { s0 += *(const PG8_LAS f32x4*)(lds + ((ww * NTB + w) * 64 + lane) * 16); if (PAIRED) s1 += *(const PG8_LAS f32x4*)(lds + 65536 + ((ww * NTB + w) * 64 + lane) * 16); }
        epi(s0, s1, TP + tok0 + 16 * w + r16, 4 * q);
    }
}
__device__ __forceinline__ u32x2 pack4(const f32x4 v) { u32x2 w; w.x = cvt_pk_bf16(v[0], v[1]); w.y = cvt_pk_bf16(v[2], v[3]); return w; }
__device__ __forceinline__ f32x4 unpack4(const u32x2 w) { return (f32x4){bf_lo(w.x), bf_hi(w.x), bf_lo(w.y), bf_hi(w.y)}; }

struct EpiNull {
    static constexpr bool PERM = true, AFTER_DRAIN = false, PREFETCH = false;
    float* sink;
    __device__ __forceinline__ void operator()(const f32x4 (&acc)[2][2][4][2], const Unit& u, int wr, int wc, int fr, int fq) const {
        if (acc[0][0][0][0][0] == 1.2345e-33f) *sink = 1.f;
    }
};

template <int MODE> struct EpiProbe {
    static constexpr bool PERM = true, AFTER_DRAIN = false, PREFETCH = false;
    unsigned char* ws; float* sink;
    __device__ __forceinline__ void operator()(const f32x4 (&acc)[2][2][4][2], const Unit& u, int wr, int wc, int fr, int fq) const {
        const int row0 = u.pm * 256 + wr * 64 + fr; bf16_t* base = (bf16_t*)(ws + WS_FF) + u.pn * 128 + wc * 32 + 8 * fq;
        if (MODE == 0) {
#pragma unroll
            for (int g = 0; g < 8; ++g) { EPI_G(g); *(u32x4*)(base + (size_t)row * DFF) = pack8(acc[ai][0][m][0] + acc[ai][1][m][0], acc[ai][0][m][1] + acc[ai][1][m][1]); }
        } else {
            f32x4 s = (f32x4){0.f, 0.f, 0.f, 0.f};
#pragma unroll
            for (int g = 0; g < 8; ++g) { EPI_G(g); (void)row; s += acc[ai][0][m][0] + acc[ai][1][m][0] + acc[ai][0][m][1] + acc[ai][1][m][1]; }
            if (s[0] + s[1] + s[2] + s[3] == 1.2345e-33f) *sink = 1.f;
        }
    }
};
__device__ __forceinline__ int otid() { int t = threadIdx.x; asm volatile("" : "+v"(t)); return t; }
struct Args { const float* in[25]; float* out; unsigned char* ws; int ph_lo, ph_hi; };
enum { I_XP = 0, I_XS, I_SCONV, I_SRE, I_SIM, I_N1G, I_WIN, I_CONVW, I_CONVB, I_LRE, I_LIM, I_LDT, I_BRE, I_BIM, I_CRE, I_CIM, I_SD, I_WGLU, I_BGLU, I_WBR, I_WOUT, I_N2G, I_WGU, I_WDN, I_FG };

__device__ __forceinline__ int perm_in(int n0) { if (n0 < 512 || n0 >= 1536) return n0; const int q = n0 - 512, tl = q >> 8, rr = q & 255; return rr < 128 ? 512 + tl * 128 + rr : 1024 + tl * 128 + (rr - 128); }
__device__ __forceinline__ int perm_gu(int n0) { const int tl = n0 >> 8, rr = n0 & 255; return rr < 128 ? tl * 128 + rr : DFF + tl * 128 + (rr - 128); }

constexpr int P0_PER = 256 + 16 + 32 + 32 + 64 + 352 + 176;
__device__ __forceinline__ void p0_weights(const Args& a, float* tile, int it_lo, int it_hi, int vb, int nvb) {
    constexpr int PER = P0_PER, TP_ = 260;
    unsigned char* ws = a.ws; const int tid = otid(); const __amdgpu_buffer_rsrc_t rwp = __builtin_amdgcn_make_buffer_rsrc(ws, 0, (int)WS_ZEND, WT_FLAGS);
    for (int it = it_lo + vb; it < it_hi; it += nvb) {
        const int l = it / PER; int r = it % PER;
        const float* src; const float* gs = nullptr; bf16_t* dst; int ldn, K, n0, k0, sn0, sn1;
        if (r < 256) { n0 = (r >> 4) * 256; k0 = (r & 15) * 64; src = a.in[I_WIN] + (size_t)l * 1024 * 4096; ldn = 4096; K = 1024; dst = (bf16_t*)(ws + WS_WIN + l * SZ_WIN); gs = a.in[I_N1G] + l * 1024; sn0 = perm_in(n0); sn1 = perm_in(n0 + 128); }
        else if ((r -= 256) < 16) { n0 = (r >> 3) * 256; k0 = (r & 7) * 64; src = a.in[I_WGLU] + (size_t)l * 512 * 512; ldn = 512; K = 512; dst = (bf16_t*)(ws + WS_WGLU + l * SZ_WGLU); sn0 = n0; sn1 = n0 + 128; }
        else if ((r -= 16) < 32) { n0 = (r >> 3) * 256; k0 = (r & 7) * 64; src = a.in[I_WBR] + (size_t)l * 1024 * 1024; ldn = 1024; K = 512; dst = (bf16_t*)(ws + WS_WBA + l * SZ_WB); sn0 = n0; sn1 = n0 + 128; }
        else if ((r -= 32) < 32) { n0 = (r >> 3) * 256; k0 = (r & 7) * 64; src = a.in[I_WBR] + (size_t)l * 1024 * 1024 + (size_t)512 * 1024; ldn = 1024; K = 512; dst = (bf16_t*)(ws + WS_WBB + l * SZ_WB); sn0 = n0; sn1 = n0 + 128; }
        else if ((r -= 32) < 64) { n0 = (r >> 4) * 256; k0 = (r & 15) * 64; src = a.in[I_WOUT] + (size_t)l * 1024 * 1024; ldn = 1024; K = 1024; dst = (bf16_t*)(ws + WS_WOUT + l * SZ_WOUT); sn0 = n0; sn1 = n0 + 128; }
        else if ((r -= 64) < 352) { n0 = (r >> 4) * 256; k0 = (r & 15) * 64; src = a.in[I_WGU] + (size_t)l * 1024 * 5632; ldn = 5632; K = 1024; dst = (bf16_t*)(ws + WS_WGU + l * SZ_WGU); gs = a.in[I_N2G] + l * 1024; sn0 = perm_gu(n0); sn1 = perm_gu(n0 + 128); }
        else { r -= 352; n0 = (r / 44) * 256; k0 = (r % 44) * 64; src = a.in[I_WDN] + (size_t)l * DFF * 1024; ldn = 1024; K = DFF; dst = (bf16_t*)(ws + WS_WDN + l * SZ_WDN); sn0 = n0; sn1 = n0 + 128; }
        f32x4 v[8];
#pragma unroll
        for (int j = 0; j < 8; ++j) { const int idx = tid + 512 * j, k = idx >> 6, n = (idx & 63) * 4; v[j] = *(const f32x4*)(src + (size_t)(k0 + k) * ldn + (n < 128 ? sn0 + n : sn1 + n - 128)); }
        __syncthreads();
#pragma unroll
        for (int j = 0; j < 8; ++j) { const int idx = tid + 512 * j, k = idx >> 6, n = (idx & 63) * 4; f32x4 x = v[j]; if (gs) x *= gs[k0 + k]; *(f32x4*)(tile + k * TP_ + n) = x; }
        __syncthreads();
#pragma unroll
        for (int j = 0; j < 4; ++j) { const int idx = tid + 512 * j, n = idx & 255, kg = idx >> 8; const float* tp = tile + (8 * kg) * TP_ + n; u32x4 w;
            w.x = cvt_pk_bf16(tp[0], tp[TP_]); w.y = cvt_pk_bf16(tp[2 * TP_], tp[3 * TP_]); w.z = cvt_pk_bf16(tp[4 * TP_], tp[5 * TP_]); w.w = cvt_pk_bf16(tp[6 * TP_], tp[7 * TP_]);
            wt16(rwp, ws, dst + (size_t)(n0 + n) * K + k0 + 8 * kg, w); }
    }
}
__device__ __forceinline__ void p0_ssm(const Args& a) {
    float* ABAR = (float*)(a.ws + WS_ABAR); float* APOW = (float*)(a.ws + WS_APOW); float* BBAR = (float*)(a.ws + WS_BBAR); u32x4* BBF = (u32x4*)(a.ws + WS_BBF); const int tx0_ = otid();
    for (int i = blockIdx.x * 512 + tx0_; i < NL * NG * NP; i += gridDim.x * 512) {
        const int lg = i >> 6;
        const float dt = expf(a.in[I_LDT][lg]), lr = a.in[I_LRE][i], li = a.in[I_LIM][i];
        const float mag = expf(lr * dt), ang = li * dt; float sn, cs; sincosf(ang, &sn, &cs);
        const float ar = mag * cs, ai = mag * sn, nr = ar - 1.0f, ni = ai, den = lr * lr + li * li, fr = (nr * lr + ni * li) / den, fi = (ni * lr - nr * li) / den;
        ABAR[2 * i] = ar; ABAR[2 * i + 1] = ai;
        float pr = ar, pi = ai;
#pragma unroll
        for (int s = 0; s < 6; ++s) { const float tr = pr * pr - pi * pi, ti = 2.0f * pr * pi; pr = tr; pi = ti; }
        APOW[2 * i] = pr; APOW[2 * i + 1] = pi;
        float bbr[16], bbi[16];
#pragma unroll
        for (int c = 0; c < 16; ++c) { const float br = a.in[I_BRE][(size_t)i * 16 + c], bi = a.in[I_BIM][(size_t)i * 16 + c]; bbr[c] = fr * br - fi * bi; bbi[c] = fr * bi + fi * br; BBAR[((size_t)lg * 32 + c) * NP + (i & 63)] = bbr[c]; BBAR[((size_t)lg * 32 + 16 + c) * NP + (i & 63)] = bbi[c]; }
        const int p = i & 63, sh = p >> 5, n = p & 31;
#pragma unroll
        for (int h = 0; h < 2; ++h) {
            u32x4 wr_, wi_; wr_.x = cvt_pk_bf16(bbr[8 * h], bbr[8 * h + 1]); wr_.y = cvt_pk_bf16(bbr[8 * h + 2], bbr[8 * h + 3]); wr_.z = cvt_pk_bf16(bbr[8 * h + 4], bbr[8 * h + 5]); wr_.w = cvt_pk_bf16(bbr[8 * h + 6], bbr[8 * h + 7]);
            wi_.x = cvt_pk_bf16(bbi[8 * h], bbi[8 * h + 1]); wi_.y = cvt_pk_bf16(bbi[8 * h + 2], bbi[8 * h + 3]); wi_.z = cvt_pk_bf16(bbi[8 * h + 4], bbi[8 * h + 5]); wi_.w = cvt_pk_bf16(bbi[8 * h + 6], bbi[8 * h + 7]);
            BBF[((size_t)lg * 4 + 2 * sh) * 64 + 32 * h + n] = wr_; BBF[((size_t)lg * 4 + 2 * sh + 1) * 64 + 32 * h + n] = wi_; }
    }
    u32x4* CMF = (u32x4*)(a.ws + WS_CMF);
    for (int i = blockIdx.x * 512 + tx0_; i < NL * NG * 5 * 64; i += gridDim.x * 512) {
        const int lane = i & 63, ks = (i >> 6) % 5, lg = i / 320, ch = lane & 15, q = lane >> 4; float v[8];
#pragma unroll
        for (int j = 0; j < 8; ++j) {
            if (ks < 4) { const int k = 32 * ks + 8 * q + j, sh = k >> 6, kk = k & 63, p = sh * 32 + (kk >> 1); const size_t ci = ((size_t)lg * 16 + ch) * NP + p; v[j] = (kk & 1) ? -a.in[I_CIM][ci] : a.in[I_CRE][ci]; }
            else v[j] = (8 * q + j == ch) ? a.in[I_SD][(size_t)lg * 16 + ch] : 0.f; }
        u32x4 w; w.x = cvt_pk_bf16(v[0], v[1]); w.y = cvt_pk_bf16(v[2], v[3]); w.z = cvt_pk_bf16(v[4], v[5]); w.w = cvt_pk_bf16(v[6], v[7]); CMF[i] = w;
    }
}
__device__ __forceinline__ void p0_x(const Args& a) {
    float* X = a.out; bf16_t* XB = (bf16_t*)(a.ws + WS_XB); float* RS = (float*)(a.ws + WS_ROWSS);
    int tx_ = threadIdx.x; asm volatile("" : "+v"(tx_)); const int lane = tx_ & 63, gw = blockIdx.x * 8 + (tx_ >> 6), nw = gridDim.x * 8;
    for (int i = blockIdx.x * 512 + tx_; i < 9 * MP; i += gridDim.x * 512) if (i >= T) RS[i] = 0.f;
    for (int r0 = gw; r0 < T; r0 += 2 * nw) {
        f32x4 v[2][4];
#pragma unroll
        for (int k = 0; k < 2; ++k) { const int row = r0 + k * nw; if (row < T) { const float* src = row < TP ? a.in[I_XP] + (size_t)row * D : a.in[I_XS] + (size_t)(row - TP) * D;
#pragma unroll
            for (int j = 0; j < 2; ++j) { const int c = j * 512 + lane * 8; v[k][2 * j] = *(const f32x4*)(src + c); v[k][2 * j + 1] = *(const f32x4*)(src + c + 4); } } }
#pragma unroll
        for (int k = 0; k < 2; ++k) { const int row = r0 + k * nw; if (row < T) { float ss = 0.f;
#pragma unroll
            for (int j = 0; j < 2; ++j) { const int c = j * 512 + lane * 8; const f32x4 v0 = v[k][2 * j], v1 = v[k][2 * j + 1];
                *(f32x4*)(X + (size_t)row * D + c) = v0; *(f32x4*)(X + (size_t)row * D + c + 4) = v1; *(u32x4*)(XB + (size_t)row * D + c) = pack8(v0, v1);
                ss += (v0[0] * v0[0] + v0[1] * v0[1]) + (v0[2] * v0[2] + v0[3] * v0[3]) + (v1[0] * v1[0] + v1[1] * v1[1]) + (v1[2] * v1[2] + v1[3] * v1[3]); }
#pragma unroll
            for (int o = 32; o >= 1; o >>= 1) ss += __shfl_xor(ss, o);
            if (lane == 0) RS[row] = ss; } }
    }
}
__device__ __forceinline__ void final_norm(const Args& a) {
    float* X = a.out; const float* RS = (const float*)(a.ws + WS_ROWSS) + 8 * (size_t)MP; const float* g = a.in[I_FG];
    int tx_ = threadIdx.x; asm volatile("" : "+v"(tx_)); const int lane = tx_ & 63, gw = blockIdx.x * 8 + (tx_ >> 6), nw = gridDim.x * 8;
    f32x4 gg[4];
#pragma unroll
    for (int j = 0; j < 4; ++j) gg[j] = *(const f32x4*)(g + j * 256 + lane * 4);
    for (int r0 = gw; r0 < T; r0 += 2 * nw) {
        f32x4 v[2][4]; float rsv[2];
#pragma unroll
        for (int k = 0; k < 2; ++k) { const int row = r0 + k * nw; if (row < T) { rsv[k] = RS[row];
#pragma unroll
            for (int j = 0; j < 4; ++j) v[k][j] = *(const f32x4*)(X + (size_t)row * D + j * 256 + lane * 4); } }
#pragma unroll
        for (int k = 0; k < 2; ++k) { const int row = r0 + k * nw; if (row < T) { const float rs = rsqrtf(rsv[k] * (1.0f / 1024.0f) + EPS);
#pragma unroll
            for (int j = 0; j < 4; ++j) *(f32x4*)(X + (size_t)row * D + j * 256 + lane * 4) = v[k][j] * rs * gg[j]; } }
    }
}
__device__ __forceinline__ void conv_phase(const Args& a, int l) {
    bf16_t* ZB = (bf16_t*)(a.ws + WS_ZB); const bf16_t* CV = (const bf16_t*)(a.ws + WS_CV);
    const float* cw = a.in[I_CONVW] + (size_t)l * 3 * CW; const float* cb = a.in[I_CONVB] + (size_t)l * CW; const float* sc = a.in[I_SCONV] + (size_t)l * TS * 2 * CW;
    const int txc_ = otid(); const int c8 = (txc_ & 63) * 8; const __amdgpu_buffer_rsrc_t rwc = __builtin_amdgcn_make_buffer_rsrc(a.ws, 0, (int)WS_ZEND, WT_FLAGS);
    const f32x4 w0a = *(const f32x4*)(cw + c8), w0b = *(const f32x4*)(cw + c8 + 4), w1a = *(const f32x4*)(cw + CW + c8), w1b = *(const f32x4*)(cw + CW + c8 + 4),
                w2a = *(const f32x4*)(cw + 2 * CW + c8), w2b = *(const f32x4*)(cw + 2 * CW + c8 + 4), ba = *(const f32x4*)(cb + c8), bb = *(const f32x4*)(cb + c8 + 4);
    const f32x4 zero = (f32x4){0.f, 0.f, 0.f, 0.f};
    for (int r0 = blockIdx.x * 8 + (txc_ >> 6); r0 < T; r0 += gridDim.x * 32) {
        u32x4 zr[4], x0r[4], x1r[4], x2r[4]; f32x4 s1a[4], s1b[4], s2a[4], s2b[4];
#pragma unroll
        for (int k = 0; k < 4; ++k) { const int row = r0 + k * gridDim.x * 8; if (row < T) { const size_t off = (size_t)row * 512 + c8;
            zr[k] = *(const u32x4*)(ZB + off); x0r[k] = *(const u32x4*)(CV + off);
            if (row < TP) { const int t = row & (SEQ - 1); x1r[k] = (u32x4){0u, 0u, 0u, 0u}; x2r[k] = x1r[k]; if (t >= 1) x1r[k] = *(const u32x4*)(CV + off - 512); if (t >= 2) x2r[k] = *(const u32x4*)(CV + off - 1024); }
            else { const float* s0 = sc + (size_t)(row - TP) * 2 * CW + c8; s2a[k] = *(const f32x4*)s0; s2b[k] = *(const f32x4*)(s0 + 4); s1a[k] = *(const f32x4*)(s0 + CW); s1b[k] = *(const f32x4*)(s0 + CW + 4); } } }
        asm volatile("" ::: "memory");
#pragma unroll
        for (int k = 0; k < 4; ++k) { const int row = r0 + k * gridDim.x * 8; if (row < T) { const size_t off = (size_t)row * 512 + c8;
            f32x4 z0, z1, x0a, x0b, x1a, x1b, x2a, x2b; unpack8(zr[k], z0, z1); unpack8(x0r[k], x0a, x0b);
            if (row < TP) { const int t = row & (SEQ - 1); unpack8(x1r[k], x1a, x1b); unpack8(x2r[k], x2a, x2b);
                if (t >= SEQ - 2) { float* o = a.out + O_PC + ((size_t)(l * NB + (row >> 11)) * 2 + (t - (SEQ - 2))) * CW + c8; *(f32x4*)o = x0a; *(f32x4*)(o + 4) = x0b; } }
            else { const int b = row - TP; x1a = s1a[k]; x1b = s1b[k]; x2a = s2a[k]; x2b = s2b[k];
                float* o = a.out + O_SC + (size_t)(l * TS + b) * 2 * CW + c8; *(f32x4*)o = x1a; *(f32x4*)(o + 4) = x1b; *(f32x4*)(o + CW) = x0a; *(f32x4*)(o + CW + 4) = x0b; }
            const f32x4 oa = z0 * (ba + w0a * x2a + w1a * x1a + w2a * x0a), ob = z1 * (bb + w0b * x2b + w1b * x1b + w2b * x0b);
            wt16(rwc, a.ws, ZB + off, pack8(oa, ob)); } }
    }
}
struct SsmW { float ar, ai; float bbr[16], bbi[16]; };
template <bool OUT> __device__ __forceinline__ void ssm_run(const bf16_t* U, bf16_t* GY, int row0, int ntok, int g, float& hr, float& hi, const float ar, const float ai,
                                                            const float (&bbr)[16], const float (&bbi)[16], const float (&cr)[16], const float (&ci)[16], const float (&dl)[16], int lane) {
    for (int t0 = 0; t0 < ntok; t0 += 64) {
        const int nt = (ntok - t0) < 64 ? (ntok - t0) : 64;
        u32x4 w0 = (u32x4){0u, 0u, 0u, 0u}, w1 = w0;
        if (lane < nt) { const u32x4* up = (const u32x4*)(U + (size_t)(row0 + t0 + lane) * 512 + g * 16); w0 = up[0]; w1 = up[1]; }
        for (int j = 0; j < nt; ++j) {
            unsigned ws_[8]; ws_[0] = __builtin_amdgcn_readlane(w0.x, j); ws_[1] = __builtin_amdgcn_readlane(w0.y, j); ws_[2] = __builtin_amdgcn_readlane(w0.z, j); ws_[3] = __builtin_amdgcn_readlane(w0.w, j);
            ws_[4] = __builtin_amdgcn_readlane(w1.x, j); ws_[5] = __builtin_amdgcn_readlane(w1.y, j); ws_[6] = __builtin_amdgcn_readlane(w1.z, j); ws_[7] = __builtin_amdgcn_readlane(w1.w, j);
            float uu[16];
#pragma unroll
            for (int q = 0; q < 8; ++q) { uu[2 * q] = bf_lo(ws_[q]); uu[2 * q + 1] = bf_hi(ws_[q]); }
            float bur = 0.f, bui = 0.f;
#pragma unroll
            for (int c = 0; c < 16; ++c) { bur = fmaf(bbr[c], uu[c], bur); bui = fmaf(bbi[c], uu[c], bui); }
            const float nhr = ar * hr - ai * hi + bur, nhi = ar * hi + ai * hr + bui; hr = nhr; hi = nhi;
            if (OUT) {
                float v[16];
#pragma unroll
                for (int c = 0; c < 16; ++c) v[c] = fmaf(dl[c], uu[c], cr[c] * hr - ci[c] * hi);
                float w8[8], w4[4], w2[2], w1_;
                { const bool up = lane & 32;
#pragma unroll
                  for (int k = 0; k < 8; ++k) { const float send = up ? v[k] : v[k + 8], keep = up ? v[k + 8] : v[k]; w8[k] = keep + __shfl_xor(send, 32); } }
                { const bool up = lane & 16;
#pragma unroll
                  for (int k = 0; k < 4; ++k) { const float send = up ? w8[k] : w8[k + 4], keep = up ? w8[k + 4] : w8[k]; w4[k] = keep + __shfl_xor(send, 16); } }
                { const bool up = lane & 8;
#pragma unroll
                  for (int k = 0; k < 2; ++k) { const float send = up ? w4[k] : w4[k + 2], keep = up ? w4[k + 2] : w4[k]; w2[k] = keep + __shfl_xor(send, 8); } }
                { const bool up = lane & 4; const float send = up ? w2[0] : w2[1], keep = up ? w2[1] : w2[0]; w1_ = keep + __shfl_xor(send, 4); }
                w1_ += __shfl_xor(w1_, 2); w1_ += __shfl_xor(w1_, 1);
                const float gy = 0.5f * w1_ * (1.0f + erff(w1_ * 0.70710678118f));
                if ((lane & 3) == 0) GY[(size_t)(row0 + t0 + j) * 512 + g * 16 + (lane >> 2)] = (bf16_t)(cvt_pk_bf16(gy, gy) & 0xffffu);
            }
        }
    }
}
__device__ __forceinline__ void ssm_sample_phase(const Args& a, int l) {
    const bf16_t* U = (const bf16_t*)(a.ws + WS_U); bf16_t* GY = (bf16_t*)(a.ws + WS_GY);
    const float* ABAR = (const float*)(a.ws + WS_ABAR); const float* BBAR = (const float*)(a.ws + WS_BBAR);
    int tx_ = threadIdx.x; asm volatile("" : "+v"(tx_)); const int lane = tx_ & 63, gw = blockIdx.x * 8 + (tx_ >> 6), nw = gridDim.x * 8;
    for (int item = gw; item < TS * NG; item += nw) {
        const int b = item >> 5, g = item & 31, i = (l * NG + g) * NP + lane;
        const float ar = ABAR[2 * i], ai = ABAR[2 * i + 1];
        float bbr[16], bbi[16], cr[16], ci[16], dl[16];
#pragma unroll
        for (int c = 0; c < 16; ++c) { bbr[c] = BBAR[((size_t)(l * NG + g) * 32 + c) * NP + lane]; bbi[c] = BBAR[((size_t)(l * NG + g) * 32 + 16 + c) * NP + lane]; const size_t ci_ = ((size_t)(l * NG + g) * 16 + c) * NP + lane; cr[c] = a.in[I_CRE][ci_]; ci[c] = a.in[I_CIM][ci_]; dl[c] = lane == 0 ? a.in[I_SD][(size_t)l * 512 + g * 16 + c] : 0.f; }
        const size_t si = ((size_t)(l * TS + b) * NG + g) * NP + lane; float hr = a.in[I_SRE][si], hi = a.in[I_SIM][si];
        ssm_run<true>(U, GY, TP + b, 1, g, hr, hi, ar, ai, bbr, bbi, cr, ci, dl, lane);
        a.out[O_SRE + si] = hr; a.out[O_SIM + si] = hi;
    }
}
typedef float f32x16 __attribute__((ext_vector_type(16)));
constexpr int SSM_HP = 272, SSM_WAVE_LDS = 32 * SSM_HP;
__device__ __forceinline__ void ssm_pass1_dual(const Args& a, int l) {
    const bf16_t* U = (const bf16_t*)(a.ws + WS_U); const float* ABAR = (const float*)(a.ws + WS_ABAR); float* E = (float*)(a.ws + WS_E); const u32x4* BBF = (const u32x4*)(a.ws + WS_BBF);
    int tx_ = threadIdx.x; asm volatile("" : "+v"(tx_)); const int lane = tx_ & 63, gw = blockIdx.x * 8 + (tx_ >> 6), nw = gridDim.x * 8, n = lane & 31, hh = lane >> 5;
    for (int item = gw; item < NB * NG * 8; item += nw) {
        const int b0 = item >> 9, g = (item >> 4) & 31, ch = item & 15, lg = l * NG + g;
        float ar[2], ai[2], hr[2][2] = {{0.f, 0.f}, {0.f, 0.f}}, hi[2][2] = {{0.f, 0.f}, {0.f, 0.f}};
#pragma unroll
        for (int sh = 0; sh < 2; ++sh) { const int i = lg * NP + sh * 32 + n; ar[sh] = ABAR[2 * i]; ai[sh] = ABAR[2 * i + 1]; }
        pg8::bf16x8 bf[4];
#pragma unroll
        for (int ct = 0; ct < 4; ++ct) bf[ct] = __builtin_bit_cast(pg8::bf16x8, BBF[((size_t)lg * 4 + ct) * 64 + lane]);
        const bf16_t* up0 = U + (size_t)(b0 * SEQ + ch * 128 + 64 * ((n >> 2) & 1) + 4 * (n >> 3) + (n & 3)) * 512 + g * 16 + 8 * hh;
        u32x4 cur0 = *(const u32x4*)up0, cur1 = *(const u32x4*)(up0 + (size_t)4 * SEQ * 512);
#pragma unroll 1
        for (int rt = 0; rt < 4; ++rt) {
            const int rn = rt < 3 ? rt + 1 : 3;
            const u32x4 nxt0 = *(const u32x4*)(up0 + (size_t)(16 * rn) * 512), nxt1 = *(const u32x4*)(up0 + (size_t)(4 * SEQ + 16 * rn) * 512);
            f32x16 acc[2][4];
#pragma unroll
            for (int ct = 0; ct < 4; ++ct) { f32x16 z;
#pragma unroll
                for (int i = 0; i < 16; ++i) z[i] = 0.f;
                acc[0][ct] = __builtin_amdgcn_mfma_f32_32x32x16_bf16(__builtin_bit_cast(pg8::bf16x8, cur0), bf[ct], z, 0, 0, 0);
                acc[1][ct] = __builtin_amdgcn_mfma_f32_32x32x16_bf16(__builtin_bit_cast(pg8::bf16x8, cur1), bf[ct], z, 0, 0, 0); }
#pragma unroll
            for (int i = 0; i < 16; ++i)
#pragma unroll
                for (int sh = 0; sh < 2; ++sh)
#pragma unroll
                    for (int it = 0; it < 2; ++it) { const float nr = ar[sh] * hr[it][sh] - ai[sh] * hi[it][sh] + acc[it][2 * sh][i], ni = ar[sh] * hi[it][sh] + ai[sh] * hr[it][sh] + acc[it][2 * sh + 1][i]; hr[it][sh] = nr; hi[it][sh] = ni; }
            cur0 = nxt0; cur1 = nxt1;
        }
#pragma unroll
        for (int it = 0; it < 2; ++it)
#pragma unroll
            for (int sh = 0; sh < 2; ++sh) { const size_t ei = (((size_t)((b0 + 4 * it) * NG + g) * NCH + 2 * ch + hh) * NP + sh * 32 + n) * 2; E[ei] = hr[it][sh]; E[ei + 1] = hi[it][sh]; }
    }
}
template <bool PASS2> __device__ __forceinline__ void ssm_mfma_phase(const Args& a, int l, PG8_LAS unsigned char* lds) {
    const bf16_t* U = (const bf16_t*)(a.ws + WS_U); bf16_t* GY = (bf16_t*)(a.ws + WS_GY);
    const float* ABAR = (const float*)(a.ws + WS_ABAR); const float* APOW = (const float*)(a.ws + WS_APOW); float* E = (float*)(a.ws + WS_E);
    const u32x4* BBF = (const u32x4*)(a.ws + WS_BBF); const u32x4* CMF = (const u32x4*)(a.ws + WS_CMF);
    int tx_ = threadIdx.x; asm volatile("" : "+v"(tx_)); const int lane = tx_ & 63, wid = tx_ >> 6, gw = blockIdx.x * 8 + wid, nw = gridDim.x * 8;
    const int n = lane & 31, hh = lane >> 5, t16 = lane & 15, q = lane >> 4;
    PG8_LAS unsigned char* hl = lds + wid * SSM_WAVE_LDS;
    PG8_LAS float* Elds = (PG8_LAS float*)(lds + 81920);
    (void)gw; (void)nw; (void)E;
#pragma unroll 1
    for (int kk = 0; kk < 2; ++kk) {
        const int b = blockIdx.x >> 5, g = blockIdx.x & 31, ch = 2 * wid + kk, lg = l * NG + g;
        float ar[2], ai[2], hr[2] = {0.f, 0.f}, hi[2] = {0.f, 0.f};
#pragma unroll
        for (int sh = 0; sh < 2; ++sh) { const int i = lg * NP + sh * 32 + n; ar[sh] = ABAR[2 * i]; ai[sh] = ABAR[2 * i + 1]; }
        pg8::bf16x8 bf[4];
#pragma unroll
        for (int ct = 0; ct < 4; ++ct) bf[ct] = __builtin_bit_cast(pg8::bf16x8, BBF[((size_t)lg * 4 + ct) * 64 + lane]);
        pg8::bf16x8 cm[5];
        if (PASS2) {
#pragma unroll
            for (int ks = 0; ks < 5; ++ks) cm[ks] = __builtin_bit_cast(pg8::bf16x8, CMF[((size_t)lg * 5 + ks) * 64 + lane]);
            const int sc = 2 * ch + hh; float pr[2], pi[2];
#pragma unroll
            for (int sh = 0; sh < 2; ++sh) { const int i = lg * NP + sh * 32 + n; pr[sh] = APOW[2 * i]; pi[sh] = APOW[2 * i + 1]; }
            typedef float f32x2_ __attribute__((ext_vector_type(2)));
            const PG8_LAS f32x2_* Eb = (const PG8_LAS f32x2_*)Elds + n;
            for (int jb = 0; jb < 2 * ch + 1; jb += 8) {
                f32x2_ e0[8], e1[8];
#pragma unroll
                for (int jj = 0; jj < 8; ++jj) { e0[jj] = Eb[(jb + jj) * NP]; e1[jj] = Eb[(jb + jj) * NP + 32]; }
#pragma unroll
                for (int jj = 0; jj < 8; ++jj) if (jb + jj < sc) {
                    const float tr0 = pr[0] * hr[0] - pi[0] * hi[0] + e0[jj].x, ti0 = pr[0] * hi[0] + pi[0] * hr[0] + e0[jj].y; hr[0] = tr0; hi[0] = ti0;
                    const float tr1 = pr[1] * hr[1] - pi[1] * hi[1] + e1[jj].x, ti1 = pr[1] * hi[1] + pi[1] * hr[1] + e1[jj].y; hr[1] = tr1; hi[1] = ti1; }
            }
        }
        const int row0 = b * SEQ + ch * 128;
        u32x4 afr4[4], uw4[4][2];
#pragma unroll
        for (int rt = 0; rt < 4; ++rt) {
            const int tau = 64 * ((n >> 2) & 1) + 16 * rt + 4 * (n >> 3) + (n & 3);
            afr4[rt] = *(const u32x4*)(U + (size_t)(row0 + tau) * 512 + g * 16 + 8 * hh);
            if (PASS2) {
#pragma unroll
                for (int tb = 0; tb < 2; ++tb) { uw4[rt][tb] = (u32x4){0u, 0u, 0u, 0u}; if (q < 2) uw4[rt][tb] = *(const u32x4*)(U + (size_t)(row0 + 64 * tb + 16 * rt + t16) * 512 + g * 16 + 8 * q); } }
        }
#pragma unroll
        for (int rt = 0; rt < 4; ++rt) {
            const pg8::bf16x8 afr = __builtin_bit_cast(pg8::bf16x8, afr4[rt]);
            f32x16 acc[4];
#pragma unroll
            for (int ct = 0; ct < 4; ++ct) { f32x16 z;
#pragma unroll
                for (int i = 0; i < 16; ++i) z[i] = 0.f;
                acc[ct] = __builtin_amdgcn_mfma_f32_32x32x16_bf16(afr, bf[ct], z, 0, 0, 0); }
#pragma unroll
            for (int sh = 0; sh < 2; ++sh)
#pragma unroll
                for (int i = 0; i < 16; ++i) { const float nr = ar[sh] * hr[sh] - ai[sh] * hi[sh] + acc[2 * sh][i], ni = ar[sh] * hi[sh] + ai[sh] * hr[sh] + acc[2 * sh + 1][i]; hr[sh] = nr; hi[sh] = ni;
                    if (PASS2) *(PG8_LAS unsigned*)(hl + (16 * hh + i) * SSM_HP + sh * 128 + 4 * n) = cvt_pk_bf16(nr, ni); }
            if (PASS2) {
                asm volatile("s_waitcnt lgkmcnt(0)" ::: "memory");
#pragma unroll
                for (int tb = 0; tb < 2; ++tb) {
                    f32x4 y = (f32x4){0.f, 0.f, 0.f, 0.f};
#pragma unroll
                    for (int ks = 0; ks < 4; ++ks) { const pg8::bf16x8 hf = __builtin_bit_cast(pg8::bf16x8, *(const PG8_LAS u32x4*)(hl + (16 * tb + t16) * SSM_HP + (32 * ks + 8 * q) * 2)); y = __builtin_amdgcn_mfma_f32_16x16x32_bf16(cm[ks], hf, y, 0, 0, 0); }
                    const size_t trow = (size_t)(row0 + 64 * tb + 16 * rt + t16) * 512 + g * 16;
                    y = __builtin_amdgcn_mfma_f32_16x16x32_bf16(cm[4], __builtin_bit_cast(pg8::bf16x8, uw4[rt][tb]), y, 0, 0, 0);
                    const pg8::f32x2 ga = pg8::gelu_pk((pg8::f32x2){y[0], y[1]}), gb = pg8::gelu_pk((pg8::f32x2){y[2], y[3]});
                    u32x2 w; w.x = cvt_pk_bf16(ga.x, ga.y); w.y = cvt_pk_bf16(gb.x, gb.y); *(u32x2*)(GY + trow + 4 * q) = w;
                }
                asm volatile("s_waitcnt lgkmcnt(0)" ::: "memory");
            }
        }
        if (!PASS2) {
#pragma unroll
            for (int sh = 0; sh < 2; ++sh) { const int ei = ((2 * ch + hh) * NP + sh * 32 + n) * 2; Elds[ei] = hr[sh]; Elds[ei + 1] = hi[sh]; }
        } else if (ch == 15 && hh == 1) {
#pragma unroll
            for (int sh = 0; sh < 2; ++sh) { const size_t oi = ((size_t)(l * NB + b) * NG + g) * NP + sh * 32 + n; a.out[O_PRE + oi] = hr[sh]; a.out[O_PIM + oi] = hi[sh]; }
        }
    }
}
#define XB_TMO      128
#define XB_XCNT(j)  (256  + 64 * (j))
#define XB_XSUB(j)  (1280 + 64 * (j))
#define XB_XGEN(j)  (2304 + 64 * (j))
#define XB_TOP      3328
#define XB_TOPGEN   3392
#define XCD_BAR_WORDS 3456
#define XB_SPIN_CAP (1u << 18)

__device__ __forceinline__ unsigned xb_ld(unsigned* p)              { return __hip_atomic_load(p, __ATOMIC_RELAXED, __HIP_MEMORY_SCOPE_AGENT); }
__device__ __forceinline__ unsigned xb_add(unsigned* p, unsigned v) { return __hip_atomic_fetch_add(p, v, __ATOMIC_RELAXED, __HIP_MEMORY_SCOPE_AGENT); }
__device__ __forceinline__ unsigned xb_xcc_id() { return (unsigned)__builtin_amdgcn_s_getreg((3 << 11) | 20) & 0xFu; }
#define XB_SPIN(cond, bar) do { unsigned _sp = 0; while (cond) { __builtin_amdgcn_s_sleep(1); \
    if ((++_sp & 255u) == 0u) { if (xb_ld(&(bar)[XB_TMO])) break; if (_sp > XB_SPIN_CAP) { atomicAdd(&(bar)[XB_TMO], 1u); break; } } } } while (0)

struct XcdBarrier {
    unsigned* bar; unsigned x;
    volatile PG8_LAS unsigned* st;
};

__device__ __forceinline__ XcdBarrier xcd_barrier_post(unsigned* bar, volatile PG8_LAS unsigned* st) {
    XcdBarrier b; b.bar = bar; b.x = xb_xcc_id(); b.st = st;
    if (threadIdx.x == 0) { st[2] = xb_add(&bar[XB_XCNT(b.x)], 1u); st[3] = b.x; }
    return b;
}
__device__ __forceinline__ void xcd_barrier_complete(unsigned* bar, unsigned x, unsigned& nloc, unsigned& nx) {
    const unsigned G = gridDim.x * gridDim.y * gridDim.z;
    unsigned sum, cnt, mine, sp = 0u;
    for (;;) {
        sum = 0u; cnt = 0u; mine = 0u;
#pragma unroll
        for (unsigned j = 0; j < 16; ++j) { const unsigned c = xb_ld(&bar[XB_XCNT(j)]); sum += c; cnt += (c > 0u) ? 1u : 0u; mine = (j == x) ? c : mine; }
        if (sum == G) break;
        __builtin_amdgcn_s_sleep(1);
        if ((++sp & 255u) == 0u) { if (xb_ld(&bar[XB_TMO])) break; if (sp > XB_SPIN_CAP) { atomicAdd(&bar[XB_TMO], 1u); break; } }
    }
    nloc = mine > 0u ? mine : 1u; nx = cnt > 0u ? cnt : 1u;
}

__device__ __forceinline__ void xcd_barrier(const XcdBarrier& b) {
    asm volatile("s_waitcnt vmcnt(0)" ::: "memory");
    __syncthreads();
    if (threadIdx.x == 0) {
        unsigned* bar = b.bar;
        __builtin_amdgcn_s_waitcnt(0);
        unsigned nloc = b.st[0], nx = b.st[1];
        if (nloc == 0u) { xcd_barrier_complete(bar, b.x, nloc, nx); b.st[0] = nloc; b.st[1] = nx; }
        const unsigned old = xb_add(&bar[XB_XSUB(b.x)], 1u);
        const unsigned gen = old / nloc;
        if (old + 1u == (gen + 1u) * nloc) {
            __builtin_amdgcn_fence(__ATOMIC_RELEASE, "agent");
            asm volatile("s_waitcnt vmcnt(0)" ::: "memory");
            const unsigned og = xb_add(&bar[XB_TOP], 1u);
            const unsigned tg = og / nx;
            if (og + 1u == (tg + 1u) * nx) xb_add(&bar[XB_TOPGEN], 1u);
            else XB_SPIN(xb_ld(&bar[XB_TOPGEN]) == tg, bar);
            __builtin_amdgcn_fence(__ATOMIC_ACQUIRE, "agent");
            xb_add(&bar[XB_XGEN(b.x)], 1u);
            asm volatile("s_waitcnt vmcnt(0)" ::: "memory");
        } else {
            XB_SPIN(xb_ld(&bar[XB_XGEN(b.x)]) == gen, bar);
            __builtin_amdgcn_fence(__ATOMIC_ACQUIRE, "agent");
            asm volatile("s_waitcnt vmcnt(0)" ::: "memory");
        }
    }
    __syncthreads();
}

#ifndef PROBE
#define PROBE 0
#endif
#ifndef PM
#define PM 511
#endif
#ifndef ONE_LAUNCH
#define ONE_LAUNCH 1
#endif
constexpr int LDS_X = pg8::STAGE_BYTES + 64, LDS_BYTES = LDS_X + 4096;
constexpr size_t WS_BAR = (WS_END + 255) & ~(size_t)255, WS_TOTAL = WS_BAR + (size_t)XCD_BAR_WORDS * 4;
constexpr int N_PHASES = 2 + 8 * NL;

__global__ void __launch_bounds__(512, 2) mk_fwd(Args a) {
    extern __shared__ __attribute__((aligned(16))) unsigned char lds_raw[];
    PG8_LAS unsigned char* lds = (PG8_LAS unsigned char*)lds_raw;
    volatile PG8_LAS unsigned* bst = (volatile PG8_LAS unsigned*)(lds + pg8::STAGE_BYTES);
    if (threadIdx.x < 16) bst[threadIdx.x] = 0u;
    __syncthreads();
    const XcdBarrier gbar = xcd_barrier_post((unsigned*)(a.ws + WS_BAR), bst);
    if (a.ph_hi > 1000) cg::this_grid().sync();
    for (int ph = a.ph_lo; ph < a.ph_hi; ++ph) {
        if (ph > 0 && ph < N_PHASES - 1 && ((ph - 1) & 7) == 2) continue;
        size_t zoff_ = 0; int G = gridDim.x, bx = blockIdx.x; asm volatile("" : "+s"(zoff_), "+s"(G), "+s"(bx)); unsigned char* ws = a.ws + zoff_;
        bf16_t* XB = (bf16_t*)(ws + WS_XB); float* RS = (float*)(ws + WS_ROWSS);
        for (int rep = 0; rep < (((PROBE == 2 && ph == 0) || (PROBE == 3 && ph > 0 && ph < N_PHASES - 1 && (((ph - 1) & 7) == 0 || ((ph - 1) & 7) == 6)) || (PROBE == 7 && ph > 0 && ph < N_PHASES - 1 && ((ph - 1) & 7) == 6) || (PROBE == 8 && ph > 0 && ph < N_PHASES - 1 && ((ph - 1) & 7) == 0) || (PROBE == 4 && ph > 0 && ph < N_PHASES - 1 && (((ph - 1) & 7) == 1 || ((ph - 1) & 7) == 2))) ? 2 : 1); ++rep) {
        if (rep) __syncthreads();
        if ((PM & 1) && ph == 0) { p0_weights(a, (float*)lds_raw, 0, P0_PER, bx, G); p0_ssm(a); p0_x(a); }
        else if ((PM & 2) && ph == N_PHASES - 1) { final_norm(a); }
        else {
            const int l = (ph - 1) >> 3, s = (ph - 1) & 7;
            if ((PM & 4) && s == 0) {
                pg8::Gemm g{XB, (const bf16_t*)(ws + WS_WIN + l * SZ_WIN), TP, 4096, 1024}; pg8::StaticOrder S; S.init(TP, 4096, G, bx);
                EpiIn E{ws, RS + (size_t)(2 * l) * MP, lds + LDS_X};
                if (PROBE == 11) { EpiNull EN{(float*)(ws + WS_E)}; pg8::gemm_phase<EpiNull, pg8::StaticOrder, false>(lds, g, S, EN, nullptr); }
                pg8::gemm_phase<EpiIn, pg8::StaticOrder, false>(lds, g, S, E, nullptr); __syncthreads();
                if (bx < 224) {
                    const int su = bx; int n0, n1, kind, dc;
                    if (su < 32) { kind = 0; dc = 16 * su; n0 = dc; n1 = n0; } else if (su < 64) { kind = 1; dc = 16 * (su - 32); n0 = 512 + (dc >> 7) * 256 + (dc & 127); n1 = n0 + 128; }
                    else if (su < 96) { kind = 2; dc = 16 * (su - 64); n0 = 1536 + dc; n1 = n0; } else if (su < 160) { kind = 3; dc = 16 * (su - 96); n0 = 2048 + dc; n1 = n0; } else { kind = 4; dc = 16 * (su - 160); n0 = 3072 + dc; n1 = n0; }
                    const float* rowss = RS + (size_t)(2 * l) * MP;
                    skinny_unit<true, 8>(lds, XB + (size_t)TP * 1024, (const bf16_t*)(ws + WS_WIN + l * SZ_WIN), 1024, n0, n1, 0, otid(), [=](const f32x4 s0, const f32x4 s1, int row, int c4) {
                        const float rs = rsqrtf(rowss[row] * (1.0f / 1024.0f) + EPS); f32x4 v = s0 * rs;
                        if (kind == 1) v = v * (s1 * rs);
                        if (kind >= 3) { _Pragma("unroll") for (int j = 0; j < 4; ++j) v[j] = sigm(v[j]); }
                        bf16_t* dst = kind == 0 ? (bf16_t*)(ws + WS_ZB) + (size_t)row * 512 : kind == 1 ? (bf16_t*)(ws + WS_CV) + (size_t)row * 512 : kind == 2 ? (bf16_t*)(ws + WS_U) + (size_t)row * 512 : kind == 3 ? (bf16_t*)(ws + WS_SGA) + (size_t)row * 1024 : (bf16_t*)(ws + WS_SGS) + (size_t)row * 1024;
                        *(u32x2*)(dst + dc + c4) = pack4(v); });
                }
            } else if ((PM & 8) && s == 1) { if (!rep) conv_phase(a, l); ssm_sample_phase(a, l); __syncthreads(); ssm_mfma_phase<false>(a, l, lds); __syncthreads(); ssm_mfma_phase<true>(a, l, lds); }
            else if ((PM & 16) && s == 2) { }
            else if ((PM & 32) && s == 3) {
                { pg8::Gemm g{(const bf16_t*)(ws + WS_ZB), (const bf16_t*)(ws + WS_WBA + l * SZ_WB), TP, 1024, 512}; pg8::StaticOrder S; S.init(TP, 1024, G, bx);
                  EpiBr<false> E{ws}; if (PROBE == 11) { EpiNull EN{(float*)(ws + WS_E)}; pg8::gemm_phase<EpiNull, pg8::StaticOrder, false>(lds, g, S, EN, nullptr); } pg8::gemm_phase<EpiBr<false>, pg8::StaticOrder, false>(lds, g, S, E, nullptr); __syncthreads(); }
                { pg8::Gemm g{(const bf16_t*)(ws + WS_GY), (const bf16_t*)(ws + WS_WGLU + l * SZ_WGLU), TP, 512, 512}; pg8::StaticOrder S; S.init(TP, 512, G, bx);
                  EpiGlu E{ws, a.in[I_BGLU] + (size_t)l * 512}; if (PROBE == 11) { EpiNull EN{(float*)(ws + WS_E)}; pg8::gemm_phase<EpiNull, pg8::StaticOrder, false>(lds, g, S, EN, nullptr); } pg8::gemm_phase<EpiGlu, pg8::StaticOrder, false>(lds, g, S, E, nullptr); __syncthreads(); }
                if (bx >= 128 && bx < 192) {
                    const int dc = 16 * (bx - 128);
                    skinny_unit<false, 8>(lds, (const bf16_t*)(ws + WS_ZB) + (size_t)TP * 512, (const bf16_t*)(ws + WS_WBA + l * SZ_WB), 512, dc, dc, 0, otid(), [=](const f32x4 s0, const f32x4 s1, int row, int c4) {
                        u32x2* p = (u32x2*)((bf16_t*)(ws + WS_SGA) + (size_t)row * 1024 + dc + c4); *p = pack4(unpack4(*p) * s0); });
                } else if (bx >= 192 && bx < 224) {
                    const int dc = 16 * (bx - 192); const float* bias = a.in[I_BGLU] + (size_t)l * 512;
                    skinny_unit<false, 8>(lds, (const bf16_t*)(ws + WS_GY) + (size_t)TP * 512, (const bf16_t*)(ws + WS_WGLU + l * SZ_WGLU), 512, dc, dc, 0, otid(), [=](const f32x4 s0, const f32x4 s1, int row, int c4) {
                        const f32x4 gy = unpack4(*(const u32x2*)((const bf16_t*)(ws + WS_GY) + (size_t)row * 512 + dc + c4)); f32x4 v = s0 + *(const f32x4*)(bias + dc + c4);
                        _Pragma("unroll") for (int j = 0; j < 4; ++j) v[j] = gy[j] * sigm(v[j]);
                        *(u32x2*)((bf16_t*)(ws + WS_YS2) + (size_t)row * 512 + dc + c4) = pack4(v); });
                }
                if (l + 1 < NL && bx >= 128) { __syncthreads(); p0_weights(a, (float*)lds_raw, (l + 1) * P0_PER, (l + 1) * P0_PER + 340, bx - 128, 128); }
            } else if ((PM & 64) && s == 4) {
                pg8::Gemm g{(const bf16_t*)(ws + WS_YS2), (const bf16_t*)(ws + WS_WBB + l * SZ_WB), TP, 1024, 512}; pg8::StaticOrder S; S.init(TP, 1024, G, bx);
                EpiBr<true> E{ws}; if (PROBE == 11) { EpiNull EN{(float*)(ws + WS_E)}; pg8::gemm_phase<EpiNull, pg8::StaticOrder, false>(lds, g, S, EN, nullptr); } pg8::gemm_phase<EpiBr<true>, pg8::StaticOrder, false>(lds, g, S, E, nullptr); __syncthreads();
                {
                    const int dc = 16 * (bx & 63);
                    skinny_unit<false, 2>(lds, (const bf16_t*)(ws + WS_YS2) + (size_t)TP * 512, (const bf16_t*)(ws + WS_WBB + l * SZ_WB), 512, dc, dc, 32 * (bx >> 6), otid(), [=](const f32x4 s0, const f32x4 s1, int row, int c4) {
                        const size_t off = (size_t)row * 1024 + dc + c4; u32x2* p = (u32x2*)((bf16_t*)(ws + WS_SGS) + off); const f32x4 t = unpack4(*(const u32x2*)((const bf16_t*)(ws + WS_SGA) + off));
                        *p = pack4(t + unpack4(*p) * s0); });
                }
            } else if ((PM & 128) && (s == 5 || s == 7)) {
                const bool dn = s == 7;
                pg8::Gemm g{(const bf16_t*)(dn ? ws + WS_FF : ws + WS_SGS), (const bf16_t*)(dn ? ws + WS_WDN + l * SZ_WDN : ws + WS_WOUT + l * SZ_WOUT), TP, 1024, dn ? DFF : 1024}; pg8::StaticOrder S; S.init(TP, 1024, G, bx);
                EpiRes E{a.out, ws, RS + (size_t)(2 * l + (dn ? 2 : 1)) * MP};
                if (PROBE == 5) { EpiProbe<1> EN{ws, (float*)(ws + WS_E)}; pg8::gemm_phase<EpiProbe<1>, pg8::StaticOrder, false>(lds, g, S, EN, nullptr); }
                if (PROBE == 11) { EpiNull EN{(float*)(ws + WS_E)}; pg8::gemm_phase<EpiNull, pg8::StaticOrder, false>(lds, g, S, EN, nullptr); }
                pg8::gemm_phase<EpiRes, pg8::StaticOrder, false>(lds, g, S, E, nullptr); __syncthreads();
                {
                    const int dc = 16 * (bx & 63), Ks = dn ? DFF : 1024; float* rso = RS + (size_t)(2 * l + (dn ? 2 : 1)) * MP; float* X = a.out;
                    skinny_unit<false, 2>(lds, (const bf16_t*)(dn ? ws + WS_FF : ws + WS_SGS) + (size_t)TP * Ks, (const bf16_t*)(dn ? ws + WS_WDN + l * SZ_WDN : ws + WS_WOUT + l * SZ_WOUT), Ks, dc, dc, 32 * (bx >> 6), otid(), [=](const f32x4 s0, const f32x4 s1, int row, int c4) {
                        const size_t off = (size_t)row * 1024 + dc + c4; const f32x4 x = *(const f32x4*)(X + off) + s0; *(f32x4*)(X + off) = x; *(u32x2*)(XB + off) = pack4(x);
                        float ss = (x[0] * x[0] + x[1] * x[1]) + (x[2] * x[2] + x[3] * x[3]); ss += __shfl_xor(ss, 16); ss += __shfl_xor(ss, 32);
                        if (c4 == 0) atomicAdd(rso + row, ss); });
                }
            } else if (PM & 256) {
                pg8::Gemm g{XB, (const bf16_t*)(ws + WS_WGU + l * SZ_WGU), TP, 2 * DFF, 1024}; pg8::StaticOrder S; S.init(TP, 2 * DFF, G, bx);
                EpiGU E{ws, RS + (size_t)(2 * l + 1) * MP, lds + LDS_X};
                if (PROBE == 11) { EpiNull EN{(float*)(ws + WS_E)}; pg8::gemm_phase<EpiNull, pg8::StaticOrder, false>(lds, g, S, EN, nullptr); }
                if (PROBE == 20) { EpiProbe<0> EP{ws, (float*)(ws + WS_E)}; pg8::gemm_phase<EpiProbe<0>, pg8::StaticOrder, false>(lds, g, S, EP, nullptr); }
                if (PROBE == 21) { EpiProbe<1> EP{ws, (float*)(ws + WS_E)}; pg8::gemm_phase<EpiProbe<1>, pg8::StaticOrder, false>(lds, g, S, EP, nullptr); }
                if (PROBE == 22 || PROBE == 24 || PROBE == 26) { pg8::gemm_phase<EpiGU, pg8::StaticOrder, false>(lds, g, S, E, nullptr); __syncthreads(); if (PROBE == 26) __syncthreads(); }
                pg8::gemm_phase<EpiGU, pg8::StaticOrder, false>(lds, g, S, E, nullptr); __syncthreads();
                if (bx >= 80) {
                    const int dc = 16 * (255 - bx), n0 = (dc >> 7) * 256 + (dc & 127); const float* rowss = RS + (size_t)(2 * l + 1) * MP;
                    skinny_unit<true, 8>(lds, XB + (size_t)TP * 1024, (const bf16_t*)(ws + WS_WGU + l * SZ_WGU), 1024, n0, n0 + 128, 0, otid(), [=](const f32x4 s0, const f32x4 s1, int row, int c4) {
                        const float rs = rsqrtf(rowss[row] * (1.0f / 1024.0f) + EPS); const f32x4 g = s0 * rs, up = s1 * rs; f32x4 v;
                        _Pragma("unroll") for (int j = 0; j < 4; ++j) v[j] = g[j] * sigm(g[j]) * up[j];
                        *(u32x2*)((bf16_t*)(ws + WS_FF) + (size_t)row * DFF + dc + c4) = pack4(v); });
                }
                if (l + 1 < NL && bx >= 128) { __syncthreads(); p0_weights(a, (float*)lds_raw, (l + 1) * P0_PER + 340, (l + 2) * P0_PER, bx - 128, 128); }
            }
        }
        }
        if (ph + 1 < a.ph_hi) { xcd_barrier(gbar); if (PROBE == 1) xcd_barrier(gbar); }
        if (ph == a.ph_lo) {
            if (threadIdx.x == 0) { bool ok = true; unsigned* bw = (unsigned*)(a.ws + WS_BAR);
                for (unsigned j = 0; j < 16; ++j) { const unsigned cnt = xb_ld(&bw[XB_XCNT(j)]); ok = ok && (j < 8 ? cnt == 32u : cnt == 0u); }
                bst[4] = ok ? (bst[2] * 8u + bst[3]) : (unsigned)blockIdx.x; }
            __syncthreads();
        }
    }
}

extern "C" void kernel_launch(void* const* d_in, const int* in_sizes, int n_in, void* d_out, int out_size, void* d_ws, size_t ws_size, hipStream_t stream) {
    static int grid = 0;
    if (grid == 0) {
        if (n_in != 25 || (size_t)out_size != O_END || ws_size < WS_TOTAL) { fprintf(stderr, "kernel_launch: unexpected shapes: n_in %d out %d ws %zu (need %zu)\n", n_in, out_size, ws_size, (size_t)WS_TOTAL); grid = -1; return; }
        int dev = 0, cus = 0, per_cu = 0;
        hipGetDevice(&dev); hipDeviceGetAttribute(&cus, hipDeviceAttributeMultiprocessorCount, dev);
        if (hipFuncSetAttribute((const void*)mk_fwd, hipFuncAttributeMaxDynamicSharedMemorySize, LDS_BYTES) != hipSuccess) { fprintf(stderr, "kernel_launch: hipFuncSetAttribute failed\n"); grid = -1; return; }
        if (hipOccupancyMaxActiveBlocksPerMultiprocessor(&per_cu, (const void*)mk_fwd, 512, LDS_BYTES) != hipSuccess || per_cu < 1) { fprintf(stderr, "kernel_launch: occupancy query says %d\n", per_cu); per_cu = 1; }
        (void)hipGetLastError();
        grid = 256;
        if (cus < 256) fprintf(stderr, "kernel_launch: %d CUs, need 256\n", cus);
    }
    if (grid < 0) return;
    if (hipMemsetAsync((char*)d_ws + WS_BAR, 0, (size_t)XCD_BAR_WORDS * 4, stream) != hipSuccess) { fprintf(stderr, "kernel_launch: memset of the barrier words failed\n"); return; }
    Args a{};
    for (int i = 0; i < 25; ++i) a.in[i] = (const float*)d_in[i];
    a.out = (float*)d_out; a.ws = (unsigned char*)d_ws;
#if ONE_LAUNCH
    a.ph_lo = 0; a.ph_hi = N_PHASES;
    void* args[] = {&a};
    hipError_t e = hipLaunchCooperativeKernel((const void*)mk_fwd, dim3(grid), dim3(512), args, LDS_BYTES, stream);
    if (e != hipSuccess) fprintf(stderr, "cooperative launch failed: %s (grid %d)\n", hipGetErrorString(e), grid);
#else
    for (int ph = 0; ph < N_PHASES; ++ph) { a.ph_lo = ph; a.ph_hi = ph + 1; hipLaunchKernelGGL(mk_fwd, dim3(grid), dim3(512), LDS_BYTES, stream, a); }
#endif
}
```

```cpp
#include <hip/hip_runtime.h>
#include <hip/hip_cooperative_groups.h>
#include <cstdio>
namespace cg = cooperative_groups;
namespace pg8 {
#define PG8_LAS __attribute__((address_space(3)))
typedef unsigned short bf16_t;
typedef short bf16x8 __attribute__((ext_vector_type(8)));
typedef float f32x4 __attribute__((ext_vector_type(4)));
typedef unsigned u32x4 __attribute__((ext_vector_type(4)));
constexpr int BM = 256, BK = 64, HALF = 128, HTB = HALF * BK * 2  , STAGE_BYTES = 8 * HTB, NXCD = 8, WGM = 8;

__host__ __device__ __forceinline__ int lds_byte(int r, int c) { const int st = (r >> 4) * 2 + (c >> 5), rr = r & 15, cc = c & 31, ob = rr * 64 + cc * 2; return st * 1024 + (ob ^ (((ob >> 9) & 1) << 5)); }
__host__ __device__ __forceinline__ void stage_rc(int b, int& R, int& C) { const int st = b / 1024, sb = b % 1024, swz = sb ^ (((sb >> 9) & 1) << 5); R = (st >> 1) * 16 + swz / 64; C = (st & 1) * 32 + (swz % 64) / 2; }
__host__ __device__ __forceinline__ int perm32(int rho) { const int n = rho >> 4, i = rho & 15; return 8 * (i >> 2) + 4 * n + (i & 3); }

struct Unit { int pm, pn; };
struct Gemm { const bf16_t* A; const bf16_t* Bt; int M, N, K; };

struct StaticOrder {
    int nM, nN, nwg, G, c;
    __host__ __device__ void init(int M, int N, int G_, int c_) { nM = M / BM; nN = N / BM; nwg = nM * nN; G = G_; c = c_; }
    __host__ __device__ bool next(int i, Unit& u) const {
        const long L = (long)i * G + c; if (L >= nwg) return false;
        int wgid = (int)L; { const int q = nwg / NXCD, r = nwg % NXCD, xcd = wgid % NXCD, off = wgid / NXCD; wgid = (xcd < r ? xcd * (q + 1) : r * (q + 1) + (xcd - r) * q) + off; }
        const int nig = WGM * nN, gid = wgid / nig, fm = gid * WGM, gsz = (nM - fm) < WGM ? (nM - fm) : WGM;
        u.pm = fm + ((wgid % nig) % gsz); u.pn = (wgid % nig) / gsz; return true;
    }
    __device__ __forceinline__ void a_ready(const Unit&) const {}
    __device__ __forceinline__ void done(const Unit&) const {}
};
__device__ __forceinline__ unsigned cvt_pk_bf16(float lo, float hi) { unsigned r; asm volatile("v_cvt_pk_bf16_f32 %0, %1, %2" : "=v"(r) : "v"(lo), "v"(hi)); return r; }
typedef float f32x2 __attribute__((ext_vector_type(2)));
__device__ __forceinline__ f32x2 gelu_pk(f32x2 v) {
    const f32x2 av = __builtin_elementwise_abs(v), d = av * 0.2316418882f + 1.0f;
    f32x2 t; t.x = __builtin_amdgcn_rcpf(d.x); t.y = __builtin_amdgcn_rcpf(d.y);
    f32x2 q = t * 0.5307027145f + (-0.7265760135f); q = q * t + 0.7107068705f; q = q * t + (-0.142248368f); q = q * t + 0.127414796f; q = q * t;
    const f32x2 s = (v * v) * (-0.72134752044f);
    f32x2 e; e.x = __builtin_amdgcn_exp2f(s.x); e.y = __builtin_amdgcn_exp2f(s.y);
    const f32x2 m = v * (q * e), r = v - m;
    f32x2 o; o.x = v.x < 0.f ? m.x : r.x; o.y = v.y < 0.f ? m.y : r.y; return o;
}

template <class Epi, class Sched, bool STAMP = false>
__device__ __forceinline__ void gemm_phase(PG8_LAS unsigned char* lds, const Gemm g, const Sched& S, const Epi& E, unsigned long long* stamps) {
    int tid_ = threadIdx.x; asm volatile("" : "+v"(tid_));
    const int tid = tid_, wid = __builtin_amdgcn_readfirstlane(tid >> 6), lane = tid & 63, wr = wid >> 2, wc = wid & 3, fr = lane & 15, fq = lane >> 4;
    const int K = g.K, nt = K / BK;
    int ts_lo = 0, ts_hi = 0, nts = 0; const unsigned long long rt_entry = STAMP ? (unsigned long long)wall_clock64() : 0ull;
#define PG8_STAMP() do { if (STAMP && wid == 0 && nts < 64) { const unsigned long long _c = (unsigned long long)clock64(); \
        ts_lo = (lane == nts) ? (int)(unsigned)_c : ts_lo; ts_hi = (lane == nts) ? (int)(unsigned)(_c >> 32) : ts_hi; ++nts; } } while (0)
    PG8_STAMP();
    unsigned voffA[2], voffB[2];
#pragma unroll
    for (int i = 0; i < 2; ++i) { int R, C; stage_rc(tid * 16 + i * 8192, R, C); const int Rb = Epi::PERM ? ((R & ~31) + perm32(R & 31)) : R;
        voffA[i] = (unsigned)(R * K + C) * 2u; voffB[i] = (unsigned)(Rb * K + C) * 2u; }
    const size_t kstep = (size_t)(BK * 2);
    const size_t hstep = (size_t)HALF * K * 2;
    const size_t tstep = 2 * hstep;
    const unsigned ldsw = (unsigned)wid * 1024u;
    const int aoff = lds_byte(wr * 64 + fr, fq * 8), boff = lds_byte(wc * 32 + fr, fq * 8);
#define PG8_SA(b, h) (((b) * 2 + (h)) * HTB)
#define PG8_SB(b, h) ((4 + (b) * 2 + (h)) * HTB)
#define PG8_STAGE(bufoff, gbase, voff) do { _Pragma("unroll") for (int _i = 0; _i < 2; ++_i) \
        __builtin_amdgcn_global_load_lds((const unsigned*)((const char*)(gbase) + (voff)[_i]), (PG8_LAS unsigned*)(lds + (bufoff) + ldsw + _i * 8192), 16, 0, 0); } while (0)
#define PG8_LDA(dst, b, h) do { _Pragma("unroll") for (int m = 0; m < 4; ++m) _Pragma("unroll") for (int k = 0; k < 2; ++k) dst[m][k] = *(const PG8_LAS bf16x8*)(lds + PG8_SA(b, h) + aoff + m * 2048 + k * 1024); } while (0)
#define PG8_LDB(dst, b, h) do { _Pragma("unroll") for (int n = 0; n < 2; ++n) _Pragma("unroll") for (int k = 0; k < 2; ++k) dst[n][k] = *(const PG8_LAS bf16x8*)(lds + PG8_SB(b, h) + boff + n * 2048 + k * 1024); } while (0)
#define PG8_MMA(ai, bj, At, Bt) do { __builtin_amdgcn_s_setprio(1); _Pragma("unroll") for (int m = 0; m < 4; ++m) _Pragma("unroll") for (int n = 0; n < 2; ++n) _Pragma("unroll") for (int k = 0; k < 2; ++k) \
        acc[ai][bj][m][n] = __builtin_amdgcn_mfma_f32_16x16x32_bf16(Bt[n][k], At[m][k], acc[ai][bj][m][n], 0, 0, 0); __builtin_amdgcn_s_setprio(0); } while (0)
#define PG8_WAIT_V(n) asm volatile("s_waitcnt vmcnt(" #n ")" ::: "memory")
#define PG8_WAIT_L(n) asm volatile("s_waitcnt lgkmcnt(" #n ")" ::: "memory")
#define PG8_BAR __builtin_amdgcn_s_barrier()
#define PG8_SCHED __builtin_amdgcn_sched_barrier(0)
    Unit cur, nxt; int ui = 0;
    if (!S.next(0, cur)) return;
    f32x4 acc[2][2][4][2];
#pragma unroll
    for (int a = 0; a < 2; ++a)
#pragma unroll
        for (int b = 0; b < 2; ++b)
#pragma unroll
            for (int m = 0; m < 4; ++m)
#pragma unroll
                for (int n = 0; n < 2; ++n) acc[a][b][m][n] = (f32x4){0.f, 0.f, 0.f, 0.f};
    bf16x8 At[4][2], B0[2][2], B1[2][2];
    const char* cA = (const char*)g.A + (size_t)cur.pm * tstep; const char* cB = (const char*)g.Bt + (size_t)cur.pn * tstep;
    S.a_ready(cur);
    PG8_STAGE(PG8_SB(0, 0), cB, voffB); PG8_STAGE(PG8_SA(0, 0), cA, voffA); PG8_STAGE(PG8_SB(0, 1), cB + hstep, voffB); PG8_STAGE(PG8_SA(0, 1), cA + hstep, voffA);
    if (wr == 1) PG8_BAR;
    PG8_WAIT_V(4); PG8_BAR;
    PG8_STAGE(PG8_SB(1, 0), cB + kstep, voffB); PG8_STAGE(PG8_SA(1, 0), cA + kstep, voffA); PG8_STAGE(PG8_SB(1, 1), cB + hstep + kstep, voffB);
    PG8_WAIT_V(6); PG8_BAR;
    PG8_STAMP();
    for (;;) {
        const bool has_next = S.next(ui + 1, nxt);
        const char* nA = has_next ? (const char*)g.A + (size_t)nxt.pm * tstep : cA; const char* nB = has_next ? (const char*)g.Bt + (size_t)nxt.pn * tstep : cB;
        for (int t = 0; t < nt; t += 2) {
            const bool last = (t == nt - 2);
            const char* a1 = cA + (size_t)(t + 1) * kstep;
            const char* a2 = last ? nA : cA + (size_t)(t + 2) * kstep; const char* b2 = last ? nB : cB + (size_t)(t + 2) * kstep;
            const char* a3 = a2 + kstep; const char* b3 = b2 + kstep;
            if (last && has_next) S.a_ready(nxt);
            if constexpr (Epi::PREFETCH) { if (last) E.prefetch(cur, wid, lane); }
            PG8_LDB(B0, 0, 0); PG8_SCHED; PG8_LDA(At, 0, 0); PG8_STAGE(PG8_SA(1, 1), a1 + hstep, voffA);
            PG8_WAIT_L(8); PG8_BAR; PG8_WAIT_L(0); PG8_MMA(0, 0, At, B0); PG8_BAR; PG8_SCHED;
            PG8_LDB(B1, 0, 1); PG8_STAGE(PG8_SB(0, 0), b2, voffB);
            PG8_BAR; PG8_WAIT_L(0); PG8_MMA(0, 1, At, B1); PG8_BAR;
            PG8_LDA(At, 0, 1); PG8_STAGE(PG8_SA(0, 0), a2, voffA);
            PG8_BAR; PG8_WAIT_L(0); PG8_MMA(1, 0, At, B0); PG8_BAR; PG8_SCHED;
            PG8_STAGE(PG8_SB(0, 1), b2 + hstep, voffB);
            PG8_WAIT_V(6); PG8_BAR; PG8_MMA(1, 1, At, B1); PG8_BAR;
            PG8_LDB(B0, 1, 0); PG8_SCHED; PG8_LDA(At, 1, 0); PG8_STAGE(PG8_SA(0, 1), a2 + hstep, voffA);
            PG8_WAIT_L(8); PG8_BAR; PG8_WAIT_L(0); PG8_MMA(0, 0, At, B0); PG8_BAR; PG8_SCHED;
            PG8_LDB(B1, 1, 1); PG8_STAGE(PG8_SB(1, 0), b3, voffB);
            PG8_BAR; PG8_WAIT_L(0); PG8_MMA(0, 1, At, B1); PG8_BAR;
            PG8_LDA(At, 1, 1); PG8_STAGE(PG8_SA(1, 0), a3, voffA);
            PG8_BAR; PG8_WAIT_L(0); PG8_MMA(1, 0, At, B0); PG8_BAR; PG8_SCHED;
            PG8_STAGE(PG8_SB(1, 1), b3 + hstep, voffB);
            PG8_WAIT_V(6); PG8_BAR; PG8_MMA(1, 1, At, B1); PG8_BAR;
        }
        PG8_STAMP();
        if constexpr (!Epi::AFTER_DRAIN) { E(acc, cur, wr, wc, fr, fq); S.done(cur); }
        PG8_STAMP();
        if (!has_next) break;
#pragma unroll
        for (int a = 0; a < 2; ++a)
#pragma unroll
            for (int b = 0; b < 2; ++b)
#pragma unroll
                for (int m = 0; m < 4; ++m)
#pragma unroll
                    for (int n = 0; n < 2; ++n) acc[a][b][m][n] = (f32x4){0.f, 0.f, 0.f, 0.f};
        cur = nxt; cA = nA; cB = nB; ++ui;
    }
    PG8_WAIT_V(0);
    if (wr == 0) PG8_BAR;
    PG8_BAR;
    if constexpr (Epi::AFTER_DRAIN) { E.fused(acc, cur, wr, wc, fr, fq, lds, wid, lane); S.done(cur); }
    PG8_STAMP();
    if (STAMP && wid == 0) { stamps[lane] = lane < nts ? (((unsigned long long)(unsigned)ts_hi << 32) | (unsigned)ts_lo) : 0ull;
        if (lane == 62) stamps[62] = rt_entry; if (lane == 63) stamps[63] = (unsigned long long)wall_clock64(); }
#undef PG8_STAMP
#undef PG8_SA
#undef PG8_SB
#undef PG8_STAGE
#undef PG8_LDA
#undef PG8_LDB
#undef PG8_MMA
#undef PG8_WAIT_V
#undef PG8_WAIT_L
#undef PG8_BAR
#undef PG8_SCHED
}
}
using pg8::bf16_t; using pg8::f32x4; using pg8::u32x4; using pg8::Unit; using pg8::cvt_pk_bf16;
typedef unsigned u32x2 __attribute__((ext_vector_type(2)));
constexpr int D = 1024, TP = 16384, TS = 128, T = TP + TS, MP = 16640, NL = 4, CW = 512, NG = 32, NP = 64, DFF = 2816, SEQ = 2048, NB = 8, LC = 64, NCH = SEQ / LC;
constexpr float EPS = 1e-6f;
constexpr size_t O_YP = 0, O_YS = (size_t)TP * D, O_PC = O_YS + (size_t)TS * D, O_PRE = O_PC + (size_t)NL * NB * 2 * CW, O_PIM = O_PRE + (size_t)NL * NB * NG * NP,
                 O_SC = O_PIM + (size_t)NL * NB * NG * NP, O_SRE = O_SC + (size_t)NL * TS * 2 * CW, O_SIM = O_SRE + (size_t)NL * TS * NG * NP, O_END = O_SIM + (size_t)NL * TS * NG * NP;
constexpr size_t SZ_WIN = (size_t)4096 * 1024 * 2, SZ_WGLU = (size_t)512 * 512 * 2, SZ_WB = (size_t)1024 * 512 * 2, SZ_WOUT = (size_t)1024 * 1024 * 2, SZ_WGU = (size_t)5632 * 1024 * 2, SZ_WDN = (size_t)1024 * 2816 * 2;
constexpr size_t WS_WIN = 0, WS_WGLU = WS_WIN + NL * SZ_WIN, WS_WBA = WS_WGLU + NL * SZ_WGLU, WS_WBB = WS_WBA + NL * SZ_WB, WS_WOUT = WS_WBB + NL * SZ_WB, WS_WGU = WS_WOUT + NL * SZ_WOUT,
                 WS_WDN = WS_WGU + NL * SZ_WGU, WS_XB = WS_WDN + NL * SZ_WDN;
constexpr size_t SZ_H = (size_t)MP * 512 * 2, SZ_F = (size_t)MP * 1024 * 2;
constexpr size_t WS_ZB = WS_XB + SZ_F, WS_CV = WS_ZB + SZ_H, WS_U = WS_CV + SZ_H, WS_SGA = WS_U + SZ_H, WS_SGS = WS_SGA + SZ_F, WS_GY = WS_SGS + SZ_F, WS_YS2 = WS_GY + SZ_H, WS_ZEND = WS_YS2 + SZ_H;
constexpr size_t WS_FF = WS_ZB;
static_assert((size_t)MP * DFF * 2 <= WS_ZEND - WS_ZB, "F alias");
constexpr size_t WS_ROWSS = WS_ZEND, SZ_ROWSS = (size_t)MP * 4, WS_ABAR = WS_ROWSS + 9 * SZ_ROWSS, WS_APOW = WS_ABAR + (size_t)NL * NG * NP * 8, WS_BBAR = WS_APOW + (size_t)NL * NG * NP * 8,
                 WS_E = WS_BBAR + (size_t)NL * NG * NP * 32 * 4, WS_BBF = WS_E + (size_t)NB * NG * NCH * NP * 8, WS_CMF = WS_BBF + (size_t)NL * NG * 4 * 64 * 16, WS_END = WS_CMF + (size_t)NL * NG * 5 * 64 * 16;

__device__ __forceinline__ float bf_lo(unsigned w) { return __uint_as_float(w << 16); }
__device__ __forceinline__ float bf_hi(unsigned w) { return __uint_as_float(w & 0xffff0000u); }
__device__ __forceinline__ float sigm(float x) { return __builtin_amdgcn_rcpf(1.0f + __expf(-x)); }
__device__ __forceinline__ u32x4 pack8(const f32x4 a, const f32x4 b) { u32x4 w; w.x = cvt_pk_bf16(a[0], a[1]); w.y = cvt_pk_bf16(a[2], a[3]); w.z = cvt_pk_bf16(b[0], b[1]); w.w = cvt_pk_bf16(b[2], b[3]); return w; }
__device__ __forceinline__ void unpack8(const u32x4 w, f32x4& a, f32x4& b) { a = (f32x4){bf_lo(w.x), bf_hi(w.x), bf_lo(w.y), bf_hi(w.y)}; b = (f32x4){bf_lo(w.z), bf_hi(w.z), bf_lo(w.w), bf_hi(w.w)}; }

__device__ __forceinline__ float nr_rcp(float d) { float r = __uint_as_float(0x7EF311C7u - __float_as_uint(d)); r = r * fmaf(-d, r, 2.0f); r = r * fmaf(-d, r, 2.0f); return r; }
#define WT_FLAGS 0x00020000
__device__ __forceinline__ void wt16s(const __amdgpu_buffer_rsrc_t r, const void* base, const void* p, const u32x4 v) { __builtin_amdgcn_raw_buffer_store_b128(v, r, (unsigned)((const char*)p - (const char*)base), 0, 16); }
__device__ __forceinline__ void wt16(const __amdgpu_buffer_rsrc_t r, const void* base, const void* p, const u32x4 v) { (void)r; (void)base; *(u32x4*)p = v; }
#define EPI_FENCE asm volatile("" ::: "memory")
#define EPI_G(g) const int ai = (g) >> 2, m = (g) & 3, row = row0 + ai * 128 + m * 16
struct EpiIn {
    static constexpr bool PERM = true, AFTER_DRAIN = false, PREFETCH = true;
    unsigned char* ws; const float* rowss; PG8_LAS unsigned char* ldsx;
    __device__ __forceinline__ void prefetch(const Unit& u, int wid, int lane) const { const float* src = rowss + u.pm * 256 + (wid >> 2) * 64 + lane;
        __builtin_amdgcn_global_load_lds((const unsigned*)src, (PG8_LAS unsigned*)(ldsx + wid * 512), 4, 0, 0); __builtin_amdgcn_global_load_lds((const unsigned*)(src + 128), (PG8_LAS unsigned*)(ldsx + wid * 512 + 256), 4, 0, 0); }
    __device__ __forceinline__ void operator()(const f32x4 (&acc)[2][2][4][2], const Unit& u, int wr, int wc, int fr, int fq) const {
        bf16_t* const ZB = (bf16_t*)(ws + WS_ZB); bf16_t* const CV = (bf16_t*)(ws + WS_CV); bf16_t* const U = (bf16_t*)(ws + WS_U); bf16_t* const SGA = (bf16_t*)(ws + WS_SGA); bf16_t* const SGS = (bf16_t*)(ws + WS_SGS);
        const int row0 = u.pm * 256 + wr * 64 + fr, pn = u.pn, cw = wc * 32 + 8 * fq;
        const __amdgpu_buffer_rsrc_t rw = __builtin_amdgcn_make_buffer_rsrc(ws, 0, (int)WS_ZEND, WT_FLAGS);
        float rs[8];
#pragma unroll
        for (int g = 0; g < 8; ++g) { EPI_G(g); (void)row; rs[g] = *(const PG8_LAS float*)(ldsx + (wr * 4 + wc) * 512 + ai * 256 + (16 * m + fr) * 4); }
#pragma unroll
        for (int g = 0; g < 8; ++g) rs[g] = rsqrtf(rs[g] * (1.0f / 1024.0f) + EPS);
        if (pn >= 2 && pn < 6) {
            bf16_t* base = CV + (pn - 2) * 128 + cw;
#pragma unroll
            for (int g = 0; g < 8; ++g) { EPI_G(g); const float rs2 = rs[g] * rs[g];
                wt16(rw, ws, base + (size_t)row * 512, pack8(acc[ai][0][m][0] * acc[ai][1][m][0] * rs2, acc[ai][0][m][1] * acc[ai][1][m][1] * rs2)); }
        } else {
            bf16_t* base; int ldc; const bool sg = pn >= 8;
            if (pn < 2) { base = ZB + pn * 256; ldc = 512; } else if (pn < 8) { base = U + (pn - 6) * 256; ldc = 512; } else if (pn < 12) { base = SGA + (pn - 8) * 256; ldc = 1024; } else { base = SGS + (pn - 12) * 256; ldc = 1024; }
            base += cw;
#pragma unroll
            for (int g = 0; g < 8; ++g) { EPI_G(g);
#pragma unroll
                for (int bj = 0; bj < 2; ++bj) { f32x4 v0, v1;
                    if (sg) { const float rl = rs[g] * -1.4426950408889634f; const f32x4 e0 = acc[ai][bj][m][0] * rl, e1 = acc[ai][bj][m][1] * rl;
#pragma unroll
                        for (int j = 0; j < 4; ++j) { v0[j] = __builtin_amdgcn_rcpf(1.0f + __builtin_amdgcn_exp2f(e0[j])); v1[j] = __builtin_amdgcn_rcpf(1.0f + __builtin_amdgcn_exp2f(e1[j])); } }
                    else { v0 = acc[ai][bj][m][0] * rs[g]; v1 = acc[ai][bj][m][1] * rs[g]; }
                    wt16(rw, ws, base + (size_t)row * ldc + bj * 128, pack8(v0, v1)); } }
        }
    }
};
#ifndef PROBE
#define PROBE 0
#endif
struct EpiGU {
    static constexpr bool PERM = true, AFTER_DRAIN = false, PREFETCH = (PROBE != 24);
    unsigned char* ws; const float* rowss; PG8_LAS unsigned char* ldsx;
    __device__ __forceinline__ void prefetch(const Unit& u, int wid, int lane) const { const float* src = rowss + u.pm * 256 + (wid >> 2) * 64 + lane;
        __builtin_amdgcn_global_load_lds((const unsigned*)src, (PG8_LAS unsigned*)(ldsx + wid * 512), 4, 0, 0); __builtin_amdgcn_global_load_lds((const unsigned*)(src + 128), (PG8_LAS unsigned*)(ldsx + wid * 512 + 256), 4, 0, 0); }
    __device__ __forceinline__ void operator()(const f32x4 (&acc)[2][2][4][2], const Unit& u, int wr, int wc, int fr, int fq) const {
        const int row0 = u.pm * 256 + wr * 64 + fr; bf16_t* base = (bf16_t*)(ws + WS_FF) + u.pn * 128 + wc * 32 + 8 * fq;
        const __amdgpu_buffer_rsrc_t rw = __builtin_amdgcn_make_buffer_rsrc(ws, 0, (int)WS_ZEND, WT_FLAGS);
        float rs[8];
#pragma unroll
        for (int g = 0; g < 8; ++g) { EPI_G(g); rs[g] = PREFETCH ? *(const PG8_LAS float*)(ldsx + (wr * 4 + wc) * 512 + ai * 256 + (16 * m + fr) * 4) : rowss[row]; }
        EPI_FENCE;
#pragma unroll
        for (int g = 0; g < 8; ++g) { EPI_G(g); const float r = rsqrtf(rs[g] * (1.0f / 1024.0f) + EPS), r2 = r * r, rl = r * -1.4426950408889634f; f32x4 o[2];
#pragma unroll
            for (int n = 0; n < 2; ++n) { const f32x4 t = acc[ai][0][m][n] * acc[ai][1][m][n] * r2, xe = acc[ai][0][m][n] * rl;
#pragma unroll
                for (int j = 0; j < 4; ++j) o[n][j] = t[j] * __builtin_amdgcn_rcpf(1.0f + __builtin_amdgcn_exp2f(xe[j])); }
            wt16(rw, ws, base + (size_t)row * DFF, pack8(o[0], o[1])); }
    }
};
struct EpiGlu {
    static constexpr bool PERM = true, AFTER_DRAIN = false, PREFETCH = false;
    unsigned char* ws; const float* bias;
    __device__ __forceinline__ void operator()(const f32x4 (&acc)[2][2][4][2], const Unit& u, int wr, int wc, int fr, int fq) const {
        const bf16_t* const GY = (const bf16_t*)(ws + WS_GY); bf16_t* const YS2 = (bf16_t*)(ws + WS_YS2);
        const int row0 = u.pm * 256 + wr * 64 + fr, col0 = u.pn * 256 + wc * 32 + 8 * fq;
        const __amdgpu_buffer_rsrc_t rw = __builtin_amdgcn_make_buffer_rsrc(ws, 0, (int)WS_ZEND, WT_FLAGS);
        f32x4 bv[2][2];
#pragma unroll
        for (int bj = 0; bj < 2; ++bj) { bv[bj][0] = *(const f32x4*)(bias + col0 + bj * 128); bv[bj][1] = *(const f32x4*)(bias + col0 + bj * 128 + 4); }
        u32x4 buf[4][2];
#define GLU_LOAD(g) { EPI_G(g); (void)ai; (void)m; buf[(g) & 3][0] = *(const u32x4*)(GY + (size_t)row * 512 + col0); buf[(g) & 3][1] = *(const u32x4*)(GY + (size_t)row * 512 + col0 + 128); }
        GLU_LOAD(0) GLU_LOAD(1) GLU_LOAD(2)
#pragma unroll
        for (int g = 0; g < 8; ++g) { if (g + 3 < 8) GLU_LOAD(g + 3)
            EPI_FENCE; EPI_G(g);
#pragma unroll
            for (int bj = 0; bj < 2; ++bj) { f32x4 g0, g1; unpack8(buf[g & 3][bj], g0, g1); f32x4 v0 = acc[ai][bj][m][0] + bv[bj][0], v1 = acc[ai][bj][m][1] + bv[bj][1];
#pragma unroll
                for (int j = 0; j < 4; ++j) { v0[j] = g0[j] * sigm(v0[j]); v1[j] = g1[j] * sigm(v1[j]); }
                wt16(rw, ws, YS2 + (size_t)row * 512 + col0 + bj * 128, pack8(v0, v1)); } }
#undef GLU_LOAD
    }
};
template <bool SECOND> struct EpiBr {
    static constexpr bool PERM = true, AFTER_DRAIN = false, PREFETCH = false;
    unsigned char* ws;
    __device__ __forceinline__ void operator()(const f32x4 (&acc)[2][2][4][2], const Unit& u, int wr, int wc, int fr, int fq) const {
        bf16_t* const SGA = (bf16_t*)(ws + WS_SGA); bf16_t* const SGS = (bf16_t*)(ws + WS_SGS);
        const int row0 = u.pm * 256 + wr * 64 + fr, col0 = u.pn * 256 + wc * 32 + 8 * fq;
        const __amdgpu_buffer_rsrc_t rw = __builtin_amdgcn_make_buffer_rsrc(ws, 0, (int)WS_ZEND, WT_FLAGS);
        constexpr int DP = SECOND ? 3 : 4;
        u32x4 sb[DP][2], tb[SECOND ? DP : 1][2];
#define BR_LOAD(g) { EPI_G(g); (void)ai; (void)m; const size_t off = (size_t)row * 1024 + col0; sb[(g) % DP][0] = *(const u32x4*)((SECOND ? SGS : SGA) + off); sb[(g) % DP][1] = *(const u32x4*)((SECOND ? SGS : SGA) + off + 128); \
            if (SECOND) { tb[(g) % DP][0] = *(const u32x4*)(SGA + off); tb[(g) % DP][1] = *(const u32x4*)(SGA + off + 128); } }
        BR_LOAD(0) BR_LOAD(1) if (DP > 3) BR_LOAD(2)
#pragma unroll
        for (int g = 0; g < 8; ++g) { if (g + DP - 1 < 8) BR_LOAD(g + DP - 1)
            EPI_FENCE; EPI_G(g);
#pragma unroll
            for (int bj = 0; bj < 2; ++bj) { const size_t off = (size_t)row * 1024 + col0 + bj * 128; f32x4 s0, s1; unpack8(sb[g % DP][bj], s0, s1);
                if (!SECOND) wt16(rw, ws, SGA + off, pack8(s0 * acc[ai][bj][m][0], s1 * acc[ai][bj][m][1]));
                else { f32x4 t0, t1; unpack8(tb[g % DP][bj], t0, t1); wt16(rw, ws, SGS + off, pack8(t0 + s0 * acc[ai][bj][m][0], t1 + s1 * acc[ai][bj][m][1])); } } }
#undef BR_LOAD
    }
};
struct EpiRes {
    static constexpr bool PERM = true, AFTER_DRAIN = false, PREFETCH = false;
    float* X; unsigned char* ws; float* rowss_out;
    __device__ __forceinline__ void operator()(const f32x4 (&acc)[2][2][4][2], const Unit& u, int wr, int wc, int fr, int fq) const {
        const int row0 = u.pm * 256 + wr * 64 + fr, col0 = u.pn * 256 + wc * 32 + 8 * fq; bf16_t* const XB = (bf16_t*)(ws + WS_XB);
        const __amdgpu_buffer_rsrc_t rw = __builtin_amdgcn_make_buffer_rsrc(ws, 0, (int)WS_ZEND, WT_FLAGS), ro = __builtin_amdgcn_make_buffer_rsrc(X, 0, (int)((size_t)T * D * 4), WT_FLAGS);
        f32x4 xb[3][2][2];
#define RES_LOAD(g) { EPI_G(g); (void)ai; (void)m; const size_t off = (size_t)row * 1024 + col0; xb[(g) % 3][0][0] = *(const f32x4*)(X + off); xb[(g) % 3][0][1] = *(const f32x4*)(X + off + 4); \
            xb[(g) % 3][1][0] = *(const f32x4*)(X + off + 128); xb[(g) % 3][1][1] = *(const f32x4*)(X + off + 132); }
        RES_LOAD(0) RES_LOAD(1)
#pragma unroll
        for (int g = 0; g < 8; ++g) { if (g + 2 < 8) RES_LOAD(g + 2)
            EPI_FENCE; EPI_G(g); float ss = 0.f;
#pragma unroll
            for (int bj = 0; bj < 2; ++bj) { const size_t off = (size_t)row * 1024 + col0 + bj * 128;
                const f32x4 x0 = xb[g % 3][bj][0] + acc[ai][bj][m][0], x1 = xb[g % 3][bj][1] + acc[ai][bj][m][1];
                wt16(ro, X, X + off, __builtin_bit_cast(u32x4, x0)); wt16(ro, X, X + off + 4, __builtin_bit_cast(u32x4, x1)); wt16(rw, ws, XB + off, pack8(x0, x1));
                ss += (x0[0] * x0[0] + x0[1] * x0[1]) + (x0[2] * x0[2] + x0[3] * x0[3]) + (x1[0] * x1[0] + x1[1] * x1[1]) + (x1[2] * x1[2] + x1[3] * x1[3]); }
            ss += __shfl_xor(ss, 16); ss += __shfl_xor(ss, 32);
            if (fq == 0) atomicAdd(rowss_out + row, ss); }
#undef RES_LOAD
    }
};
template <bool PAIRED, int NTB, class F> __device__ __forceinline__ void skinny_unit(PG8_LAS unsigned char* lds, const bf16_t* Act, const bf16_t* Bt, int K, int n0, int n1, int tok0, int tid, const F& epi) {
    const int lane = tid & 63, w = __builtin_amdgcn_readfirstlane(tid >> 6), r16 = lane & 15, q = lane >> 4, ks = K >> 3;
    const bf16_t* wp0 = Bt + (size_t)(n0 + r16) * K + w * ks + 8 * q;
    const bf16_t* wp1 = Bt + (size_t)(n1 + r16) * K + w * ks + 8 * q;
    const bf16_t* ap = Act + (size_t)(tok0 + r16) * K + w * ks + 8 * q;
    f32x4 acc0[NTB], acc1[NTB];
#pragma unroll
    for (int tb = 0; tb < NTB; ++tb) { acc0[tb] = (f32x4){0.f, 0.f, 0.f, 0.f}; acc1[tb] = acc0[tb]; }
#pragma unroll (NTB > 4 ? 2 : 6)
    for (int k0 = 0; k0 < ks; k0 += 32) {
        const pg8::bf16x8 wf0 = __builtin_bit_cast(pg8::bf16x8, *(const u32x4*)(wp0 + k0));
        pg8::bf16x8 wf1 = wf0; if (PAIRED) wf1 = __builtin_bit_cast(pg8::bf16x8, *(const u32x4*)(wp1 + k0));
        pg8::bf16x8 af[NTB];
#pragma unroll
        for (int tb = 0; tb < NTB; ++tb) af[tb] = __builtin_bit_cast(pg8::bf16x8, *(const u32x4*)(ap + (size_t)(tb * 16) * K + k0));
#pragma unroll
        for (int tb = 0; tb < NTB; ++tb) { acc0[tb] = __builtin_amdgcn_mfma_f32_16x16x32_bf16(wf0, af[tb], acc0[tb], 0, 0, 0);
            if (PAIRED) acc1[tb] = __builtin_amdgcn_mfma_f32_16x16x32_bf16(wf1, af[tb], acc1[tb], 0, 0, 0); }
    }
    __syncthreads();
#pragma unroll
    for (int tb = 0; tb < NTB; ++tb) { *(PG8_LAS f32x4*)(lds + ((w * NTB + tb) * 64 + lane) * 16) = acc0[tb]; if (PAIRED) *(PG8_LAS f32x4*)(lds + 65536 + ((w * NTB + tb) * 64 + lane) * 16) = acc1[tb]; }
    __syncthreads();
    if (w < NTB) {
        f32x4 s0 = (f32x4){0.f, 0.f, 0.f, 0.f}, s1 = s0;
#pragma unroll
        for (int ww = 0; ww < 8; ++ww) { s0 += *(const PG8_LAS f32x4*)(lds + ((ww * NTB + w) * 64 + lane) * 16); if (PAIRED) s1 += *(const PG8_LAS f32x4*)(lds + 65536 + ((ww * NTB + w) * 64 + lane) * 16); }
        epi(s0, s1, TP + tok0 + 16 * w + r16, 4 * q);
    }
}
__device__ __forceinline__ u32x2 pack4(const f32x4 v) { u32x2 w; w.x = cvt_pk_bf16(v[0], v[1]); w.y = cvt_pk_bf16(v[2], v[3]); return w; }
__device__ __forceinline__ f32x4 unpack4(const u32x2 w) { return (f32x4){bf_lo(w.x), bf_hi(w.x), bf_lo(w.y), bf_hi(w.y)}; }

struct EpiNull {
    static constexpr bool PERM = true, AFTER_DRAIN = false, PREFETCH = false;
    float* sink;
    __device__ __forceinline__ void operator()(const f32x4 (&acc)[2][2][4][2], const Unit& u, int wr, int wc, int fr, int fq) const {
        if (acc[0][0][0][0][0] == 1.2345e-33f) *sink = 1.f;
    }
};

template <int MODE> struct EpiProbe {
    static constexpr bool PERM = true, AFTER_DRAIN = false, PREFETCH = false;
    unsigned char* ws; float* sink;
    __device__ __forceinline__ void operator()(const f32x4 (&acc)[2][2][4][2], const Unit& u, int wr, int wc, int fr, int fq) const {
        const int row0 = u.pm * 256 + wr * 64 + fr; bf16_t* base = (bf16_t*)(ws + WS_FF) + u.pn * 128 + wc * 32 + 8 * fq;
        if (MODE == 0) {
#pragma unroll
            for (int g = 0; g < 8; ++g) { EPI_G(g); *(u32x4*)(base + (size_t)row * DFF) = pack8(acc[ai][0][m][0] + acc[ai][1][m][0], acc[ai][0][m][1] + acc[ai][1][m][1]); }
        } else {
            f32x4 s = (f32x4){0.f, 0.f, 0.f, 0.f};
#pragma unroll
            for (int g = 0; g < 8; ++g) { EPI_G(g); (void)row; s += acc[ai][0][m][0] + acc[ai][1][m][0] + acc[ai][0][m][1] + acc[ai][1][m][1]; }
            if (s[0] + s[1] + s[2] + s[3] == 1.2345e-33f) *sink = 1.f;
        }
    }
};
__device__ __forceinline__ int otid() { int t = threadIdx.x; asm volatile("" : "+v"(t)); return t; }
struct Args { const float* in[25]; float* out; unsigned char* ws; int ph_lo, ph_hi; };
enum { I_XP = 0, I_XS, I_SCONV, I_SRE, I_SIM, I_N1G, I_WIN, I_CONVW, I_CONVB, I_LRE, I_LIM, I_LDT, I_BRE, I_BIM, I_CRE, I_CIM, I_SD, I_WGLU, I_BGLU, I_WBR, I_WOUT, I_N2G, I_WGU, I_WDN, I_FG };

__device__ __forceinline__ int perm_in(int n0) { if (n0 < 512 || n0 >= 1536) return n0; const int q = n0 - 512, tl = q >> 8, rr = q & 255; return rr < 128 ? 512 + tl * 128 + rr : 1024 + tl * 128 + (rr - 128); }
__device__ __forceinline__ int perm_gu(int n0) { const int tl = n0 >> 8, rr = n0 & 255; return rr < 128 ? tl * 128 + rr : DFF + tl * 128 + (rr - 128); }

constexpr int P0_PER = 256 + 16 + 32 + 32 + 64 + 352 + 176;
__device__ __forceinline__ void p0_weights(const Args& a, float* tile, int it_lo, int it_hi, int vb, int nvb) {
    constexpr int PER = P0_PER, TP_ = 260;
    unsigned char* ws = a.ws; const int tid = otid(); const __amdgpu_buffer_rsrc_t rwp = __builtin_amdgcn_make_buffer_rsrc(ws, 0, (int)WS_ZEND, WT_FLAGS);
    for (int it = it_lo + vb; it < it_hi; it += nvb) {
        const int l = it / PER; int r = it % PER;
        const float* src; const float* gs = nullptr; bf16_t* dst; int ldn, K, n0, k0, sn0, sn1;
        if (r < 256) { n0 = (r >> 4) * 256; k0 = (r & 15) * 64; src = a.in[I_WIN] + (size_t)l * 1024 * 4096; ldn = 4096; K = 1024; dst = (bf16_t*)(ws + WS_WIN + l * SZ_WIN); gs = a.in[I_N1G] + l * 1024; sn0 = perm_in(n0); sn1 = perm_in(n0 + 128); }
        else if ((r -= 256) < 16) { n0 = (r >> 3) * 256; k0 = (r & 7) * 64; src = a.in[I_WGLU] + (size_t)l * 512 * 512; ldn = 512; K = 512; dst = (bf16_t*)(ws + WS_WGLU + l * SZ_WGLU); sn0 = n0; sn1 = n0 + 128; }
        else if ((r -= 16) < 32) { n0 = (r >> 3) * 256; k0 = (r & 7) * 64; src = a.in[I_WBR] + (size_t)l * 1024 * 1024; ldn = 1024; K = 512; dst = (bf16_t*)(ws + WS_WBA + l * SZ_WB); sn0 = n0; sn1 = n0 + 128; }
        else if ((r -= 32) < 32) { n0 = (r >> 3) * 256; k0 = (r & 7) * 64; src = a.in[I_WBR] + (size_t)l * 1024 * 1024 + (size_t)512 * 1024; ldn = 1024; K = 512; dst = (bf16_t*)(ws + WS_WBB + l * SZ_WB); sn0 = n0; sn1 = n0 + 128; }
        else if ((r -= 32) < 64) { n0 = (r >> 4) * 256; k0 = (r & 15) * 64; src = a.in[I_WOUT] + (size_t)l * 1024 * 1024; ldn = 1024; K = 1024; dst = (bf16_t*)(ws + WS_WOUT + l * SZ_WOUT); sn0 = n0; sn1 = n0 + 128; }
        else if ((r -= 64) < 352) { n0 = (r >> 4) * 256; k0 = (r & 15) * 64; src = a.in[I_WGU] + (size_t)l * 1024 * 5632; ldn = 5632; K = 1024; dst = (bf16_t*)(ws + WS_WGU + l * SZ_WGU); gs = a.in[I_N2G] + l * 1024; sn0 = perm_gu(n0); sn1 = perm_gu(n0 + 128); }
        else { r -= 352; n0 = (r / 44) * 256; k0 = (r % 44) * 64; src = a.in[I_WDN] + (size_t)l * DFF * 1024; ldn = 1024; K = DFF; dst = (bf16_t*)(ws + WS_WDN + l * SZ_WDN); sn0 = n0; sn1 = n0 + 128; }
        f32x4 v[8];
#pragma unroll
        for (int j = 0; j < 8; ++j) { const int idx = tid + 512 * j, k = idx >> 6, n = (idx & 63) * 4; v[j] = *(const f32x4*)(src + (size_t)(k0 + k) * ldn + (n < 128 ? sn0 + n : sn1 + n - 128)); }
        __syncthreads();
#pragma unroll
        for (int j = 0; j < 8; ++j) { const int idx = tid + 512 * j, k = idx >> 6, n = (idx & 63) * 4; f32x4 x = v[j]; if (gs) x *= gs[k0 + k]; *(f32x4*)(tile + k * TP_ + n) = x; }
        __syncthreads();
#pragma unroll
        for (int j = 0; j < 4; ++j) { const int idx = tid + 512 * j, n = idx & 255, kg = idx >> 8; const float* tp = tile + (8 * kg) * TP_ + n; u32x4 w;
            w.x = cvt_pk_bf16(tp[0], tp[TP_]); w.y = cvt_pk_bf16(tp[2 * TP_], tp[3 * TP_]); w.z = cvt_pk_bf16(tp[4 * TP_], tp[5 * TP_]); w.w = cvt_pk_bf16(tp[6 * TP_], tp[7 * TP_]);
            wt16(rwp, ws, dst + (size_t)(n0 + n) * K + k0 + 8 * kg, w); }
    }
}
__device__ __forceinline__ void p0_ssm(const Args& a) {
    float* ABAR = (float*)(a.ws + WS_ABAR); float* APOW = (float*)(a.ws + WS_APOW); float* BBAR = (float*)(a.ws + WS_BBAR); u32x4* BBF = (u32x4*)(a.ws + WS_BBF); const int tx0_ = otid();
    for (int i = blockIdx.x * 512 + tx0_; i < NL * NG * NP; i += gridDim.x * 512) {
        const int lg = i >> 6;
        const float dt = expf(a.in[I_LDT][lg]), lr = a.in[I_LRE][i], li = a.in[I_LIM][i];
        const float mag = expf(lr * dt), ang = li * dt; float sn, cs; sincosf(ang, &sn, &cs);
        const float ar = mag * cs, ai = mag * sn, nr = ar - 1.0f, ni = ai, den = lr * lr + li * li, fr = (nr * lr + ni * li) / den, fi = (ni * lr - nr * li) / den;
        ABAR[2 * i] = ar; ABAR[2 * i + 1] = ai;
        float pr = ar, pi = ai;
#pragma unroll
        for (int s = 0; s < 6; ++s) { const float tr = pr * pr - pi * pi, ti = 2.0f * pr * pi; pr = tr; pi = ti; }
        APOW[2 * i] = pr; APOW[2 * i + 1] = pi;
        float bbr[16], bbi[16];
#pragma unroll
        for (int c = 0; c < 16; ++c) { const float br = a.in[I_BRE][(size_t)i * 16 + c], bi = a.in[I_BIM][(size_t)i * 16 + c]; bbr[c] = fr * br - fi * bi; bbi[c] = fr * bi + fi * br; BBAR[((size_t)lg * 32 + c) * NP + (i & 63)] = bbr[c]; BBAR[((size_t)lg * 32 + 16 + c) * NP + (i & 63)] = bbi[c]; }
        const int p = i & 63, sh = p >> 5, n = p & 31;
#pragma unroll
        for (int h = 0; h < 2; ++h) {
            u32x4 wr_, wi_; wr_.x = cvt_pk_bf16(bbr[8 * h], bbr[8 * h + 1]); wr_.y = cvt_pk_bf16(bbr[8 * h + 2], bbr[8 * h + 3]); wr_.z = cvt_pk_bf16(bbr[8 * h + 4], bbr[8 * h + 5]); wr_.w = cvt_pk_bf16(bbr[8 * h + 6], bbr[8 * h + 7]);
            wi_.x = cvt_pk_bf16(bbi[8 * h], bbi[8 * h + 1]); wi_.y = cvt_pk_bf16(bbi[8 * h + 2], bbi[8 * h + 3]); wi_.z = cvt_pk_bf16(bbi[8 * h + 4], bbi[8 * h + 5]); wi_.w = cvt_pk_bf16(bbi[8 * h + 6], bbi[8 * h + 7]);
            BBF[((size_t)lg * 4 + 2 * sh) * 64 + 32 * h + n] = wr_; BBF[((size_t)lg * 4 + 2 * sh + 1) * 64 + 32 * h + n] = wi_; }
    }
    u32x4* CMF = (u32x4*)(a.ws + WS_CMF);
    for (int i = blockIdx.x * 512 + tx0_; i < NL * NG * 5 * 64; i += gridDim.x * 512) {
        const int lane = i & 63, ks = (i >> 6) % 5, lg = i / 320, ch = lane & 15, q = lane >> 4; float v[8];
#pragma unroll
        for (int j = 0; j < 8; ++j) {
            if (ks < 4) { const int k = 32 * ks + 8 * q + j, sh = k >> 6, kk = k & 63, p = sh * 32 + (kk >> 1); const size_t ci = ((size_t)lg * 16 + ch) * NP + p; v[j] = (kk & 1) ? -a.in[I_CIM][ci] : a.in[I_CRE][ci]; }
            else v[j] = (8 * q + j == ch) ? a.in[I_SD][(size_t)lg * 16 + ch] : 0.f; }
        u32x4 w; w.x = cvt_pk_bf16(v[0], v[1]); w.y = cvt_pk_bf16(v[2], v[3]); w.z = cvt_pk_bf16(v[4], v[5]); w.w = cvt_pk_bf16(v[6], v[7]); CMF[i] = w;
    }
}
__device__ __forceinline__ void p0_x(const Args& a) {
    float* X = a.out; bf16_t* XB = (bf16_t*)(a.ws + WS_XB); float* RS = (float*)(a.ws + WS_ROWSS);
    int tx_ = threadIdx.x; asm volatile("" : "+v"(tx_)); const int lane = tx_ & 63, gw = blockIdx.x * 8 + (tx_ >> 6), nw = gridDim.x * 8;
    for (int i = blockIdx.x * 512 + tx_; i < 9 * MP; i += gridDim.x * 512) if (i >= T) RS[i] = 0.f;
    for (int r0 = gw; r0 < T; r0 += 2 * nw) {
        f32x4 v[2][4];
#pragma unroll
        for (int k = 0; k < 2; ++k) { const int row = r0 + k * nw; if (row < T) { const float* src = row < TP ? a.in[I_XP] + (size_t)row * D : a.in[I_XS] + (size_t)(row - TP) * D;
#pragma unroll
            for (int j = 0; j < 2; ++j) { const int c = j * 512 + lane * 8; v[k][2 * j] = *(const f32x4*)(src + c); v[k][2 * j + 1] = *(const f32x4*)(src + c + 4); } } }
#pragma unroll
        for (int k = 0; k < 2; ++k) { const int row = r0 + k * nw; if (row < T) { float ss = 0.f;
#pragma unroll
            for (int j = 0; j < 2; ++j) { const int c = j * 512 + lane * 8; const f32x4 v0 = v[k][2 * j], v1 = v[k][2 * j + 1];
                *(f32x4*)(X + (size_t)row * D + c) = v0; *(f32x4*)(X + (size_t)row * D + c + 4) = v1; *(u32x4*)(XB + (size_t)row * D + c) = pack8(v0, v1);
                ss += (v0[0] * v0[0] + v0[1] * v0[1]) + (v0[2] * v0[2] + v0[3] * v0[3]) + (v1[0] * v1[0] + v1[1] * v1[1]) + (v1[2] * v1[2] + v1[3] * v1[3]); }
#pragma unroll
            for (int o = 32; o >= 1; o >>= 1) ss += __shfl_xor(ss, o);
            if (lane == 0) RS[row] = ss; } }
    }
}
__device__ __forceinline__ void final_norm(const Args& a) {
    float* X = a.out; const float* RS = (const float*)(a.ws + WS_ROWSS) + 8 * (size_t)MP; const float* g = a.in[I_FG];
    int tx_ = threadIdx.x; asm volatile("" : "+v"(tx_)); const int lane = tx_ & 63, gw = blockIdx.x * 8 + (tx_ >> 6), nw = gridDim.x * 8;
    f32x4 gg[4];
#pragma unroll
    for (int j = 0; j < 4; ++j) gg[j] = *(const f32x4*)(g + j * 256 + lane * 4);
    for (int r0 = gw; r0 < T; r0 += 2 * nw) {
        f32x4 v[2][4]; float rsv[2];
#pragma unroll
        for (int k = 0; k < 2; ++k) { const int row = r0 + k * nw; if (row < T) { rsv[k] = RS[row];
#pragma unroll
            for (int j = 0; j < 4; ++j) v[k][j] = *(const f32x4*)(X + (size_t)row * D + j * 256 + lane * 4); } }
#pragma unroll
        for (int k = 0; k < 2; ++k) { const int row = r0 + k * nw; if (row < T) { const float rs = rsqrtf(rsv[k] * (1.0f / 1024.0f) + EPS);
#pragma unroll
            for (int j = 0; j < 4; ++j) *(f32x4*)(X + (size_t)row * D + j * 256 + lane * 4) = v[k][j] * rs * gg[j]; } }
    }
}
__device__ __forceinline__ void conv_phase(const Args& a, int l) {
    bf16_t* ZB = (bf16_t*)(a.ws + WS_ZB); const bf16_t* CV = (const bf16_t*)(a.ws + WS_CV);
    const float* cw = a.in[I_CONVW] + (size_t)l * 3 * CW; const float* cb = a.in[I_CONVB] + (size_t)l * CW; const float* sc = a.in[I_SCONV] + (size_t)l * TS * 2 * CW;
    const int txc_ = otid(); const int c8 = (txc_ & 63) * 8; const __amdgpu_buffer_rsrc_t rwc = __builtin_amdgcn_make_buffer_rsrc(a.ws, 0, (int)WS_ZEND, WT_FLAGS);
    const f32x4 w0a = *(const f32x4*)(cw + c8), w0b = *(const f32x4*)(cw + c8 + 4), w1a = *(const f32x4*)(cw + CW + c8), w1b = *(const f32x4*)(cw + CW + c8 + 4),
                w2a = *(const f32x4*)(cw + 2 * CW + c8), w2b = *(const f32x4*)(cw + 2 * CW + c8 + 4), ba = *(const f32x4*)(cb + c8), bb = *(const f32x4*)(cb + c8 + 4);
    const f32x4 zero = (f32x4){0.f, 0.f, 0.f, 0.f};
    for (int r0 = blockIdx.x * 8 + (txc_ >> 6); r0 < T; r0 += gridDim.x * 32) {
        u32x4 zr[4], x0r[4], x1r[4], x2r[4]; f32x4 s1a[4], s1b[4], s2a[4], s2b[4];
#pragma unroll
        for (int k = 0; k < 4; ++k) { const int row = r0 + k * gridDim.x * 8; if (row < T) { const size_t off = (size_t)row * 512 + c8;
            zr[k] = *(const u32x4*)(ZB + off); x0r[k] = *(const u32x4*)(CV + off);
            if (row < TP) { const int t = row & (SEQ - 1); x1r[k] = (u32x4){0u, 0u, 0u, 0u}; x2r[k] = x1r[k]; if (t >= 1) x1r[k] = *(const u32x4*)(CV + off - 512); if (t >= 2) x2r[k] = *(const u32x4*)(CV + off - 1024); }
            else { const float* s0 = sc + (size_t)(row - TP) * 2 * CW + c8; s2a[k] = *(const f32x4*)s0; s2b[k] = *(const f32x4*)(s0 + 4); s1a[k] = *(const f32x4*)(s0 + CW); s1b[k] = *(const f32x4*)(s0 + CW + 4); } } }
        asm volatile("" ::: "memory");
#pragma unroll
        for (int k = 0; k < 4; ++k) { const int row = r0 + k * gridDim.x * 8; if (row < T) { const size_t off = (size_t)row * 512 + c8;
            f32x4 z0, z1, x0a, x0b, x1a, x1b, x2a, x2b; unpack8(zr[k], z0, z1); unpack8(x0r[k], x0a, x0b);
            if (row < TP) { const int t = row & (SEQ - 1); unpack8(x1r[k], x1a, x1b); unpack8(x2r[k], x2a, x2b);
                if (t >= SEQ - 2) { float* o = a.out + O_PC + ((size_t)(l * NB + (row >> 11)) * 2 + (t - (SEQ - 2))) * CW + c8; *(f32x4*)o = x0a; *(f32x4*)(o + 4) = x0b; } }
            else { const int b = row - TP; x1a = s1a[k]; x1b = s1b[k]; x2a = s2a[k]; x2b = s2b[k];
                float* o = a.out + O_SC + (size_t)(l * TS + b) * 2 * CW + c8; *(f32x4*)o = x1a; *(f32x4*)(o + 4) = x1b; *(f32x4*)(o + CW) = x0a; *(f32x4*)(o + CW + 4) = x0b; }
            const f32x4 oa = z0 * (ba + w0a * x2a + w1a * x1a + w2a * x0a), ob = z1 * (bb + w0b * x2b + w1b * x1b + w2b * x0b);
            wt16(rwc, a.ws, ZB + off, pack8(oa, ob)); } }
    }
}
struct SsmW { float ar, ai; float bbr[16], bbi[16]; };
template <bool OUT> __device__ __forceinline__ void ssm_run(const bf16_t* U, bf16_t* GY, int row0, int ntok, int g, float& hr, float& hi, const float ar, const float ai,
                                                            const float (&bbr)[16], const float (&bbi)[16], const float (&cr)[16], const float (&ci)[16], const float (&dl)[16], int lane) {
    for (int t0 = 0; t0 < ntok; t0 += 64) {
        const int nt = (ntok - t0) < 64 ? (ntok - t0) : 64;
        u32x4 w0 = (u32x4){0u, 0u, 0u, 0u}, w1 = w0;
        if (lane < nt) { const u32x4* up = (const u32x4*)(U + (size_t)(row0 + t0 + lane) * 512 + g * 16); w0 = up[0]; w1 = up[1]; }
        for (int j = 0; j < nt; ++j) {
            unsigned ws_[8]; ws_[0] = __builtin_amdgcn_readlane(w0.x, j); ws_[1] = __builtin_amdgcn_readlane(w0.y, j); ws_[2] = __builtin_amdgcn_readlane(w0.z, j); ws_[3] = __builtin_amdgcn_readlane(w0.w, j);
            ws_[4] = __builtin_amdgcn_readlane(w1.x, j); ws_[5] = __builtin_amdgcn_readlane(w1.y, j); ws_[6] = __builtin_amdgcn_readlane(w1.z, j); ws_[7] = __builtin_amdgcn_readlane(w1.w, j);
            float uu[16];
#pragma unroll
            for (int q = 0; q < 8; ++q) { uu[2 * q] = bf_lo(ws_[q]); uu[2 * q + 1] = bf_hi(ws_[q]); }
            float bur = 0.f, bui = 0.f;
#pragma unroll
            for (int c = 0; c < 16; ++c) { bur = fmaf(bbr[c], uu[c], bur); bui = fmaf(bbi[c], uu[c], bui); }
            const float nhr = ar * hr - ai * hi + bur, nhi = ar * hi + ai * hr + bui; hr = nhr; hi = nhi;
            if (OUT) {
                float v[16];
#pragma unroll
                for (int c = 0; c < 16; ++c) v[c] = fmaf(dl[c], uu[c], cr[c] * hr - ci[c] * hi);
                float w8[8], w4[4], w2[2], w1_;
                { const bool up = lane & 32;
#pragma unroll
                  for (int k = 0; k < 8; ++k) { const float send = up ? v[k] : v[k + 8], keep = up ? v[k + 8] : v[k]; w8[k] = keep + __shfl_xor(send, 32); } }
                { const bool up = lane & 16;
#pragma unroll
                  for (int k = 0; k < 4; ++k) { const float send = up ? w8[k] : w8[k + 4], keep = up ? w8[k + 4] : w8[k]; w4[k] = keep + __shfl_xor(send, 16); } }
                { const bool up = lane & 8;
#pragma unroll
                  for (int k = 0; k < 2; ++k) { const float send = up ? w4[k] : w4[k + 2], keep = up ? w4[k + 2] : w4[k]; w2[k] = keep + __shfl_xor(send, 8); } }
                { const bool up = lane & 4; const float send = up ? w2[0] : w2[1], keep = up ? w2[1] : w2[0]; w1_ = keep + __shfl_xor(send, 4); }
                w1_ += __shfl_xor(w1_, 2); w1_ += __shfl_xor(w1_, 1);
                const float gy = 0.5f * w1_ * (1.0f + erff(w1_ * 0.70710678118f));
                if ((lane & 3) == 0) GY[(size_t)(row0 + t0 + j) * 512 + g * 16 + (lane >> 2)] = (bf16_t)(cvt_pk_bf16(gy, gy) & 0xffffu);
            }
        }
    }
}
__device__ __forceinline__ void ssm_sample_phase(const Args& a, int l) {
    const bf16_t* U = (const bf16_t*)(a.ws + WS_U); bf16_t* GY = (bf16_t*)(a.ws + WS_GY);
    const float* ABAR = (const float*)(a.ws + WS_ABAR); const float* BBAR = (const float*)(a.ws + WS_BBAR);
    int tx_ = threadIdx.x; asm volatile("" : "+v"(tx_)); const int lane = tx_ & 63, gw = blockIdx.x * 8 + (tx_ >> 6), nw = gridDim.x * 8;
    for (int item = gw; item < TS * NG; item += nw) {
        const int b = item >> 5, g = item & 31, i = (l * NG + g) * NP + lane;
        const float ar = ABAR[2 * i], ai = ABAR[2 * i + 1];
        float bbr[16], bbi[16], cr[16], ci[16], dl[16];
#pragma unroll
        for (int c = 0; c < 16; ++c) { bbr[c] = BBAR[((size_t)(l * NG + g) * 32 + c) * NP + lane]; bbi[c] = BBAR[((size_t)(l * NG + g) * 32 + 16 + c) * NP + lane]; const size_t ci_ = ((size_t)(l * NG + g) * 16 + c) * NP + lane; cr[c] = a.in[I_CRE][ci_]; ci[c] = a.in[I_CIM][ci_]; dl[c] = lane == 0 ? a.in[I_SD][(size_t)l * 512 + g * 16 + c] : 0.f; }
        const size_t si = ((size_t)(l * TS + b) * NG + g) * NP + lane; float hr = a.in[I_SRE][si], hi = a.in[I_SIM][si];
        ssm_run<true>(U, GY, TP + b, 1, g, hr, hi, ar, ai, bbr, bbi, cr, ci, dl, lane);
        a.out[O_SRE + si] = hr; a.out[O_SIM + si] = hi;
    }
}
typedef float f32x16 __attribute__((ext_vector_type(16)));
constexpr int SSM_HP = 272, SSM_WAVE_LDS = 32 * SSM_HP;
__device__ __forceinline__ void ssm_pass1_dual(const Args& a, int l) {
    const bf16_t* U = (const bf16_t*)(a.ws + WS_U); const float* ABAR = (const float*)(a.ws + WS_ABAR); float* E = (float*)(a.ws + WS_E); const u32x4* BBF = (const u32x4*)(a.ws + WS_BBF);
    int tx_ = threadIdx.x; asm volatile("" : "+v"(tx_)); const int lane = tx_ & 63, gw = blockIdx.x * 8 + (tx_ >> 6), nw = gridDim.x * 8, n = lane & 31, hh = lane >> 5;
    for (int item = gw; item < NB * NG * 8; item += nw) {
        const int b0 = item >> 9, g = (item >> 4) & 31, ch = item & 15, lg = l * NG + g;
        float ar[2], ai[2], hr[2][2] = {{0.f, 0.f}, {0.f, 0.f}}, hi[2][2] = {{0.f, 0.f}, {0.f, 0.f}};
#pragma unroll
        for (int sh = 0; sh < 2; ++sh) { const int i = lg * NP + sh * 32 + n; ar[sh] = ABAR[2 * i]; ai[sh] = ABAR[2 * i + 1]; }
        pg8::bf16x8 bf[4];
#pragma unroll
        for (int ct = 0; ct < 4; ++ct) bf[ct] = __builtin_bit_cast(pg8::bf16x8, BBF[((size_t)lg * 4 + ct) * 64 + lane]);
        const bf16_t* up0 = U + (size_t)(b0 * SEQ + ch * 128 + 64 * ((n >> 2) & 1) + 4 * (n >> 3) + (n & 3)) * 512 + g * 16 + 8 * hh;
        u32x4 cur0 = *(const u32x4*)up0, cur1 = *(const u32x4*)(up0 + (size_t)4 * SEQ * 512);
#pragma unroll 1
        for (int rt = 0; rt < 4; ++rt) {
            const int rn = rt < 3 ? rt + 1 : 3;
            const u32x4 nxt0 = *(const u32x4*)(up0 + (size_t)(16 * rn) * 512), nxt1 = *(const u32x4*)(up0 + (size_t)(4 * SEQ + 16 * rn) * 512);
            f32x16 acc[2][4];
#pragma unroll
            for (int ct = 0; ct < 4; ++ct) { f32x16 z;
#pragma unroll
                for (int i = 0; i < 16; ++i) z[i] = 0.f;
                acc[0][ct] = __builtin_amdgcn_mfma_f32_32x32x16_bf16(__builtin_bit_cast(pg8::bf16x8, cur0), bf[ct], z, 0, 0, 0);
                acc[1][ct] = __builtin_amdgcn_mfma_f32_32x32x16_bf16(__builtin_bit_cast(pg8::bf16x8, cur1), bf[ct], z, 0, 0, 0); }
#pragma unroll
            for (int i = 0; i < 16; ++i)
#pragma unroll
                for (int sh = 0; sh < 2; ++sh)
#pragma unroll
                    for (int it = 0; it < 2; ++it) { const float nr = ar[sh] * hr[it][sh] - ai[sh] * hi[it][sh] + acc[it][2 * sh][i], ni = ar[sh] * hi[it][sh] + ai[sh] * hr[it][sh] + acc[it][2 * sh + 1][i]; hr[it][sh] = nr; hi[it][sh] = ni; }
            cur0 = nxt0; cur1 = nxt1;
        }
#pragma unroll
        for (int it = 0; it < 2; ++it)
#pragma unroll
            for (int sh = 0; sh < 2; ++sh) { const size_t ei = (((size_t)((b0 + 4 * it) * NG + g) * NCH + 2 * ch + hh) * NP + sh * 32 + n) * 2; E[ei] = hr[it][sh]; E[ei + 1] = hi[it][sh]; }
    }
}
template <bool PASS2> __device__ __forceinline__ void ssm_mfma_phase(const Args& a, int l, PG8_LAS unsigned char* lds) {
    const bf16_t* U = (const bf16_t*)(a.ws + WS_U); bf16_t* GY = (bf16_t*)(a.ws + WS_GY);
    const float* ABAR = (const float*)(a.ws + WS_ABAR); const float* APOW = (const float*)(a.ws + WS_APOW); float* E = (float*)(a.ws + WS_E);
    const u32x4* BBF = (const u32x4*)(a.ws + WS_BBF); const u32x4* CMF = (const u32x4*)(a.ws + WS_CMF);
    int tx_ = threadIdx.x; asm volatile("" : "+v"(tx_)); const int lane = tx_ & 63, wid = tx_ >> 6, gw = blockIdx.x * 8 + wid, nw = gridDim.x * 8;
    const int n = lane & 31, hh = lane >> 5, t16 = lane & 15, q = lane >> 4;
    PG8_LAS unsigned char* hl = lds + wid * SSM_WAVE_LDS;
    PG8_LAS float* Elds = (PG8_LAS float*)(lds + 81920);
    (void)gw; (void)nw; (void)E;
#pragma unroll 1
    for (int kk = 0; kk < 2; ++kk) {
        const int b = blockIdx.x >> 5, g = blockIdx.x & 31, ch = 2 * wid + kk, lg = l * NG + g;
        float ar[2], ai[2], hr[2] = {0.f, 0.f}, hi[2] = {0.f, 0.f};
#pragma unroll
        for (int sh = 0; sh < 2; ++sh) { const int i = lg * NP + sh * 32 + n; ar[sh] = ABAR[2 * i]; ai[sh] = ABAR[2 * i + 1]; }
        pg8::bf16x8 bf[4];
#pragma unroll
        for (int ct = 0; ct < 4; ++ct) bf[ct] = __builtin_bit_cast(pg8::bf16x8, BBF[((size_t)lg * 4 + ct) * 64 + lane]);
        pg8::bf16x8 cm[5];
        if (PASS2) {
#pragma unroll
            for (int ks = 0; ks < 5; ++ks) cm[ks] = __builtin_bit_cast(pg8::bf16x8, CMF[((size_t)lg * 5 + ks) * 64 + lane]);
            const int sc = 2 * ch + hh; float pr[2], pi[2];
#pragma unroll
            for (int sh = 0; sh < 2; ++sh) { const int i = lg * NP + sh * 32 + n; pr[sh] = APOW[2 * i]; pi[sh] = APOW[2 * i + 1]; }
            typedef float f32x2_ __attribute__((ext_vector_type(2)));
            const PG8_LAS f32x2_* Eb = (const PG8_LAS f32x2_*)Elds + n;
            for (int jb = 0; jb < 2 * ch + 1; jb += 8) {
                f32x2_ e0[8], e1[8];
#pragma unroll
                for (int jj = 0; jj < 8; ++jj) { e0[jj] = Eb[(jb + jj) * NP]; e1[jj] = Eb[(jb + jj) * NP + 32]; }
#pragma unroll
                for (int jj = 0; jj < 8; ++jj) if (jb + jj < sc) {
                    const float tr0 = pr[0] * hr[0] - pi[0] * hi[0] + e0[jj].x, ti0 = pr[0] * hi[0] + pi[0] * hr[0] + e0[jj].y; hr[0] = tr0; hi[0] = ti0;
                    const float tr1 = pr[1] * hr[1] - pi[1] * hi[1] + e1[jj].x, ti1 = pr[1] * hi[1] + pi[1] * hr[1] + e1[jj].y; hr[1] = tr1; hi[1] = ti1; }
            }
        }
        const int row0 = b * SEQ + ch * 128;
        u32x4 afr4[4], uw4[4][2];
#pragma unroll
        for (int rt = 0; rt < 4; ++rt) {
            const int tau = 64 * ((n >> 2) & 1) + 16 * rt + 4 * (n >> 3) + (n & 3);
            afr4[rt] = *(const u32x4*)(U + (size_t)(row0 + tau) * 512 + g * 16 + 8 * hh);
            if (PASS2) {
#pragma unroll
                for (int tb = 0; tb < 2; ++tb) { uw4[rt][tb] = (u32x4){0u, 0u, 0u, 0u}; if (q < 2) uw4[rt][tb] = *(const u32x4*)(U + (size_t)(row0 + 64 * tb + 16 * rt + t16) * 512 + g * 16 + 8 * q); } }
        }
#pragma unroll
        for (int rt = 0; rt < 4; ++rt) {
            const pg8::bf16x8 afr = __builtin_bit_cast(pg8::bf16x8, afr4[rt]);
            f32x16 acc[4];
#pragma unroll
            for (int ct = 0; ct < 4; ++ct) { f32x16 z;
#pragma unroll
                for (int i = 0; i < 16; ++i) z[i] = 0.f;
                acc[ct] = __builtin_amdgcn_mfma_f32_32x32x16_bf16(afr, bf[ct], z, 0, 0, 0); }
#pragma unroll
            for (int sh = 0; sh < 2; ++sh)
#pragma unroll
                for (int i = 0; i < 16; ++i) { const float nr = ar[sh] * hr[sh] - ai[sh] * hi[sh] + acc[2 * sh][i], ni = ar[sh] * hi[sh] + ai[sh] * hr[sh] + acc[2 * sh + 1][i]; hr[sh] = nr; hi[sh] = ni;
                    if (PASS2) *(PG8_LAS unsigned*)(hl + (16 * hh + i) * SSM_HP + sh * 128 + 4 * n) = cvt_pk_bf16(nr, ni); }
            if (PASS2) {
                asm volatile("s_waitcnt lgkmcnt(0)" ::: "memory");
#pragma unroll
                for (int tb = 0; tb < 2; ++tb) {
                    f32x4 y = (f32x4){0.f, 0.f, 0.f, 0.f};
#pragma unroll
                    for (int ks = 0; ks < 4; ++ks) { const pg8::bf16x8 hf = __builtin_bit_cast(pg8::bf16x8, *(const PG8_LAS u32x4*)(hl + (16 * tb + t16) * SSM_HP + (32 * ks + 8 * q) * 2)); y = __builtin_amdgcn_mfma_f32_16x16x32_bf16(cm[ks], hf, y, 0, 0, 0); }
                    const size_t trow = (size_t)(row0 + 64 * tb + 16 * rt + t16) * 512 + g * 16;
                    y = __builtin_amdgcn_mfma_f32_16x16x32_bf16(cm[4], __builtin_bit_cast(pg8::bf16x8, uw4[rt][tb]), y, 0, 0, 0);
                    const pg8::f32x2 ga = pg8::gelu_pk((pg8::f32x2){y[0], y[1]}), gb = pg8::gelu_pk((pg8::f32x2){y[2], y[3]});
                    u32x2 w; w.x = cvt_pk_bf16(ga.x, ga.y); w.y = cvt_pk_bf16(gb.x, gb.y); *(u32x2*)(GY + trow + 4 * q) = w;
                }
                asm volatile("s_waitcnt lgkmcnt(0)" ::: "memory");
            }
        }
        if (!PASS2) {
#pragma unroll
            for (int sh = 0; sh < 2; ++sh) { const int ei = ((2 * ch + hh) * NP + sh * 32 + n) * 2; Elds[ei] = hr[sh]; Elds[ei + 1] = hi[sh]; }
        } else if (ch == 15 && hh == 1) {
#pragma unroll
            for (int sh = 0; sh < 2; ++sh) { const size_t oi = ((size_t)(l * NB + b) * NG + g) * NP + sh * 32 + n; a.out[O_PRE + oi] = hr[sh]; a.out[O_PIM + oi] = hi[sh]; }
        }
    }
}
#define XB_TMO      128
#define XB_XCNT(j)  (256  + 64 * (j))
#define XB_XSUB(j)  (1280 + 64 * (j))
#define XB_XGEN(j)  (2304 + 64 * (j))
#define XB_TOP      3328
#define XB_TOPGEN   3392
#define XCD_BAR_WORDS 3456
#define XB_SPIN_CAP (1u << 18)

__device__ __forceinline__ unsigned xb_ld(unsigned* p)              { return __hip_atomic_load(p, __ATOMIC_RELAXED, __HIP_MEMORY_SCOPE_AGENT); }
__device__ __forceinline__ unsigned xb_add(unsigned* p, unsigned v) { return __hip_atomic_fetch_add(p, v, __ATOMIC_RELAXED, __HIP_MEMORY_SCOPE_AGENT); }
__device__ __forceinline__ unsigned xb_xcc_id() { return (unsigned)__builtin_amdgcn_s_getreg((3 << 11) | 20) & 0xFu; }
#define XB_SPIN(cond, bar) do { unsigned _sp = 0; while (cond) { __builtin_amdgcn_s_sleep(1); \
    if ((++_sp & 255u) == 0u) { if (xb_ld(&(bar)[XB_TMO])) break; if (_sp > XB_SPIN_CAP) { atomicAdd(&(bar)[XB_TMO], 1u); break; } } } } while (0)

struct XcdBarrier {
    unsigned* bar; unsigned x;
    volatile PG8_LAS unsigned* st;
};

__device__ __forceinline__ XcdBarrier xcd_barrier_post(unsigned* bar, volatile PG8_LAS unsigned* st) {
    XcdBarrier b; b.bar = bar; b.x = xb_xcc_id(); b.st = st;
    if (threadIdx.x == 0) { st[2] = xb_add(&bar[XB_XCNT(b.x)], 1u); st[3] = b.x; }
    return b;
}
__device__ __forceinline__ void xcd_barrier_complete(unsigned* bar, unsigned x, unsigned& nloc, unsigned& nx) {
    const unsigned G = gridDim.x * gridDim.y * gridDim.z;
    unsigned sum, cnt, mine, sp = 0u;
    for (;;) {
        sum = 0u; cnt = 0u; mine = 0u;
#pragma unroll
        for (unsigned j = 0; j < 16; ++j) { const unsigned c = xb_ld(&bar[XB_XCNT(j)]); sum += c; cnt += (c > 0u) ? 1u : 0u; mine = (j == x) ? c : mine; }
        if (sum == G) break;
        __builtin_amdgcn_s_sleep(1);
        if ((++sp & 255u) == 0u) { if (xb_ld(&bar[XB_TMO])) break; if (sp > XB_SPIN_CAP) { atomicAdd(&bar[XB_TMO], 1u); break; } }
    }
    nloc = mine > 0u ? mine : 1u; nx = cnt > 0u ? cnt : 1u;
}

__device__ __forceinline__ void xcd_barrier(const XcdBarrier& b) {
    asm volatile("s_waitcnt vmcnt(0)" ::: "memory");
    __syncthreads();
    if (threadIdx.x == 0) {
        unsigned* bar = b.bar;
        __builtin_amdgcn_s_waitcnt(0);
        unsigned nloc = b.st[0], nx = b.st[1];
        if (nloc == 0u) { xcd_barrier_complete(bar, b.x, nloc, nx); b.st[0] = nloc; b.st[1] = nx; }
        const unsigned old = xb_add(&bar[XB_XSUB(b.x)], 1u);
        const unsigned gen = old / nloc;
        if (old + 1u == (gen + 1u) * nloc) {
            __builtin_amdgcn_fence(__ATOMIC_RELEASE, "agent");
            asm volatile("s_waitcnt vmcnt(0)" ::: "memory");
            const unsigned og = xb_add(&bar[XB_TOP], 1u);
            const unsigned tg = og / nx;
            if (og + 1u == (tg + 1u) * nx) xb_add(&bar[XB_TOPGEN], 1u);
            else XB_SPIN(xb_ld(&bar[XB_TOPGEN]) == tg, bar);
            __builtin_amdgcn_fence(__ATOMIC_ACQUIRE, "agent");
            xb_add(&bar[XB_XGEN(b.x)], 1u);
            asm volatile("s_waitcnt vmcnt(0)" ::: "memory");
        } else {
            XB_SPIN(xb_ld(&bar[XB_XGEN(b.x)]) == gen, bar);
            __builtin_amdgcn_fence(__ATOMIC_ACQUIRE, "agent");
            asm volatile("s_waitcnt vmcnt(0)" ::: "memory");
        }
    }
    __syncthreads();
}

#ifndef PROBE
#define PROBE 0
#endif
#ifndef PM
#define PM 511
#endif
#ifndef ONE_LAUNCH
#define ONE_LAUNCH 1
#endif
constexpr int LDS_X = pg8::STAGE_BYTES + 64, LDS_BYTES = LDS_X + 4096;
constexpr size_t WS_BAR = (WS_END + 255) & ~(size_t)255, WS_TOTAL = WS_BAR + (size_t)XCD_BAR_WORDS * 4;
constexpr int N_PHASES = 2 + 8 * NL;

__global__ void __launch_bounds__(512, 2) mk_fwd(Args a) {
    extern __shared__ __attribute__((aligned(16))) unsigned char lds_raw[];
    PG8_LAS unsigned char* lds = (PG8_LAS unsigned char*)lds_raw;
    volatile PG8_LAS unsigned* bst = (volatile PG8_LAS unsigned*)(lds + pg8::STAGE_BYTES);
    if (threadIdx.x < 16) bst[threadIdx.x] = 0u;
    __syncthreads();
    const XcdBarrier gbar = xcd_barrier_post((unsigned*)(a.ws + WS_BAR), bst);
    if (a.ph_hi > 1000) cg::this_grid().sync();
    for (int ph = a.ph_lo; ph < a.ph_hi; ++ph) {
        if (ph > 0 && ph < N_PHASES - 1 && ((ph - 1) & 7) == 2) continue;
        size_t zoff_ = 0; int G = gridDim.x, bx = blockIdx.x; asm volatile("" : "+s"(zoff_), "+s"(G), "+s"(bx)); unsigned char* ws = a.ws + zoff_;
        bf16_t* XB = (bf16_t*)(ws + WS_XB); float* RS = (float*)(ws + WS_ROWSS);
        for (int rep = 0; rep < (((PROBE == 2 && ph == 0) || (PROBE == 3 && ph > 0 && ph < N_PHASES - 1 && (((ph - 1) & 7) == 0 || ((ph - 1) & 7) == 6)) || (PROBE == 7 && ph > 0 && ph < N_PHASES - 1 && ((ph - 1) & 7) == 6) || (PROBE == 8 && ph > 0 && ph < N_PHASES - 1 && ((ph - 1) & 7) == 0) || (PROBE == 4 && ph > 0 && ph < N_PHASES - 1 && (((ph - 1) & 7) == 1 || ((ph - 1) & 7) == 2))) ? 2 : 1); ++rep) {
        if (rep) __syncthreads();
        if ((PM & 1) && ph == 0) { p0_weights(a, (float*)lds_raw, 0, P0_PER, bx, G); p0_ssm(a); p0_x(a); }
        else if ((PM & 2) && ph == N_PHASES - 1) { final_norm(a); }
        else {
            const int l = (ph - 1) >> 3, s = (ph - 1) & 7;
            if ((PM & 4) && s == 0) {
                pg8::Gemm g{XB, (const bf16_t*)(ws + WS_WIN + l * SZ_WIN), TP, 4096, 1024}; pg8::StaticOrder S; S.init(TP, 4096, G, bx);
                EpiIn E{ws, RS + (size_t)(2 * l) * MP, lds + LDS_X};
                if (PROBE == 11) { EpiNull EN{(float*)(ws + WS_E)}; pg8::gemm_phase<EpiNull, pg8::StaticOrder, false>(lds, g, S, EN, nullptr); }
                pg8::gemm_phase<EpiIn, pg8::StaticOrder, false>(lds, g, S, E, nullptr); __syncthreads();
                if (bx < 224) {
                    const int su = bx; int n0, n1, kind, dc;
                    if (su < 32) { kind = 0; dc = 16 * su; n0 = dc; n1 = n0; } else if (su < 64) { kind = 1; dc = 16 * (su - 32); n0 = 512 + (dc >> 7) * 256 + (dc & 127); n1 = n0 + 128; }
                    else if (su < 96) { kind = 2; dc = 16 * (su - 64); n0 = 1536 + dc; n1 = n0; } else if (su < 160) { kind = 3; dc = 16 * (su - 96); n0 = 2048 + dc; n1 = n0; } else { kind = 4; dc = 16 * (su - 160); n0 = 3072 + dc; n1 = n0; }
                    const float* rowss = RS + (size_t)(2 * l) * MP;
                    skinny_unit<true, 8>(lds, XB + (size_t)TP * 1024, (const bf16_t*)(ws + WS_WIN + l * SZ_WIN), 1024, n0, n1, 0, otid(), [=](const f32x4 s0, const f32x4 s1, int row, int c4) {
                        const float rs = rsqrtf(rowss[row] * (1.0f / 1024.0f) + EPS); f32x4 v = s0 * rs;
                        if (kind == 1) v = v * (s1 * rs);
                        if (kind >= 3) { _Pragma("unroll") for (int j = 0; j < 4; ++j) v[j] = sigm(v[j]); }
                        bf16_t* dst = kind == 0 ? (bf16_t*)(ws + WS_ZB) + (size_t)row * 512 : kind == 1 ? (bf16_t*)(ws + WS_CV) + (size_t)row * 512 : kind == 2 ? (bf16_t*)(ws + WS_U) + (size_t)row * 512 : kind == 3 ? (bf16_t*)(ws + WS_SGA) + (size_t)row * 1024 : (bf16_t*)(ws + WS_SGS) + (size_t)row * 1024;
                        *(u32x2*)(dst + dc + c4) = pack4(v); });
                }
            } else if ((PM & 8) && s == 1) { if (!rep) conv_phase(a, l); ssm_sample_phase(a, l); __syncthreads(); ssm_mfma_phase<false>(a, l, lds); __syncthreads(); ssm_mfma_phase<true>(a, l, lds); }
            else if ((PM & 16) && s == 2) { }
            else if ((PM & 32) && s == 3) {
                { pg8::Gemm g{(const bf16_t*)(ws + WS_ZB), (const bf16_t*)(ws + WS_WBA + l * SZ_WB), TP, 1024, 512}; pg8::StaticOrder S; S.init(TP, 1024, G, bx);
                  EpiBr<false> E{ws}; if (PROBE == 11) { EpiNull EN{(float*)(ws + WS_E)}; pg8::gemm_phase<EpiNull, pg8::StaticOrder, false>(lds, g, S, EN, nullptr); } pg8::gemm_phase<EpiBr<false>, pg8::StaticOrder, false>(lds, g, S, E, nullptr); __syncthreads(); }
                { pg8::Gemm g{(const bf16_t*)(ws + WS_GY), (const bf16_t*)(ws + WS_WGLU + l * SZ_WGLU), TP, 512, 512}; pg8::StaticOrder S; S.init(TP, 512, G, bx);
                  EpiGlu E{ws, a.in[I_BGLU] + (size_t)l * 512}; if (PROBE == 11) { EpiNull EN{(float*)(ws + WS_E)}; pg8::gemm_phase<EpiNull, pg8::StaticOrder, false>(lds, g, S, EN, nullptr); } pg8::gemm_phase<EpiGlu, pg8::StaticOrder, false>(lds, g, S, E, nullptr); __syncthreads(); }
                if (bx >= 128 && bx < 192) {
                    const int dc = 16 * (bx - 128);
                    skinny_unit<false, 8>(lds, (const bf16_t*)(ws + WS_ZB) + (size_t)TP * 512, (const bf16_t*)(ws + WS_WBA + l * SZ_WB), 512, dc, dc, 0, otid(), [=](const f32x4 s0, const f32x4 s1, int row, int c4) {
                        u32x2* p = (u32x2*)((bf16_t*)(ws + WS_SGA) + (size_t)row * 1024 + dc + c4); *p = pack4(unpack4(*p) * s0); });
                } else if (bx >= 192 && bx < 224) {
                    const int dc = 16 * (bx - 192); const float* bias = a.in[I_BGLU] + (size_t)l * 512;
                    skinny_unit<false, 8>(lds, (const bf16_t*)(ws + WS_GY) + (size_t)TP * 512, (const bf16_t*)(ws + WS_WGLU + l * SZ_WGLU), 512, dc, dc, 0, otid(), [=](const f32x4 s0, const f32x4 s1, int row, int c4) {
                        const f32x4 gy = unpack4(*(const u32x2*)((const bf16_t*)(ws + WS_GY) + (size_t)row * 512 + dc + c4)); f32x4 v = s0 + *(const f32x4*)(bias + dc + c4);
                        _Pragma("unroll") for (int j = 0; j < 4; ++j) v[j] = gy[j] * sigm(v[j]);
                        *(u32x2*)((bf16_t*)(ws + WS_YS2) + (size_t)row * 512 + dc + c4) = pack4(v); });
                }
                if (l + 1 < NL && bx >= 128) { __syncthreads(); p0_weights(a, (float*)lds_raw, (l + 1) * P0_PER, (l + 1) * P0_PER + 340, bx - 128, 128); }
            } else if ((PM & 64) && s == 4) {
                pg8::Gemm g{(const bf16_t*)(ws + WS_YS2), (const bf16_t*)(ws + WS_WBB + l * SZ_WB), TP, 1024, 512}; pg8::StaticOrder S; S.init(TP, 1024, G, bx);
                EpiBr<true> E{ws}; if (PROBE == 11) { EpiNull EN{(float*)(ws + WS_E)}; pg8::gemm_phase<EpiNull, pg8::StaticOrder, false>(lds, g, S, EN, nullptr); } pg8::gemm_phase<EpiBr<true>, pg8::StaticOrder, false>(lds, g, S, E, nullptr); __syncthreads();
                {
                    const int dc = 16 * (bx & 63);
                    skinny_unit<false, 2>(lds, (const bf16_t*)(ws + WS_YS2) + (size_t)TP * 512, (const bf16_t*)(ws + WS_WBB + l * SZ_WB), 512, dc, dc, 32 * (bx >> 6), otid(), [=](const f32x4 s0, const f32x4 s1, int row, int c4) {
                        const size_t off = (size_t)row * 1024 + dc + c4; u32x2* p = (u32x2*)((bf16_t*)(ws + WS_SGS) + off); const f32x4 t = unpack4(*(const u32x2*)((const bf16_t*)(ws + WS_SGA) + off));
                        *p = pack4(t + unpack4(*p) * s0); });
                }
            } else if ((PM & 128) && (s == 5 || s == 7)) {
                const bool dn = s == 7;
                pg8::Gemm g{(const bf16_t*)(dn ? ws + WS_FF : ws + WS_SGS), (const bf16_t*)(dn ? ws + WS_WDN + l * SZ_WDN : ws + WS_WOUT + l * SZ_WOUT), TP, 1024, dn ? DFF : 1024}; pg8::StaticOrder S; S.init(TP, 1024, G, bx);
                EpiRes E{a.out, ws, RS + (size_t)(2 * l + (dn ? 2 : 1)) * MP};
                if (PROBE == 5) { EpiProbe<1> EN{ws, (float*)(ws + WS_E)}; pg8::gemm_phase<EpiProbe<1>, pg8::StaticOrder, false>(lds, g, S, EN, nullptr); }
                if (PROBE == 11) { EpiNull EN{(float*)(ws + WS_E)}; pg8::gemm_phase<EpiNull, pg8::StaticOrder, false>(lds, g, S, EN, nullptr); }
                pg8::gemm_phase<EpiRes, pg8::StaticOrder, false>(lds, g, S, E, nullptr); __syncthreads();
                {
                    const int dc = 16 * (bx & 63), Ks = dn ? DFF : 1024; float* rso = RS + (size_t)(2 * l + (dn ? 2 : 1)) * MP; float* X = a.out;
                    skinny_unit<false, 2>(lds, (const bf16_t*)(dn ? ws + WS_FF : ws + WS_SGS) + (size_t)TP * Ks, (const bf16_t*)(dn ? ws + WS_WDN + l * SZ_WDN : ws + WS_WOUT + l * SZ_WOUT), Ks, dc, dc, 32 * (bx >> 6), otid(), [=](const f32x4 s0, const f32x4 s1, int row, int c4) {
                        const size_t off = (size_t)row * 1024 + dc + c4; const f32x4 x = *(const f32x4*)(X + off) + s0; *(f32x4*)(X + off) = x; *(u32x2*)(XB + off) = pack4(x);
                        float ss = (x[0] * x[0] + x[1] * x[1]) + (x[2] * x[2] + x[3] * x[3]); ss += __shfl_xor(ss, 16); ss += __shfl_xor(ss, 32);
                        if (c4 == 0) atomicAdd(rso + row, ss); });
                }
            } else if (PM & 256) {
                pg8::Gemm g{XB, (const bf16_t*)(ws + WS_WGU + l * SZ_WGU), TP, 2 * DFF, 1024}; pg8::StaticOrder S; S.init(TP, 2 * DFF, G, bx);
                EpiGU E{ws, RS + (size_t)(2 * l + 1) * MP, lds + LDS_X};
                if (PROBE == 11) { EpiNull EN{(float*)(ws + WS_E)}; pg8::gemm_phase<EpiNull, pg8::StaticOrder, false>(lds, g, S, EN, nullptr); }
                if (PROBE == 20) { EpiProbe<0> EP{ws, (float*)(ws + WS_E)}; pg8::gemm_phase<EpiProbe<0>, pg8::StaticOrder, false>(lds, g, S, EP, nullptr); }
                if (PROBE == 21) { EpiProbe<1> EP{ws, (float*)(ws + WS_E)}; pg8::gemm_phase<EpiProbe<1>, pg8::StaticOrder, false>(lds, g, S, EP, nullptr); }
                if (PROBE == 22 || PROBE == 24 || PROBE == 26) { pg8::gemm_phase<EpiGU, pg8::StaticOrder, false>(lds, g, S, E, nullptr); __syncthreads(); if (PROBE == 26) __syncthreads(); }
                pg8::gemm_phase<EpiGU, pg8::StaticOrder, false>(lds, g, S, E, nullptr); __syncthreads();
                if (bx >= 80) {
                    const int dc = 16 * (255 - bx), n0 = (dc >> 7) * 256 + (dc & 127); const float* rowss = RS + (size_t)(2 * l + 1) * MP;
                    skinny_unit<true, 8>(lds, XB + (size_t)TP * 1024, (const bf16_t*)(ws + WS_WGU + l * SZ_WGU), 1024, n0, n0 + 128, 0, otid(), [=](const f32x4 s0, const f32x4 s1, int row, int c4) {
                        const float rs = rsqrtf(rowss[row] * (1.0f / 1024.0f) + EPS); const f32x4 g = s0 * rs, up = s1 * rs; f32x4 v;
                        _Pragma("unroll") for (int j = 0; j < 4; ++j) v[j] = g[j] * sigm(g[j]) * up[j];
                        *(u32x2*)((bf16_t*)(ws + WS_FF) + (size_t)row * DFF + dc + c4) = pack4(v); });
                }
                if (l + 1 < NL && bx >= 128) { __syncthreads(); p0_weights(a, (float*)lds_raw, (l + 1) * P0_PER + 340, (l + 2) * P0_PER, bx - 128, 128); }
            }
        }
        }
        if (ph + 1 < a.ph_hi) { xcd_barrier(gbar); if (PROBE == 1) xcd_barrier(gbar); }
        if (ph == a.ph_lo) {
            if (threadIdx.x == 0) { bool ok = true; unsigned* bw = (unsigned*)(a.ws + WS_BAR);
                for (unsigned j = 0; j < 16; ++j) { const unsigned cnt = xb_ld(&bw[XB_XCNT(j)]); ok = ok && (j < 8 ? cnt == 32u : cnt == 0u); }
                bst[4] = ok ? (bst[2] * 8u + bst[3]) : (unsigned)blockIdx.x; }
            __syncthreads();
        }
    }
}

extern "C" void kernel_launch(void* const* d_in, const int* in_sizes, int n_in, void* d_out, int out_size, void* d_ws, size_t ws_size, hipStream_t stream) {
    static int grid = 0;
    if (grid == 0) {
        if (n_in != 25 || (size_t)out_size != O_END || ws_size < WS_TOTAL) { fprintf(stderr, "kernel_launch: unexpected shapes: n_in %d out %d ws %zu (need %zu)\n", n_in, out_size, ws_size, (size_t)WS_TOTAL); grid = -1; return; }
        int dev = 0, cus = 0, per_cu = 0;
        hipGetDevice(&dev); hipDeviceGetAttribute(&cus, hipDeviceAttributeMultiprocessorCount, dev);
        if (hipFuncSetAttribute((const void*)mk_fwd, hipFuncAttributeMaxDynamicSharedMemorySize, LDS_BYTES) != hipSuccess) { fprintf(stderr, "kernel_launch: hipFuncSetAttribute failed\n"); grid = -1; return; }
        if (hipOccupancyMaxActiveBlocksPerMultiprocessor(&per_cu, (const void*)mk_fwd, 512, LDS_BYTES) != hipSuccess || per_cu < 1) { fprintf(stderr, "kernel_launch: occupancy query says %d\n", per_cu); per_cu = 1; }
        (void)hipGetLastError();
        grid = 256;
        if (cus < 256) fprintf(stderr, "kernel_launch: %d CUs, need 256\n", cus);
    }
    if (grid < 0) return;
    if (hipMemsetAsync((char*)d_ws + WS_BAR, 0, (size_t)XCD_BAR_WORDS * 4, stream) != hipSuccess) { fprintf(stderr, "kernel_launch: memset of the barrier words failed\n"); return; }
    Args a{};
    for (int i = 0; i < 25; ++i) a.in[i] = (const float*)d_in[i];
    a.out = (float*)d_out; a.ws = (unsigned char*)d_ws;
#if ONE_LAUNCH
    a.ph_lo = 0; a.ph_hi = N_PHASES;
    void* args[] = {&a};
    hipError_t e = hipLaunchCooperativeKernel((const void*)mk_fwd, dim3(grid), dim3(512), args, LDS_BYTES, stream);
    if (e != hipSuccess) fprintf(stderr, "cooperative launch failed: %s (grid %d)\n", hipGetErrorString(e), grid);
#else
    for (int ph = 0; ph < N_PHASES; ++ph) { a.ph_lo = ph; a.ph_hi = ph + 1; hipLaunchKernelGGL(mk_fwd, dim3(grid), dim3(512), LDS_BYTES, stream, a); }
#endif
}
```

```cpp
#include <hip/hip_runtime.h>
#include <hip/hip_cooperative_groups.h>
#include <cstdio>
namespace cg = cooperative_groups;
namespace pg8 {
#define PG8_LAS __attribute__((address_space(3)))
typedef unsigned short bf16_t;
typedef short bf16x8 __attribute__((ext_vector_type(8)));
typedef float f32x4 __attribute__((ext_vector_type(4)));
typedef unsigned u32x4 __attribute__((ext_vector_type(4)));
constexpr int BM = 256, BK = 64, HALF = 128, HTB = HALF * BK * 2  , STAGE_BYTES = 8 * HTB, NXCD = 8, WGM = 8;

__host__ __device__ __forceinline__ int lds_byte(int r, int c) { const int st = (r >> 4) * 2 + (c >> 5), rr = r & 15, cc = c & 31, ob = rr * 64 + cc * 2; return st * 1024 + (ob ^ (((ob >> 9) & 1) << 5)); }
__host__ __device__ __forceinline__ void stage_rc(int b, int& R, int& C) { const int st = b / 1024, sb = b % 1024, swz = sb ^ (((sb >> 9) & 1) << 5); R = (st >> 1) * 16 + swz / 64; C = (st & 1) * 32 + (swz % 64) / 2; }
__host__ __device__ __forceinline__ int perm32(int rho) { const int n = rho >> 4, i = rho & 15; return 8 * (i >> 2) + 4 * n + (i & 3); }

struct Unit { int pm, pn; };
struct Gemm { const bf16_t* A; const bf16_t* Bt; int M, N, K; };

struct StaticOrder {
    int nM, nN, nwg, G, c;
    __host__ __device__ void init(int M, int N, int G_, int c_) { nM = M / BM; nN = N / BM; nwg = nM * nN; G = G_; c = c_; }
    __host__ __device__ bool next(int i, Unit& u) const {
        const long L = (long)i * G + c; if (L >= nwg) return false;
        int wgid = (int)L; { const int q = nwg / NXCD, r = nwg % NXCD, xcd = wgid % NXCD, off = wgid / NXCD; wgid = (xcd < r ? xcd * (q + 1) : r * (q + 1) + (xcd - r) * q) + off; }
        const int nig = WGM * nN, gid = wgid / nig, fm = gid * WGM, gsz = (nM - fm) < WGM ? (nM - fm) : WGM;
        u.pm = fm + ((wgid % nig) % gsz); u.pn = (wgid % nig) / gsz; return true;
    }
    __device__ __forceinline__ void a_ready(const Unit&) const {}
    __device__ __forceinline__ void done(const Unit&) const {}
};
__device__ __forceinline__ unsigned cvt_pk_bf16(float lo, float hi) { unsigned r; asm volatile("v_cvt_pk_bf16_f32 %0, %1, %2" : "=v"(r) : "v"(lo), "v"(hi)); return r; }
typedef float f32x2 __attribute__((ext_vector_type(2)));
__device__ __forceinline__ f32x2 gelu_pk(f32x2 v) {
    const f32x2 av = __builtin_elementwise_abs(v), d = av * 0.2316418882f + 1.0f;
    f32x2 t; t.x = __builtin_amdgcn_rcpf(d.x); t.y = __builtin_amdgcn_rcpf(d.y);
    f32x2 q = t * 0.5307027145f + (-0.7265760135f); q = q * t + 0.7107068705f; q = q * t + (-0.142248368f); q = q * t + 0.127414796f; q = q * t;
    const f32x2 s = (v * v) * (-0.72134752044f);
    f32x2 e; e.x = __builtin_amdgcn_exp2f(s.x); e.y = __builtin_amdgcn_exp2f(s.y);
    const f32x2 m = v * (q * e), r = v - m;
    f32x2 o; o.x = v.x < 0.f ? m.x : r.x; o.y = v.y < 0.f ? m.y : r.y; return o;
}

template <class Epi, class Sched, bool STAMP = false>
__device__ __forceinline__ void gemm_phase(PG8_LAS unsigned char* lds, const Gemm g, const Sched& S, const Epi& E, unsigned long long* stamps) {
    int tid_ = threadIdx.x; asm volatile("" : "+v"(tid_));
    const int tid = tid_, wid = __builtin_amdgcn_readfirstlane(tid >> 6), lane = tid & 63, wr = wid >> 2, wc = wid & 3, fr = lane & 15, fq = lane >> 4;
    const int K = g.K, nt = K / BK;
    int ts_lo = 0, ts_hi = 0, nts = 0; const unsigned long long rt_entry = STAMP ? (unsigned long long)wall_clock64() : 0ull;
#define PG8_STAMP() do { if (STAMP && wid == 0 && nts < 64) { const unsigned long long _c = (unsigned long long)clock64(); \
        ts_lo = (lane == nts) ? (int)(unsigned)_c : ts_lo; ts_hi = (lane == nts) ? (int)(unsigned)(_c >> 32) : ts_hi; ++nts; } } while (0)
    PG8_STAMP();
    unsigned voffA[2], voffB[2];
#pragma unroll
    for (int i = 0; i < 2; ++i) { int R, C; stage_rc(tid * 16 + i * 8192, R, C); const int Rb = Epi::PERM ? ((R & ~31) + perm32(R & 31)) : R;
        voffA[i] = (unsigned)(R * K + C) * 2u; voffB[i] = (unsigned)(Rb * K + C) * 2u; }
    const size_t kstep = (size_t)(BK * 2);
    const size_t hstep = (size_t)HALF * K * 2;
    const size_t tstep = 2 * hstep;
    const unsigned ldsw = (unsigned)wid * 1024u;
    const int aoff = lds_byte(wr * 64 + fr, fq * 8), boff = lds_byte(wc * 32 + fr, fq * 8);
#define PG8_SA(b, h) (((b) * 2 + (h)) * HTB)
#define PG8_SB(b, h) ((4 + (b) * 2 + (h)) * HTB)
#define PG8_STAGE(bufoff, gbase, voff) do { _Pragma("unroll") for (int _i = 0; _i < 2; ++_i) \
        __builtin_amdgcn_global_load_lds((const unsigned*)((const char*)(gbase) + (voff)[_i]), (PG8_LAS unsigned*)(lds + (bufoff) + ldsw + _i * 8192), 16, 0, 0); } while (0)
#define PG8_LDA(dst, b, h) do { _Pragma("unroll") for (int m = 0; m < 4; ++m) _Pragma("unroll") for (int k = 0; k < 2; ++k) dst[m][k] = *(const PG8_LAS bf16x8*)(lds + PG8_SA(b, h) + aoff + m * 2048 + k * 1024); } while (0)
#define PG8_LDB(dst, b, h) do { _Pragma("unroll") for (int n = 0; n < 2; ++n) _Pragma("unroll") for (int k = 0; k < 2; ++k) dst[n][k] = *(const PG8_LAS bf16x8*)(lds + PG8_SB(b, h) + boff + n * 2048 + k * 1024); } while (0)
#define PG8_MMA(ai, bj, At, Bt) do { __builtin_amdgcn_s_setprio(1); _Pragma("unroll") for (int m = 0; m < 4; ++m) _Pragma("unroll") for (int n = 0; n < 2; ++n) _Pragma("unroll") for (int k = 0; k < 2; ++k) \
        acc[ai][bj][m][n] = __builtin_amdgcn_mfma_f32_16x16x32_bf16(Bt[n][k], At[m][k], acc[ai][bj][m][n], 0, 0, 0); __builtin_amdgcn_s_setprio(0); } while (0)
#define PG8_WAIT_V(n) asm volatile("s_waitcnt vmcnt(" #n ")" ::: "memory")
#define PG8_WAIT_L(n) asm volatile("s_waitcnt lgkmcnt(" #n ")" ::: "memory")
#define PG8_BAR __builtin_amdgcn_s_barrier()
#define PG8_SCHED __builtin_amdgcn_sched_barrier(0)
    Unit cur, nxt; int ui = 0;
    if (!S.next(0, cur)) return;
    f32x4 acc[2][2][4][2];
#pragma unroll
    for (int a = 0; a < 2; ++a)
#pragma unroll
        for (int b = 0; b < 2; ++b)
#pragma unroll
            for (int m = 0; m < 4; ++m)
#pragma unroll
                for (int n = 0; n < 2; ++n) acc[a][b][m][n] = (f32x4){0.f, 0.f, 0.f, 0.f};
    bf16x8 At[4][2], B0[2][2], B1[2][2];
    const char* cA = (const char*)g.A + (size_t)cur.pm * tstep; const char* cB = (const char*)g.Bt + (size_t)cur.pn * tstep;
    S.a_ready(cur);
    PG8_STAGE(PG8_SB(0, 0), cB, voffB); PG8_STAGE(PG8_SA(0, 0), cA, voffA); PG8_STAGE(PG8_SB(0, 1), cB + hstep, voffB); PG8_STAGE(PG8_SA(0, 1), cA + hstep, voffA);
    if (wr == 1) PG8_BAR;
    PG8_WAIT_V(4); PG8_BAR;
    PG8_STAGE(PG8_SB(1, 0), cB + kstep, voffB); PG8_STAGE(PG8_SA(1, 0), cA + kstep, voffA); PG8_STAGE(PG8_SB(1, 1), cB + hstep + kstep, voffB);
    PG8_WAIT_V(6); PG8_BAR;
    PG8_STAMP();
    for (;;) {
        const bool has_next = S.next(ui + 1, nxt);
        const char* nA = has_next ? (const char*)g.A + (size_t)nxt.pm * tstep : cA; const char* nB = has_next ? (const char*)g.Bt + (size_t)nxt.pn * tstep : cB;
        for (int t = 0; t < nt; t += 2) {
            const bool last = (t == nt - 2);
            const char* a1 = cA + (size_t)(t + 1) * kstep;
            const char* a2 = last ? nA : cA + (size_t)(t + 2) * kstep; const char* b2 = last ? nB : cB + (size_t)(t + 2) * kstep;
            const char* a3 = a2 + kstep; const char* b3 = b2 + kstep;
            if (last && has_next) S.a_ready(nxt);
            if constexpr (Epi::PREFETCH) { if (last) E.prefetch(cur, wid, lane); }
            PG8_LDB(B0, 0, 0); PG8_SCHED; PG8_LDA(At, 0, 0); PG8_STAGE(PG8_SA(1, 1), a1 + hstep, voffA);
            PG8_WAIT_L(8); PG8_BAR; PG8_WAIT_L(0); PG8_MMA(0, 0, At, B0); PG8_BAR; PG8_SCHED;
            PG8_LDB(B1, 0, 1); PG8_STAGE(PG8_SB(0, 0), b2, voffB);
            PG8_BAR; PG8_WAIT_L(0); PG8_MMA(0, 1, At, B1); PG8_BAR;
            PG8_LDA(At, 0, 1); PG8_STAGE(PG8_SA(0, 0), a2, voffA);
            PG8_BAR; PG8_WAIT_L(0); PG8_MMA(1, 0, At, B0); PG8_BAR; PG8_SCHED;
            PG8_STAGE(PG8_SB(0, 1), b2 + hstep, voffB);
            PG8_WAIT_V(6); PG8_BAR; PG8_MMA(1, 1, At, B1); PG8_BAR;
            PG8_LDB(B0, 1, 0); PG8_SCHED; PG8_LDA(At, 1, 0); PG8_STAGE(PG8_SA(0, 1), a2 + hstep, voffA);
            PG8_WAIT_L(8); PG8_BAR; PG8_WAIT_L(0); PG8_MMA(0, 0, At, B0); PG8_BAR; PG8_SCHED;
            PG8_LDB(B1, 1, 1); PG8_STAGE(PG8_SB(1, 0), b3, voffB);
            PG8_BAR; PG8_WAIT_L(0); PG8_MMA(0, 1, At, B1); PG8_BAR;
            PG8_LDA(At, 1, 1); PG8_STAGE(PG8_SA(1, 0), a3, voffA);
            PG8_BAR; PG8_WAIT_L(0); PG8_MMA(1, 0, At, B0); PG8_BAR; PG8_SCHED;
            PG8_STAGE(PG8_SB(1, 1), b3 + hstep, voffB);
            PG8_WAIT_V(6); PG8_BAR; PG8_MMA(1, 1, At, B1); PG8_BAR;
        }
        PG8_STAMP();
        if (wr == 0) PG8_BAR;
        if constexpr (!Epi::AFTER_DRAIN) { E(acc, cur, wr, wc, fr, fq); S.done(cur); }
        PG8_STAMP();
        if (!has_next) break;
#pragma unroll
        for (int a = 0; a < 2; ++a)
#pragma unroll
            for (int b = 0; b < 2; ++b)
#pragma unroll
                for (int m = 0; m < 4; ++m)
#pragma unroll
                    for (int n = 0; n < 2; ++n) acc[a][b][m][n] = (f32x4){0.f, 0.f, 0.f, 0.f};
        cur = nxt; cA = nA; cB = nB; ++ui;
        if (wr == 1) PG8_BAR;
    }
    PG8_WAIT_V(0);
    PG8_BAR;
    if constexpr (Epi::AFTER_DRAIN) { E.fused(acc, cur, wr, wc, fr, fq, lds, wid, lane); S.done(cur); }
    PG8_STAMP();
    if (STAMP && wid == 0) { stamps[lane] = lane < nts ? (((unsigned long long)(unsigned)ts_hi << 32) | (unsigned)ts_lo) : 0ull;
        if (lane == 62) stamps[62] = rt_entry; if (lane == 63) stamps[63] = (unsigned long long)wall_clock64(); }
#undef PG8_STAMP
#undef PG8_SA
#undef PG8_SB
#undef PG8_STAGE
#undef PG8_LDA
#undef PG8_LDB
#undef PG8_MMA
#undef PG8_WAIT_V
#undef PG8_WAIT_L
#undef PG8_BAR
#undef PG8_SCHED
}
}
using pg8::bf16_t; using pg8::f32x4; using pg8::u32x4; using pg8::Unit; using pg8::cvt_pk_bf16;
typedef unsigned u32x2 __attribute__((ext_vector_type(2)));
constexpr int D = 1024, TP = 16384, TS = 128, T = TP + TS, MP = 16640, NL = 4, CW = 512, NG = 32, NP = 64, DFF = 2816, SEQ = 2048, NB = 8, LC = 64, NCH = SEQ / LC;
constexpr float EPS = 1e-6f;
constexpr size_t O_YP = 0, O_YS = (size_t)TP * D, O_PC = O_YS + (size_t)TS * D, O_PRE = O_PC + (size_t)NL * NB * 2 * CW, O_PIM = O_PRE + (size_t)NL * NB * NG * NP,
                 O_SC = O_PIM + (size_t)NL * NB * NG * NP, O_SRE = O_SC + (size_t)NL * TS * 2 * CW, O_SIM = O_SRE + (size_t)NL * TS * NG * NP, O_END = O_SIM + (size_t)NL * TS * NG * NP;
constexpr size_t SZ_WIN = (size_t)4096 * 1024 * 2, SZ_WGLU = (size_t)512 * 512 * 2, SZ_WB = (size_t)1024 * 512 * 2, SZ_WOUT = (size_t)1024 * 1024 * 2, SZ_WGU = (size_t)5632 * 1024 * 2, SZ_WDN = (size_t)1024 * 2816 * 2;
constexpr size_t WS_WIN = 0, WS_WGLU = WS_WIN + NL * SZ_WIN, WS_WBA = WS_WGLU + NL * SZ_WGLU, WS_WBB = WS_WBA + NL * SZ_WB, WS_WOUT = WS_WBB + NL * SZ_WB, WS_WGU = WS_WOUT + NL * SZ_WOUT,
                 WS_WDN = WS_WGU + NL * SZ_WGU, WS_XB = WS_WDN + NL * SZ_WDN;
constexpr size_t SZ_H = (size_t)MP * 512 * 2, SZ_F = (size_t)MP * 1024 * 2;
constexpr size_t WS_ZB = WS_XB + SZ_F, WS_CV = WS_ZB + SZ_H, WS_U = WS_CV + SZ_H, WS_SGA = WS_U + SZ_H, WS_SGS = WS_SGA + SZ_F, WS_GY = WS_SGS + SZ_F, WS_YS2 = WS_GY + SZ_H, WS_ZEND = WS_YS2 + SZ_H;
constexpr size_t WS_FF = WS_ZB;
static_assert((size_t)MP * DFF * 2 <= WS_ZEND - WS_ZB, "F alias");
constexpr size_t WS_ROWSS = WS_ZEND, SZ_ROWSS = (size_t)MP * 4, WS_ABAR = WS_ROWSS + 9 * SZ_ROWSS, WS_APOW = WS_ABAR + (size_t)NL * NG * NP * 8, WS_BBAR = WS_APOW + (size_t)NL * NG * NP * 8,
                 WS_E = WS_BBAR + (size_t)NL * NG * NP * 32 * 4, WS_BBF = WS_E + (size_t)NB * NG * NCH * NP * 8, WS_CMF = WS_BBF + (size_t)NL * NG * 4 * 64 * 16, WS_END = WS_CMF + (size_t)NL * NG * 5 * 64 * 16;

__device__ __forceinline__ float bf_lo(unsigned w) { return __uint_as_float(w << 16); }
__device__ __forceinline__ float bf_hi(unsigned w) { return __uint_as_float(w & 0xffff0000u); }
__device__ __forceinline__ float sigm(float x) { return __builtin_amdgcn_rcpf(1.0f + __expf(-x)); }
__device__ __forceinline__ u32x4 pack8(const f32x4 a, const f32x4 b) { u32x4 w; w.x = cvt_pk_bf16(a[0], a[1]); w.y = cvt_pk_bf16(a[2], a[3]); w.z = cvt_pk_bf16(b[0], b[1]); w.w = cvt_pk_bf16(b[2], b[3]); return w; }
__device__ __forceinline__ void unpack8(const u32x4 w, f32x4& a, f32x4& b) { a = (f32x4){bf_lo(w.x), bf_hi(w.x), bf_lo(w.y), bf_hi(w.y)}; b = (f32x4){bf_lo(w.z), bf_hi(w.z), bf_lo(w.w), bf_hi(w.w)}; }

__device__ __forceinline__ float nr_rcp(float d) { float r = __uint_as_float(0x7EF311C7u - __float_as_uint(d)); r = r * fmaf(-d, r, 2.0f); r = r * fmaf(-d, r, 2.0f); return r; }
#define WT_FLAGS 0x00020000
__device__ __forceinline__ void wt16s(const __amdgpu_buffer_rsrc_t r, const void* base, const void* p, const u32x4 v) { __builtin_amdgcn_raw_buffer_store_b128(v, r, (unsigned)((const char*)p - (const char*)base), 0, 16); }
__device__ __forceinline__ void wt16(const __amdgpu_buffer_rsrc_t r, const void* base, const void* p, const u32x4 v) { (void)r; (void)base; *(u32x4*)p = v; }
#define EPI_FENCE asm volatile("" ::: "memory")
#define EPI_G(g) const int ai = (g) >> 2, m = (g) & 3, row = row0 + ai * 128 + m * 16
struct EpiIn {
    static constexpr bool PERM = true, AFTER_DRAIN = false, PREFETCH = true;
    unsigned char* ws; const float* rowss; PG8_LAS unsigned char* ldsx;
    __device__ __forceinline__ void prefetch(const Unit& u, int wid, int lane) const { const float* src = rowss + u.pm * 256 + (wid >> 2) * 64 + lane;
        __builtin_amdgcn_global_load_lds((const unsigned*)src, (PG8_LAS unsigned*)(ldsx + wid * 512), 4, 0, 0); __builtin_amdgcn_global_load_lds((const unsigned*)(src + 128), (PG8_LAS unsigned*)(ldsx + wid * 512 + 256), 4, 0, 0); }
    __device__ __forceinline__ void operator()(const f32x4 (&acc)[2][2][4][2], const Unit& u, int wr, int wc, int fr, int fq) const {
        bf16_t* const ZB = (bf16_t*)(ws + WS_ZB); bf16_t* const CV = (bf16_t*)(ws + WS_CV); bf16_t* const U = (bf16_t*)(ws + WS_U); bf16_t* const SGA = (bf16_t*)(ws + WS_SGA); bf16_t* const SGS = (bf16_t*)(ws + WS_SGS);
        const int row0 = u.pm * 256 + wr * 64 + fr, pn = u.pn, cw = wc * 32 + 8 * fq;
        const __amdgpu_buffer_rsrc_t rw = __builtin_amdgcn_make_buffer_rsrc(ws, 0, (int)WS_ZEND, WT_FLAGS);
        float rs[8];
#pragma unroll
        for (int g = 0; g < 8; ++g) { EPI_G(g); (void)row; rs[g] = *(const PG8_LAS float*)(ldsx + (wr * 4 + wc) * 512 + ai * 256 + (16 * m + fr) * 4); }
#pragma unroll
        for (int g = 0; g < 8; ++g) rs[g] = rsqrtf(rs[g] * (1.0f / 1024.0f) + EPS);
        if (pn >= 2 && pn < 6) {
            bf16_t* base = CV + (pn - 2) * 128 + cw;
#pragma unroll
            for (int g = 0; g < 8; ++g) { EPI_G(g); const float rs2 = rs[g] * rs[g];
                wt16(rw, ws, base + (size_t)row * 512, pack8(acc[ai][0][m][0] * acc[ai][1][m][0] * rs2, acc[ai][0][m][1] * acc[ai][1][m][1] * rs2)); }
        } else {
            bf16_t* base; int ldc; const bool sg = pn >= 8;
            if (pn < 2) { base = ZB + pn * 256; ldc = 512; } else if (pn < 8) { base = U + (pn - 6) * 256; ldc = 512; } else if (pn < 12) { base = SGA + (pn - 8) * 256; ldc = 1024; } else { base = SGS + (pn - 12) * 256; ldc = 1024; }
            base += cw;
#pragma unroll
            for (int g = 0; g < 8; ++g) { EPI_G(g);
#pragma unroll
                for (int bj = 0; bj < 2; ++bj) { f32x4 v0, v1;
                    if (sg) { const float rl = rs[g] * -1.4426950408889634f; const f32x4 e0 = acc[ai][bj][m][0] * rl, e1 = acc[ai][bj][m][1] * rl;
#pragma unroll
                        for (int j = 0; j < 4; ++j) { v0[j] = __builtin_amdgcn_rcpf(1.0f + __builtin_amdgcn_exp2f(e0[j])); v1[j] = __builtin_amdgcn_rcpf(1.0f + __builtin_amdgcn_exp2f(e1[j])); } }
                    else { v0 = acc[ai][bj][m][0] * rs[g]; v1 = acc[ai][bj][m][1] * rs[g]; }
                    wt16(rw, ws, base + (size_t)row * ldc + bj * 128, pack8(v0, v1)); } }
        }
    }
};
#ifndef PROBE
#define PROBE 0
#endif
struct EpiGU {
    static constexpr bool PERM = true, AFTER_DRAIN = false, PREFETCH = (PROBE != 24);
    unsigned char* ws; const float* rowss; PG8_LAS unsigned char* ldsx;
    __device__ __forceinline__ void prefetch(const Unit& u, int wid, int lane) const { const float* src = rowss + u.pm * 256 + (wid >> 2) * 64 + lane;
        __builtin_amdgcn_global_load_lds((const unsigned*)src, (PG8_LAS unsigned*)(ldsx + wid * 512), 4, 0, 0); __builtin_amdgcn_global_load_lds((const unsigned*)(src + 128), (PG8_LAS unsigned*)(ldsx + wid * 512 + 256), 4, 0, 0); }
    __device__ __forceinline__ void operator()(const f32x4 (&acc)[2][2][4][2], const Unit& u, int wr, int wc, int fr, int fq) const {
        const int row0 = u.pm * 256 + wr * 64 + fr; bf16_t* base = (bf16_t*)(ws + WS_FF) + u.pn * 128 + wc * 32 + 8 * fq;
        const __amdgpu_buffer_rsrc_t rw = __builtin_amdgcn_make_buffer_rsrc(ws, 0, (int)WS_ZEND, WT_FLAGS);
        float rs[8];
#pragma unroll
        for (int g = 0; g < 8; ++g) { EPI_G(g); rs[g] = PREFETCH ? *(const PG8_LAS float*)(ldsx + (wr * 4 + wc) * 512 + ai * 256 + (16 * m + fr) * 4) : rowss[row]; }
        EPI_FENCE;
#pragma unroll
        for (int g = 0; g < 8; ++g) { EPI_G(g); const float r = rsqrtf(rs[g] * (1.0f / 1024.0f) + EPS), r2 = r * r, rl = r * -1.4426950408889634f; f32x4 o[2];
#pragma unroll
            for (int n = 0; n < 2; ++n) { const f32x4 t = acc[ai][0][m][n] * acc[ai][1][m][n] * r2, xe = acc[ai][0][m][n] * rl;
#pragma unroll
                for (int j = 0; j < 4; ++j) o[n][j] = t[j] * __builtin_amdgcn_rcpf(1.0f + __builtin_amdgcn_exp2f(xe[j])); }
            wt16(rw, ws, base + (size_t)row * DFF, pack8(o[0], o[1])); }
    }
};
struct EpiGlu {
    static constexpr bool PERM = true, AFTER_DRAIN = false, PREFETCH = false;
    unsigned char* ws; const float* bias;
    __device__ __forceinline__ void operator()(const f32x4 (&acc)[2][2][4][2], const Unit& u, int wr, int wc, int fr, int fq) const {
        const bf16_t* const GY = (const bf16_t*)(ws + WS_GY); bf16_t* const YS2 = (bf16_t*)(ws + WS_YS2);
        const int row0 = u.pm * 256 + wr * 64 + fr, col0 = u.pn * 256 + wc * 32 + 8 * fq;
        const __amdgpu_buffer_rsrc_t rw = __builtin_amdgcn_make_buffer_rsrc(ws, 0, (int)WS_ZEND, WT_FLAGS);
        f32x4 bv[2][2];
#pragma unroll
        for (int bj = 0; bj < 2; ++bj) { bv[bj][0] = *(const f32x4*)(bias + col0 + bj * 128); bv[bj][1] = *(const f32x4*)(bias + col0 + bj * 128 + 4); }
        u32x4 buf[4][2];
#define GLU_LOAD(g) { EPI_G(g); (void)ai; (void)m; buf[(g) & 3][0] = *(const u32x4*)(GY + (size_t)row * 512 + col0); buf[(g) & 3][1] = *(const u32x4*)(GY + (size_t)row * 512 + col0 + 128); }
        GLU_LOAD(0) GLU_LOAD(1) GLU_LOAD(2)
#pragma unroll
        for (int g = 0; g < 8; ++g) { if (g + 3 < 8) GLU_LOAD(g + 3)
            EPI_FENCE; EPI_G(g);
#pragma unroll
            for (int bj = 0; bj < 2; ++bj) { f32x4 g0, g1; unpack8(buf[g & 3][bj], g0, g1); f32x4 v0 = acc[ai][bj][m][0] + bv[bj][0], v1 = acc[ai][bj][m][1] + bv[bj][1];
#pragma unroll
                for (int j = 0; j < 4; ++j) { v0[j] = g0[j] * sigm(v0[j]); v1[j] = g1[j] * sigm(v1[j]); }
                wt16(rw, ws, YS2 + (size_t)row * 512 + col0 + bj * 128, pack8(v0, v1)); } }
#undef GLU_LOAD
    }
};
template <bool SECOND> struct EpiBr {
    static constexpr bool PERM = true, AFTER_DRAIN = false, PREFETCH = false;
    unsigned char* ws;
    __device__ __forceinline__ void operator()(const f32x4 (&acc)[2][2][4][2], const Unit& u, int wr, int wc, int fr, int fq) const {
        bf16_t* const SGA = (bf16_t*)(ws + WS_SGA); bf16_t* const SGS = (bf16_t*)(ws + WS_SGS);
        const int row0 = u.pm * 256 + wr * 64 + fr, col0 = u.pn * 256 + wc * 32 + 8 * fq;
        const __amdgpu_buffer_rsrc_t rw = __builtin_amdgcn_make_buffer_rsrc(ws, 0, (int)WS_ZEND, WT_FLAGS);
        constexpr int DP = SECOND ? 3 : 4;
        u32x4 sb[DP][2], tb[SECOND ? DP : 1][2];
#define BR_LOAD(g) { EPI_G(g); (void)ai; (void)m; const size_t off = (size_t)row * 1024 + col0; sb[(g) % DP][0] = *(const u32x4*)((SECOND ? SGS : SGA) + off); sb[(g) % DP][1] = *(const u32x4*)((SECOND ? SGS : SGA) + off + 128); \
            if (SECOND) { tb[(g) % DP][0] = *(const u32x4*)(SGA + off); tb[(g) % DP][1] = *(const u32x4*)(SGA + off + 128); } }
        BR_LOAD(0) BR_LOAD(1) if (DP > 3) BR_LOAD(2)
#pragma unroll
        for (int g = 0; g < 8; ++g) { if (g + DP - 1 < 8) BR_LOAD(g + DP - 1)
            EPI_FENCE; EPI_G(g);
#pragma unroll
            for (int bj = 0; bj < 2; ++bj) { const size_t off = (size_t)row * 1024 + col0 + bj * 128; f32x4 s0, s1; unpack8(sb[g % DP][bj], s0, s1);
                if (!SECOND) wt16(rw, ws, SGA + off, pack8(s0 * acc[ai][bj][m][0], s1 * acc[ai][bj][m][1]));
                else { f32x4 t0, t1; unpack8(tb[g % DP][bj], t0, t1); wt16(rw, ws, SGS + off, pack8(t0 + s0 * acc[ai][bj][m][0], t1 + s1 * acc[ai][bj][m][1])); } } }
#undef BR_LOAD
    }
};
struct EpiRes {
    static constexpr bool PERM = true, AFTER_DRAIN = false, PREFETCH = false;
    float* X; unsigned char* ws; float* rowss_out;
    __device__ __forceinline__ void operator()(const f32x4 (&acc)[2][2][4][2], const Unit& u, int wr, int wc, int fr, int fq) const {
        const int row0 = u.pm * 256 + wr * 64 + fr, col0 = u.pn * 256 + wc * 32 + 8 * fq; bf16_t* const XB = (bf16_t*)(ws + WS_XB);
        const __amdgpu_buffer_rsrc_t rw = __builtin_amdgcn_make_buffer_rsrc(ws, 0, (int)WS_ZEND, WT_FLAGS), ro = __builtin_amdgcn_make_buffer_rsrc(X, 0, (int)((size_t)T * D * 4), WT_FLAGS);
        f32x4 xb[3][2][2];
#define RES_LOAD(g) { EPI_G(g); (void)ai; (void)m; const size_t off = (size_t)row * 1024 + col0; xb[(g) % 3][0][0] = *(const f32x4*)(X + off); xb[(g) % 3][0][1] = *(const f32x4*)(X + off + 4); \
            xb[(g) % 3][1][0] = *(const f32x4*)(X + off + 128); xb[(g) % 3][1][1] = *(const f32x4*)(X + off + 132); }
        RES_LOAD(0) RES_LOAD(1)
#pragma unroll
        for (int g = 0; g < 8; ++g) { if (g + 2 < 8) RES_LOAD(g + 2)
            EPI_FENCE; EPI_G(g); float ss = 0.f;
#pragma unroll
            for (int bj = 0; bj < 2; ++bj) { const size_t off = (size_t)row * 1024 + col0 + bj * 128;
                const f32x4 x0 = xb[g % 3][bj][0] + acc[ai][bj][m][0], x1 = xb[g % 3][bj][1] + acc[ai][bj][m][1];
                wt16(ro, X, X + off, __builtin_bit_cast(u32x4, x0)); wt16(ro, X, X + off + 4, __builtin_bit_cast(u32x4, x1)); wt16(rw, ws, XB + off, pack8(x0, x1));
                ss += (x0[0] * x0[0] + x0[1] * x0[1]) + (x0[2] * x0[2] + x0[3] * x0[3]) + (x1[0] * x1[0] + x1[1] * x1[1]) + (x1[2] * x1[2] + x1[3] * x1[3]); }
            ss += __shfl_xor(ss, 16); ss += __shfl_xor(ss, 32);
            if (fq == 0) atomicAdd(rowss_out + row, ss); }
#undef RES_LOAD
    }
};
template <bool PAIRED, int NTB, class F> __device__ __forceinline__ void skinny_unit(PG8_LAS unsigned char* lds, const bf16_t* Act, const bf16_t* Bt, int K, int n0, int n1, int tok0, int tid, const F& epi) {
    const int lane = tid & 63, w = __builtin_amdgcn_readfirstlane(tid >> 6), r16 = lane & 15, q = lane >> 4, ks = K >> 3;
    const bf16_t* wp0 = Bt + (size_t)(n0 + r16) * K + w * ks + 8 * q;
    const bf16_t* wp1 = Bt + (size_t)(n1 + r16) * K + w * ks + 8 * q;
    const bf16_t* ap = Act + (size_t)(tok0 + r16) * K + w * ks + 8 * q;
    f32x4 acc0[NTB], acc1[NTB];
#pragma unroll
    for (int tb = 0; tb < NTB; ++tb) { acc0[tb] = (f32x4){0.f, 0.f, 0.f, 0.f}; acc1[tb] = acc0[tb]; }
#pragma unroll (NTB > 4 ? 2 : 6)
    for (int k0 = 0; k0 < ks; k0 += 32) {
        const pg8::bf16x8 wf0 = __builtin_bit_cast(pg8::bf16x8, *(const u32x4*)(wp0 + k0));
        pg8::bf16x8 wf1 = wf0; if (PAIRED) wf1 = __builtin_bit_cast(pg8::bf16x8, *(const u32x4*)(wp1 + k0));
        pg8::bf16x8 af[NTB];
#pragma unroll
        for (int tb = 0; tb < NTB; ++tb) af[tb] = __builtin_bit_cast(pg8::bf16x8, *(const u32x4*)(ap + (size_t)(tb * 16) * K + k0));
#pragma unroll
        for (int tb = 0; tb < NTB; ++tb) { acc0[tb] = __builtin_amdgcn_mfma_f32_16x16x32_bf16(wf0, af[tb], acc0[tb], 0, 0, 0);
            if (PAIRED) acc1[tb] = __builtin_amdgcn_mfma_f32_16x16x32_bf16(wf1, af[tb], acc1[tb], 0, 0, 0); }
    }
    __syncthreads();
#pragma unroll
    for (int tb = 0; tb < NTB; ++tb) { *(PG8_LAS f32x4*)(lds + ((w * NTB + tb) * 64 + lane) * 16) = acc0[tb]; if (PAIRED) *(PG8_LAS f32x4*)(lds + 65536 + ((w * NTB + tb) * 64 + lane) * 16) = acc1[tb]; }
    __syncthreads();
    if (w < NTB) {
        f32x4 s0 = (f32x4){0.f, 0.f, 0.f, 0.f}, s1 = s0;
#pragma unroll
        for (int ww = 0; ww < 8; ++ww) { s0 += *(const PG8_LAS f32x4*)(lds + ((ww * NTB + w) * 64 + lane) * 16); if (PAIRED) s1 += *(const PG8_LAS f32x4*)(lds + 65536 + ((ww * NTB + w) * 64 + lane) * 16); }
        epi(s0, s1, TP + tok0 + 16 * w + r16, 4 * q);
    }
}
__device__ __forceinline__ u32x2 pack4(const f32x4 v) { u32x2 w; w.x = cvt_pk_bf16(v[0], v[1]); w.y = cvt_pk_bf16(v[2], v[3]); return w; }
__device__ __forceinline__ f32x4 unpack4(const u32x2 w) { return (f32x4){bf_lo(w.x), bf_hi(w.x), bf_lo(w.y), bf_hi(w.y)}; }

struct EpiNull {
    static constexpr bool PERM = true, AFTER_DRAIN = false, PREFETCH = false;
    float* sink;
    __device__ __forceinline__ void operator()(const f32x4 (&acc)[2][2][4][2], const Unit& u, int wr, int wc, int fr, int fq) const {
        if (acc[0][0][0][0][0] == 1.2345e-33f) *sink = 1.f;
    }
};

template <int MODE> struct EpiProbe {
    static constexpr bool PERM = true, AFTER_DRAIN = false, PREFETCH = false;
    unsigned char* ws; float* sink;
    __device__ __forceinline__ void operator()(const f32x4 (&acc)[2][2][4][2], const Unit& u, int wr, int wc, int fr, int fq) const {
        const int row0 = u.pm * 256 + wr * 64 + fr; bf16_t* base = (bf16_t*)(ws + WS_FF) + u.pn * 128 + wc * 32 + 8 * fq;
        if (MODE == 0) {
#pragma unroll
            for (int g = 0; g < 8; ++g) { EPI_G(g); *(u32x4*)(base + (size_t)row * DFF) = pack8(acc[ai][0][m][0] + acc[ai][1][m][0], acc[ai][0][m][1] + acc[ai][1][m][1]); }
        } else {
            f32x4 s = (f32x4){0.f, 0.f, 0.f, 0.f};
#pragma unroll
            for (int g = 0; g < 8; ++g) { EPI_G(g); (void)row; s += acc[ai][0][m][0] + acc[ai][1][m][0] + acc[ai][0][m][1] + acc[ai][1][m][1]; }
            if (s[0] + s[1] + s[2] + s[3] == 1.2345e-33f) *sink = 1.f;
        }
    }
};
__device__ __forceinline__ int otid() { int t = threadIdx.x; asm volatile("" : "+v"(t)); return t; }
struct Args { const float* in[25]; float* out; unsigned char* ws; int ph_lo, ph_hi; };
enum { I_XP = 0, I_XS, I_SCONV, I_SRE, I_SIM, I_N1G, I_WIN, I_CONVW, I_CONVB, I_LRE, I_LIM, I_LDT, I_BRE, I_BIM, I_CRE, I_CIM, I_SD, I_WGLU, I_BGLU, I_WBR, I_WOUT, I_N2G, I_WGU, I_WDN, I_FG };

__device__ __forceinline__ int perm_in(int n0) { if (n0 < 512 || n0 >= 1536) return n0; const int q = n0 - 512, tl = q >> 8, rr = q & 255; return rr < 128 ? 512 + tl * 128 + rr : 1024 + tl * 128 + (rr - 128); }
__device__ __forceinline__ int perm_gu(int n0) { const int tl = n0 >> 8, rr = n0 & 255; return rr < 128 ? tl * 128 + rr : DFF + tl * 128 + (rr - 128); }

constexpr int P0_PER = 256 + 16 + 32 + 32 + 64 + 352 + 176;
__device__ __forceinline__ void p0_weights(const Args& a, float* tile, int it_lo, int it_hi, int vb, int nvb) {
    constexpr int PER = P0_PER, TP_ = 260;
    unsigned char* ws = a.ws; const int tid = otid(); const __amdgpu_buffer_rsrc_t rwp = __builtin_amdgcn_make_buffer_rsrc(ws, 0, (int)WS_ZEND, WT_FLAGS);
    for (int it = it_lo + vb; it < it_hi; it += nvb) {
        const int l = it / PER; int r = it % PER;
        const float* src; const float* gs = nullptr; bf16_t* dst; int ldn, K, n0, k0, sn0, sn1;
        if (r < 256) { n0 = (r >> 4) * 256; k0 = (r & 15) * 64; src = a.in[I_WIN] + (size_t)l * 1024 * 4096; ldn = 4096; K = 1024; dst = (bf16_t*)(ws + WS_WIN + l * SZ_WIN); gs = a.in[I_N1G] + l * 1024; sn0 = perm_in(n0); sn1 = perm_in(n0 + 128); }
        else if ((r -= 256) < 16) { n0 = (r >> 3) * 256; k0 = (r & 7) * 64; src = a.in[I_WGLU] + (size_t)l * 512 * 512; ldn = 512; K = 512; dst = (bf16_t*)(ws + WS_WGLU + l * SZ_WGLU); sn0 = n0; sn1 = n0 + 128; }
        else if ((r -= 16) < 32) { n0 = (r >> 3) * 256; k0 = (r & 7) * 64; src = a.in[I_WBR] + (size_t)l * 1024 * 1024; ldn = 1024; K = 512; dst = (bf16_t*)(ws + WS_WBA + l * SZ_WB); sn0 = n0; sn1 = n0 + 128; }
        else if ((r -= 32) < 32) { n0 = (r >> 3) * 256; k0 = (r & 7) * 64; src = a.in[I_WBR] + (size_t)l * 1024 * 1024 + (size_t)512 * 1024; ldn = 1024; K = 512; dst = (bf16_t*)(ws + WS_WBB + l * SZ_WB); sn0 = n0; sn1 = n0 + 128; }
        else if ((r -= 32) < 64) { n0 = (r >> 4) * 256; k0 = (r & 15) * 64; src = a.in[I_WOUT] + (size_t)l * 1024 * 1024; ldn = 1024; K = 1024; dst = (bf16_t*)(ws + WS_WOUT + l * SZ_WOUT); sn0 = n0; sn1 = n0 + 128; }
        else if ((r -= 64) < 352) { n0 = (r >> 4) * 256; k0 = (r & 15) * 64; src = a.in[I_WGU] + (size_t)l * 1024 * 5632; ldn = 5632; K = 1024; dst = (bf16_t*)(ws + WS_WGU + l * SZ_WGU); gs = a.in[I_N2G] + l * 1024; sn0 = perm_gu(n0); sn1 = perm_gu(n0 + 128); }
        else { r -= 352; n0 = (r / 44) * 256; k0 = (r % 44) * 64; src = a.in[I_WDN] + (size_t)l * DFF * 1024; ldn = 1024; K = DFF; dst = (bf16_t*)(ws + WS_WDN + l * SZ_WDN); sn0 = n0; sn1 = n0 + 128; }
        f32x4 v[8];
#pragma unroll
        for (int j = 0; j < 8; ++j) { const int idx = tid + 512 * j, k = idx >> 6, n = (idx & 63) * 4; v[j] = *(const f32x4*)(src + (size_t)(k0 + k) * ldn + (n < 128 ? sn0 + n : sn1 + n - 128)); }
        __syncthreads();
#pragma unroll
        for (int j = 0; j < 8; ++j) { const int idx = tid + 512 * j, k = idx >> 6, n = (idx & 63) * 4; f32x4 x = v[j]; if (gs) x *= gs[k0 + k]; *(f32x4*)(tile + k * TP_ + n) = x; }
        __syncthreads();
#pragma unroll
        for (int j = 0; j < 4; ++j) { const int idx = tid + 512 * j, n = idx & 255, kg = idx >> 8; const float* tp = tile + (8 * kg) * TP_ + n; u32x4 w;
            w.x = cvt_pk_bf16(tp[0], tp[TP_]); w.y = cvt_pk_bf16(tp[2 * TP_], tp[3 * TP_]); w.z = cvt_pk_bf16(tp[4 * TP_], tp[5 * TP_]); w.w = cvt_pk_bf16(tp[6 * TP_], tp[7 * TP_]);
            wt16(rwp, ws, dst + (size_t)(n0 + n) * K + k0 + 8 * kg, w); }
    }
}
__device__ __forceinline__ void p0_ssm(const Args& a) {
    float* ABAR = (float*)(a.ws + WS_ABAR); float* APOW = (float*)(a.ws + WS_APOW); float* BBAR = (float*)(a.ws + WS_BBAR); u32x4* BBF = (u32x4*)(a.ws + WS_BBF); const int tx0_ = otid();
    for (int i = blockIdx.x * 512 + tx0_; i < NL * NG * NP; i += gridDim.x * 512) {
        const int lg = i >> 6;
        const float dt = expf(a.in[I_LDT][lg]), lr = a.in[I_LRE][i], li = a.in[I_LIM][i];
        const float mag = expf(lr * dt), ang = li * dt; float sn, cs; sincosf(ang, &sn, &cs);
        const float ar = mag * cs, ai = mag * sn, nr = ar - 1.0f, ni = ai, den = lr * lr + li * li, fr = (nr * lr + ni * li) / den, fi = (ni * lr - nr * li) / den;
        ABAR[2 * i] = ar; ABAR[2 * i + 1] = ai;
        float pr = ar, pi = ai;
#pragma unroll
        for (int s = 0; s < 6; ++s) { const float tr = pr * pr - pi * pi, ti = 2.0f * pr * pi; pr = tr; pi = ti; }
        APOW[2 * i] = pr; APOW[2 * i + 1] = pi;
        float bbr[16], bbi[16];
#pragma unroll
        for (int c = 0; c < 16; ++c) { const float br = a.in[I_BRE][(size_t)i * 16 + c], bi = a.in[I_BIM][(size_t)i * 16 + c]; bbr[c] = fr * br - fi * bi; bbi[c] = fr * bi + fi * br; BBAR[((size_t)lg * 32 + c) * NP + (i & 63)] = bbr[c]; BBAR[((size_t)lg * 32 + 16 + c) * NP + (i & 63)] = bbi[c]; }
        const int p = i & 63, sh = p >> 5, n = p & 31;
#pragma unroll
        for (int h = 0; h < 2; ++h) {
            u32x4 wr_, wi_; wr_.x = cvt_pk_bf16(bbr[8 * h], bbr[8 * h + 1]); wr_.y = cvt_pk_bf16(bbr[8 * h + 2], bbr[8 * h + 3]); wr_.z = cvt_pk_bf16(bbr[8 * h + 4], bbr[8 * h + 5]); wr_.w = cvt_pk_bf16(bbr[8 * h + 6], bbr[8 * h + 7]);
            wi_.x = cvt_pk_bf16(bbi[8 * h], bbi[8 * h + 1]); wi_.y = cvt_pk_bf16(bbi[8 * h + 2], bbi[8 * h + 3]); wi_.z = cvt_pk_bf16(bbi[8 * h + 4], bbi[8 * h + 5]); wi_.w = cvt_pk_bf16(bbi[8 * h + 6], bbi[8 * h + 7]);
            BBF[((size_t)lg * 4 + 2 * sh) * 64 + 32 * h + n] = wr_; BBF[((size_t)lg * 4 + 2 * sh + 1) * 64 + 32 * h + n] = wi_; }
    }
    u32x4* CMF = (u32x4*)(a.ws + WS_CMF);
    for (int i = blockIdx.x * 512 + tx0_; i < NL * NG * 5 * 64; i += gridDim.x * 512) {
        const int lane = i & 63, ks = (i >> 6) % 5, lg = i / 320, ch = lane & 15, q = lane >> 4; float v[8];
#pragma unroll
        for (int j = 0; j < 8; ++j) {
            if (ks < 4) { const int k = 32 * ks + 8 * q + j, sh = k >> 6, kk = k & 63, p = sh * 32 + (kk >> 1); const size_t ci = ((size_t)lg * 16 + ch) * NP + p; v[j] = (kk & 1) ? -a.in[I_CIM][ci] : a.in[I_CRE][ci]; }
            else v[j] = (8 * q + j == ch) ? a.in[I_SD][(size_t)lg * 16 + ch] : 0.f; }
        u32x4 w; w.x = cvt_pk_bf16(v[0], v[1]); w.y = cvt_pk_bf16(v[2], v[3]); w.z = cvt_pk_bf16(v[4], v[5]); w.w = cvt_pk_bf16(v[6], v[7]); CMF[i] = w;
    }
}
__device__ __forceinline__ void p0_x(const Args& a) {
    float* X = a.out; bf16_t* XB = (bf16_t*)(a.ws + WS_XB); float* RS = (float*)(a.ws + WS_ROWSS);
    int tx_ = threadIdx.x; asm volatile("" : "+v"(tx_)); const int lane = tx_ & 63, gw = blockIdx.x * 8 + (tx_ >> 6), nw = gridDim.x * 8;
    for (int i = blockIdx.x * 512 + tx_; i < 9 * MP; i += gridDim.x * 512) if (i >= T) RS[i] = 0.f;
    for (int r0 = gw; r0 < T; r0 += 2 * nw) {
        f32x4 v[2][4];
#pragma unroll
        for (int k = 0; k < 2; ++k) { const int row = r0 + k * nw; if (row < T) { const float* src = row < TP ? a.in[I_XP] + (size_t)row * D : a.in[I_XS] + (size_t)(row - TP) * D;
#pragma unroll
            for (int j = 0; j < 2; ++j) { const int c = j * 512 + lane * 8; v[k][2 * j] = *(const f32x4*)(src + c); v[k][2 * j + 1] = *(const f32x4*)(src + c + 4); } } }
#pragma unroll
        for (int k = 0; k < 2; ++k) { const int row = r0 + k * nw; if (row < T) { float ss = 0.f;
#pragma unroll
            for (int j = 0; j < 2; ++j) { const int c = j * 512 + lane * 8; const f32x4 v0 = v[k][2 * j], v1 = v[k][2 * j + 1];
                *(f32x4*)(X + (size_t)row * D + c) = v0; *(f32x4*)(X + (size_t)row * D + c + 4) = v1; *(u32x4*)(XB + (size_t)row * D + c) = pack8(v0, v1);
                ss += (v0[0] * v0[0] + v0[1] * v0[1]) + (v0[2] * v0[2] + v0[3] * v0[3]) + (v1[0] * v1[0] + v1[1] * v1[1]) + (v1[2] * v1[2] + v1[3] * v1[3]); }
#pragma unroll
            for (int o = 32; o >= 1; o >>= 1) ss += __shfl_xor(ss, o);
            if (lane == 0) RS[row] = ss; } }
    }
}
__device__ __forceinline__ void final_norm(const Args& a) {
    float* X = a.out; const float* RS = (const float*)(a.ws + WS_ROWSS) + 8 * (size_t)MP; const float* g = a.in[I_FG];
    int tx_ = threadIdx.x; asm volatile("" : "+v"(tx_)); const int lane = tx_ & 63, gw = blockIdx.x * 8 + (tx_ >> 6), nw = gridDim.x * 8;
    f32x4 gg[4];
#pragma unroll
    for (int j = 0; j < 4; ++j) gg[j] = *(const f32x4*)(g + j * 256 + lane * 4);
    for (int r0 = gw; r0 < T; r0 += 2 * nw) {
        f32x4 v[2][4]; float rsv[2];
#pragma unroll
        for (int k = 0; k < 2; ++k) { const int row = r0 + k * nw; if (row < T) { rsv[k] = RS[row];
#pragma unroll
            for (int j = 0; j < 4; ++j) v[k][j] = *(const f32x4*)(X + (size_t)row * D + j * 256 + lane * 4); } }
#pragma unroll
        for (int k = 0; k < 2; ++k) { const int row = r0 + k * nw; if (row < T) { const float rs = rsqrtf(rsv[k] * (1.0f / 1024.0f) + EPS);
#pragma unroll
            for (int j = 0; j < 4; ++j) *(f32x4*)(X + (size_t)row * D + j * 256 + lane * 4) = v[k][j] * rs * gg[j]; } }
    }
}
__device__ __forceinline__ void conv_phase(const Args& a, int l) {
    bf16_t* ZB = (bf16_t*)(a.ws + WS_ZB); const bf16_t* CV = (const bf16_t*)(a.ws + WS_CV);
    const float* cw = a.in[I_CONVW] + (size_t)l * 3 * CW; const float* cb = a.in[I_CONVB] + (size_t)l * CW; const float* sc = a.in[I_SCONV] + (size_t)l * TS * 2 * CW;
    const int txc_ = otid(); const int c8 = (txc_ & 63) * 8; const __amdgpu_buffer_rsrc_t rwc = __builtin_amdgcn_make_buffer_rsrc(a.ws, 0, (int)WS_ZEND, WT_FLAGS);
    const f32x4 w0a = *(const f32x4*)(cw + c8), w0b = *(const f32x4*)(cw + c8 + 4), w1a = *(const f32x4*)(cw + CW + c8), w1b = *(const f32x4*)(cw + CW + c8 + 4),
                w2a = *(const f32x4*)(cw + 2 * CW + c8), w2b = *(const f32x4*)(cw + 2 * CW + c8 + 4), ba = *(const f32x4*)(cb + c8), bb = *(const f32x4*)(cb + c8 + 4);
    const f32x4 zero = (f32x4){0.f, 0.f, 0.f, 0.f};
    for (int r0 = blockIdx.x * 8 + (txc_ >> 6); r0 < T; r0 += gridDim.x * 32) {
        u32x4 zr[4], x0r[4], x1r[4], x2r[4]; f32x4 s1a[4], s1b[4], s2a[4], s2b[4];
#pragma unroll
        for (int k = 0; k < 4; ++k) { const int row = r0 + k * gridDim.x * 8; if (row < T) { const size_t off = (size_t)row * 512 + c8;
            zr[k] = *(const u32x4*)(ZB + off); x0r[k] = *(const u32x4*)(CV + off);
            if (row < TP) { const int t = row & (SEQ - 1); x1r[k] = (u32x4){0u, 0u, 0u, 0u}; x2r[k] = x1r[k]; if (t >= 1) x1r[k] = *(const u32x4*)(CV + off - 512); if (t >= 2) x2r[k] = *(const u32x4*)(CV + off - 1024); }
            else { const float* s0 = sc + (size_t)(row - TP) * 2 * CW + c8; s2a[k] = *(const f32x4*)s0; s2b[k] = *(const f32x4*)(s0 + 4); s1a[k] = *(const f32x4*)(s0 + CW); s1b[k] = *(const f32x4*)(s0 + CW + 4); } } }
        asm volatile("" ::: "memory");
#pragma unroll
        for (int k = 0; k < 4; ++k) { const int row = r0 + k * gridDim.x * 8; if (row < T) { const size_t off = (size_t)row * 512 + c8;
            f32x4 z0, z1, x0a, x0b, x1a, x1b, x2a, x2b; unpack8(zr[k], z0, z1); unpack8(x0r[k], x0a, x0b);
            if (row < TP) { const int t = row & (SEQ - 1); unpack8(x1r[k], x1a, x1b); unpack8(x2r[k], x2a, x2b);
                if (t >= SEQ - 2) { float* o = a.out + O_PC + ((size_t)(l * NB + (row >> 11)) * 2 + (t - (SEQ - 2))) * CW + c8; *(f32x4*)o = x0a; *(f32x4*)(o + 4) = x0b; } }
            else { const int b = row - TP; x1a = s1a[k]; x1b = s1b[k]; x2a = s2a[k]; x2b = s2b[k];
                float* o = a.out + O_SC + (size_t)(l * TS + b) * 2 * CW + c8; *(f32x4*)o = x1a; *(f32x4*)(o + 4) = x1b; *(f32x4*)(o + CW) = x0a; *(f32x4*)(o + CW + 4) = x0b; }
            const f32x4 oa = z0 * (ba + w0a * x2a + w1a * x1a + w2a * x0a), ob = z1 * (bb + w0b * x2b + w1b * x1b + w2b * x0b);
            wt16(rwc, a.ws, ZB + off, pack8(oa, ob)); } }
    }
}
struct SsmW { float ar, ai; float bbr[16], bbi[16]; };
template <bool OUT> __device__ __forceinline__ void ssm_run(const bf16_t* U, bf16_t* GY, int row0, int ntok, int g, float& hr, float& hi, const float ar, const float ai,
                                                            const float (&bbr)[16], const float (&bbi)[16], const float (&cr)[16], const float (&ci)[16], const float (&dl)[16], int lane) {
    for (int t0 = 0; t0 < ntok; t0 += 64) {
        const int nt = (ntok - t0) < 64 ? (ntok - t0) : 64;
        u32x4 w0 = (u32x4){0u, 0u, 0u, 0u}, w1 = w0;
        if (lane < nt) { const u32x4* up = (const u32x4*)(U + (size_t)(row0 + t0 + lane) * 512 + g * 16); w0 = up[0]; w1 = up[1]; }
        for (int j = 0; j < nt; ++j) {
            unsigned ws_[8]; ws_[0] = __builtin_amdgcn_readlane(w0.x, j); ws_[1] = __builtin_amdgcn_readlane(w0.y, j); ws_[2] = __builtin_amdgcn_readlane(w0.z, j); ws_[3] = __builtin_amdgcn_readlane(w0.w, j);
            ws_[4] = __builtin_amdgcn_readlane(w1.x, j); ws_[5] = __builtin_amdgcn_readlane(w1.y, j); ws_[6] = __builtin_amdgcn_readlane(w1.z, j); ws_[7] = __builtin_amdgcn_readlane(w1.w, j);
            float uu[16];
#pragma unroll
            for (int q = 0; q < 8; ++q) { uu[2 * q] = bf_lo(ws_[q]); uu[2 * q + 1] = bf_hi(ws_[q]); }
            float bur = 0.f, bui = 0.f;
#pragma unroll
            for (int c = 0; c < 16; ++c) { bur = fmaf(bbr[c], uu[c], bur); bui = fmaf(bbi[c], uu[c], bui); }
            const float nhr = ar * hr - ai * hi + bur, nhi = ar * hi + ai * hr + bui; hr = nhr; hi = nhi;
            if (OUT) {
                float v[16];
#pragma unroll
                for (int c = 0; c < 16; ++c) v[c] = fmaf(dl[c], uu[c], cr[c] * hr - ci[c] * hi);
                float w8[8], w4[4], w2[2], w1_;
                { const bool up = lane & 32;
#pragma unroll
                  for (int k = 0; k < 8; ++k) { const float send = up ? v[k] : v[k + 8], keep = up ? v[k + 8] : v[k]; w8[k] = keep + __shfl_xor(send, 32); } }
                { const bool up = lane & 16;
#pragma unroll
                  for (int k = 0; k < 4; ++k) { const float send = up ? w8[k] : w8[k + 4], keep = up ? w8[k + 4] : w8[k]; w4[k] = keep + __shfl_xor(send, 16); } }
                { const bool up = lane & 8;
#pragma unroll
                  for (int k = 0; k < 2; ++k) { const float send = up ? w4[k] : w4[k + 2], keep = up ? w4[k + 2] : w4[k]; w2[k] = keep + __shfl_xor(send, 8); } }
                { const bool up = lane & 4; const float send = up ? w2[0] : w2[1], keep = up ? w2[1] : w2[0]; w1_ = keep + __shfl_xor(send, 4); }
                w1_ += __shfl_xor(w1_, 2); w1_ += __shfl_xor(w1_, 1);
                const float gy = 0.5f * w1_ * (1.0f + erff(w1_ * 0.70710678118f));
                if ((lane & 3) == 0) GY[(size_t)(row0 + t0 + j) * 512 + g * 16 + (lane >> 2)] = (bf16_t)(cvt_pk_bf16(gy, gy) & 0xffffu);
            }
        }
    }
}
__device__ __forceinline__ void ssm_sample_phase(const Args& a, int l) {
    const bf16_t* U = (const bf16_t*)(a.ws + WS_U); bf16_t* GY = (bf16_t*)(a.ws + WS_GY);
    const float* ABAR = (const float*)(a.ws + WS_ABAR); const float* BBAR = (const float*)(a.ws + WS_BBAR);
    int tx_ = threadIdx.x; asm volatile("" : "+v"(tx_)); const int lane = tx_ & 63, gw = blockIdx.x * 8 + (tx_ >> 6), nw = gridDim.x * 8;
    for (int item = gw; item < TS * NG; item += nw) {
        const int b = item >> 5, g = item & 31, i = (l * NG + g) * NP + lane;
        const float ar = ABAR[2 * i], ai = ABAR[2 * i + 1];
        float bbr[16], bbi[16], cr[16], ci[16], dl[16];
#pragma unroll
        for (int c = 0; c < 16; ++c) { bbr[c] = BBAR[((size_t)(l * NG + g) * 32 + c) * NP + lane]; bbi[c] = BBAR[((size_t)(l * NG + g) * 32 + 16 + c) * NP + lane]; const size_t ci_ = ((size_t)(l * NG + g) * 16 + c) * NP + lane; cr[c] = a.in[I_CRE][ci_]; ci[c] = a.in[I_CIM][ci_]; dl[c] = lane == 0 ? a.in[I_SD][(size_t)l * 512 + g * 16 + c] : 0.f; }
        const size_t si = ((size_t)(l * TS + b) * NG + g) * NP + lane; float hr = a.in[I_SRE][si], hi = a.in[I_SIM][si];
        ssm_run<true>(U, GY, TP + b, 1, g, hr, hi, ar, ai, bbr, bbi, cr, ci, dl, lane);
        a.out[O_SRE + si] = hr; a.out[O_SIM + si] = hi;
    }
}
typedef float f32x16 __attribute__((ext_vector_type(16)));
constexpr int SSM_HP = 272, SSM_WAVE_LDS = 32 * SSM_HP;
__device__ __forceinline__ void ssm_pass1_dual(const Args& a, int l) {
    const bf16_t* U = (const bf16_t*)(a.ws + WS_U); const float* ABAR = (const float*)(a.ws + WS_ABAR); float* E = (float*)(a.ws + WS_E); const u32x4* BBF = (const u32x4*)(a.ws + WS_BBF);
    int tx_ = threadIdx.x; asm volatile("" : "+v"(tx_)); const int lane = tx_ & 63, gw = blockIdx.x * 8 + (tx_ >> 6), nw = gridDim.x * 8, n = lane & 31, hh = lane >> 5;
    for (int item = gw; item < NB * NG * 8; item += nw) {
        const int b0 = item >> 9, g = (item >> 4) & 31, ch = item & 15, lg = l * NG + g;
        float ar[2], ai[2], hr[2][2] = {{0.f, 0.f}, {0.f, 0.f}}, hi[2][2] = {{0.f, 0.f}, {0.f, 0.f}};
#pragma unroll
        for (int sh = 0; sh < 2; ++sh) { const int i = lg * NP + sh * 32 + n; ar[sh] = ABAR[2 * i]; ai[sh] = ABAR[2 * i + 1]; }
        pg8::bf16x8 bf[4];
#pragma unroll
        for (int ct = 0; ct < 4; ++ct) bf[ct] = __builtin_bit_cast(pg8::bf16x8, BBF[((size_t)lg * 4 + ct) * 64 + lane]);
        const bf16_t* up0 = U + (size_t)(b0 * SEQ + ch * 128 + 64 * ((n >> 2) & 1) + 4 * (n >> 3) + (n & 3)) * 512 + g * 16 + 8 * hh;
        u32x4 cur0 = *(const u32x4*)up0, cur1 = *(const u32x4*)(up0 + (size_t)4 * SEQ * 512);
#pragma unroll 1
        for (int rt = 0; rt < 4; ++rt) {
            const int rn = rt < 3 ? rt + 1 : 3;
            const u32x4 nxt0 = *(const u32x4*)(up0 + (size_t)(16 * rn) * 512), nxt1 = *(const u32x4*)(up0 + (size_t)(4 * SEQ + 16 * rn) * 512);
            f32x16 acc[2][4];
#pragma unroll
            for (int ct = 0; ct < 4; ++ct) { f32x16 z;
#pragma unroll
                for (int i = 0; i < 16; ++i) z[i] = 0.f;
                acc[0][ct] = __builtin_amdgcn_mfma_f32_32x32x16_bf16(__builtin_bit_cast(pg8::bf16x8, cur0), bf[ct], z, 0, 0, 0);
                acc[1][ct] = __builtin_amdgcn_mfma_f32_32x32x16_bf16(__builtin_bit_cast(pg8::bf16x8, cur1), bf[ct], z, 0, 0, 0); }
#pragma unroll
            for (int i = 0; i < 16; ++i)
#pragma unroll
                for (int sh = 0; sh < 2; ++sh)
#pragma unroll
                    for (int it = 0; it < 2; ++it) { const float nr = ar[sh] * hr[it][sh] - ai[sh] * hi[it][sh] + acc[it][2 * sh][i], ni = ar[sh] * hi[it][sh] + ai[sh] * hr[it][sh] + acc[it][2 * sh + 1][i]; hr[it][sh] = nr; hi[it][sh] = ni; }
            cur0 = nxt0; cur1 = nxt1;
        }
#pragma unroll
        for (int it = 0; it < 2; ++it)
#pragma unroll
            for (int sh = 0; sh < 2; ++sh) { const size_t ei = (((size_t)((b0 + 4 * it) * NG + g) * NCH + 2 * ch + hh) * NP + sh * 32 + n) * 2; E[ei] = hr[it][sh]; E[ei + 1] = hi[it][sh]; }
    }
}
template <bool PASS2> __device__ __forceinline__ void ssm_mfma_phase(const Args& a, int l, PG8_LAS unsigned char* lds) {
    const bf16_t* U = (const bf16_t*)(a.ws + WS_U); bf16_t* GY = (bf16_t*)(a.ws + WS_GY);
    const float* ABAR = (const float*)(a.ws + WS_ABAR); const float* APOW = (const float*)(a.ws + WS_APOW); float* E = (float*)(a.ws + WS_E);
    const u32x4* BBF = (const u32x4*)(a.ws + WS_BBF); const u32x4* CMF = (const u32x4*)(a.ws + WS_CMF);
    int tx_ = threadIdx.x; asm volatile("" : "+v"(tx_)); const int lane = tx_ & 63, wid = tx_ >> 6, gw = blockIdx.x * 8 + wid, nw = gridDim.x * 8;
    const int n = lane & 31, hh = lane >> 5, t16 = lane & 15, q = lane >> 4;
    PG8_LAS unsigned char* hl = lds + wid * SSM_WAVE_LDS;
    PG8_LAS float* Elds = (PG8_LAS float*)(lds + 81920);
    (void)gw; (void)nw; (void)E;
#pragma unroll 1
    for (int kk = 0; kk < 2; ++kk) {
        const int b = blockIdx.x >> 5, g = blockIdx.x & 31, ch = 2 * wid + kk, lg = l * NG + g;
        float ar[2], ai[2], hr[2] = {0.f, 0.f}, hi[2] = {0.f, 0.f};
#pragma unroll
        for (int sh = 0; sh < 2; ++sh) { const int i = lg * NP + sh * 32 + n; ar[sh] = ABAR[2 * i]; ai[sh] = ABAR[2 * i + 1]; }
        pg8::bf16x8 bf[4];
#pragma unroll
        for (int ct = 0; ct < 4; ++ct) bf[ct] = __builtin_bit_cast(pg8::bf16x8, BBF[((size_t)lg * 4 + ct) * 64 + lane]);
        pg8::bf16x8 cm[5];
        if (PASS2) {
#pragma unroll
            for (int ks = 0; ks < 5; ++ks) cm[ks] = __builtin_bit_cast(pg8::bf16x8, CMF[((size_t)lg * 5 + ks) * 64 + lane]);
            const int sc = 2 * ch + hh; float pr[2], pi[2];
#pragma unroll
            for (int sh = 0; sh < 2; ++sh) { const int i = lg * NP + sh * 32 + n; pr[sh] = APOW[2 * i]; pi[sh] = APOW[2 * i + 1]; }
            typedef float f32x2_ __attribute__((ext_vector_type(2)));
            const PG8_LAS f32x2_* Eb = (const PG8_LAS f32x2_*)Elds + n;
            for (int jb = 0; jb < 2 * ch + 1; jb += 8) {
                f32x2_ e0[8], e1[8];
#pragma unroll
                for (int jj = 0; jj < 8; ++jj) { e0[jj] = Eb[(jb + jj) * NP]; e1[jj] = Eb[(jb + jj) * NP + 32]; }
#pragma unroll
                for (int jj = 0; jj < 8; ++jj) if (jb + jj < sc) {
                    const float tr0 = pr[0] * hr[0] - pi[0] * hi[0] + e0[jj].x, ti0 = pr[0] * hi[0] + pi[0] * hr[0] + e0[jj].y; hr[0] = tr0; hi[0] = ti0;
                    const float tr1 = pr[1] * hr[1] - pi[1] * hi[1] + e1[jj].x, ti1 = pr[1] * hi[1] + pi[1] * hr[1] + e1[jj].y; hr[1] = tr1; hi[1] = ti1; }
            }
        }
        const int row0 = b * SEQ + ch * 128;
        u32x4 afr4[4], uw4[4][2];
#pragma unroll
        for (int rt = 0; rt < 4; ++rt) {
            const int tau = 64 * ((n >> 2) & 1) + 16 * rt + 4 * (n >> 3) + (n & 3);
            afr4[rt] = *(const u32x4*)(U + (size_t)(row0 + tau) * 512 + g * 16 + 8 * hh);
            if (PASS2) {
#pragma unroll
                for (int tb = 0; tb < 2; ++tb) { uw4[rt][tb] = (u32x4){0u, 0u, 0u, 0u}; if (q < 2) uw4[rt][tb] = *(const u32x4*)(U + (size_t)(row0 + 64 * tb + 16 * rt + t16) * 512 + g * 16 + 8 * q); } }
        }
#pragma unroll
        for (int rt = 0; rt < 4; ++rt) {
            const pg8::bf16x8 afr = __builtin_bit_cast(pg8::bf16x8, afr4[rt]);
            f32x16 acc[4];
#pragma unroll
            for (int ct = 0; ct < 4; ++ct) { f32x16 z;
#pragma unroll
                for (int i = 0; i < 16; ++i) z[i] = 0.f;
                acc[ct] = __builtin_amdgcn_mfma_f32_32x32x16_bf16(afr, bf[ct], z, 0, 0, 0); }
#pragma unroll
            for (int sh = 0; sh < 2; ++sh)
#pragma unroll
                for (int i = 0; i < 16; ++i) { const float nr = ar[sh] * hr[sh] - ai[sh] * hi[sh] + acc[2 * sh][i], ni = ar[sh] * hi[sh] + ai[sh] * hr[sh] + acc[2 * sh + 1][i]; hr[sh] = nr; hi[sh] = ni;
                    if (PASS2) *(PG8_LAS unsigned*)(hl + (16 * hh + i) * SSM_HP + sh * 128 + 4 * n) = cvt_pk_bf16(nr, ni); }
            if (PASS2) {
                asm volatile("s_waitcnt lgkmcnt(0)" ::: "memory");
#pragma unroll
                for (int tb = 0; tb < 2; ++tb) {
                    f32x4 y = (f32x4){0.f, 0.f, 0.f, 0.f};
#pragma unroll
                    for (int ks = 0; ks < 4; ++ks) { const pg8::bf16x8 hf = __builtin_bit_cast(pg8::bf16x8, *(const PG8_LAS u32x4*)(hl + (16 * tb + t16) * SSM_HP + (32 * ks + 8 * q) * 2)); y = __builtin_amdgcn_mfma_f32_16x16x32_bf16(cm[ks], hf, y, 0, 0, 0); }
                    const size_t trow = (size_t)(row0 + 64 * tb + 16 * rt + t16) * 512 + g * 16;
                    y = __builtin_amdgcn_mfma_f32_16x16x32_bf16(cm[4], __builtin_bit_cast(pg8::bf16x8, uw4[rt][tb]), y, 0, 0, 0);
                    const pg8::f32x2 ga = pg8::gelu_pk((pg8::f32x2){y[0], y[1]}), gb = pg8::gelu_pk((pg8::f32x2){y[2], y[3]});
                    u32x2 w; w.x = cvt_pk_bf16(ga.x, ga.y); w.y = cvt_pk_bf16(gb.x, gb.y); *(u32x2*)(GY + trow + 4 * q) = w;
                }
                asm volatile("s_waitcnt lgkmcnt(0)" ::: "memory");
            }
        }
        if (!PASS2) {
#pragma unroll
            for (int sh = 0; sh < 2; ++sh) { const int ei = ((2 * ch + hh) * NP + sh * 32 + n) * 2; Elds[ei] = hr[sh]; Elds[ei + 1] = hi[sh]; }
        } else if (ch == 15 && hh == 1) {
#pragma unroll
            for (int sh = 0; sh < 2; ++sh) { const size_t oi = ((size_t)(l * NB + b) * NG + g) * NP + sh * 32 + n; a.out[O_PRE + oi] = hr[sh]; a.out[O_PIM + oi] = hi[sh]; }
        }
    }
}
#define XB_TMO      128
#define XB_XCNT(j)  (256  + 64 * (j))
#define XB_XSUB(j)  (1280 + 64 * (j))
#define XB_XGEN(j)  (2304 + 64 * (j))
#define XB_TOP      3328
#define XB_TOPGEN   3392
#define XCD_BAR_WORDS 3456
#define XB_SPIN_CAP (1u << 18)

__device__ __forceinline__ unsigned xb_ld(unsigned* p)              { return __hip_atomic_load(p, __ATOMIC_RELAXED, __HIP_MEMORY_SCOPE_AGENT); }
__device__ __forceinline__ unsigned xb_add(unsigned* p, unsigned v) { return __hip_atomic_fetch_add(p, v, __ATOMIC_RELAXED, __HIP_MEMORY_SCOPE_AGENT); }
__device__ __forceinline__ unsigned xb_xcc_id() { return (unsigned)__builtin_amdgcn_s_getreg((3 << 11) | 20) & 0xFu; }
#define XB_SPIN(cond, bar) do { unsigned _sp = 0; while (cond) { __builtin_amdgcn_s_sleep(1); \
    if ((++_sp & 255u) == 0u) { if (xb_ld(&(bar)[XB_TMO])) break; if (_sp > XB_SPIN_CAP) { atomicAdd(&(bar)[XB_TMO], 1u); break; } } } } while (0)

struct XcdBarrier {
    unsigned* bar; unsigned x;
    volatile PG8_LAS unsigned* st;
};

__device__ __forceinline__ XcdBarrier xcd_barrier_post(unsigned* bar, volatile PG8_LAS unsigned* st) {
    XcdBarrier b; b.bar = bar; b.x = xb_xcc_id(); b.st = st;
    if (threadIdx.x == 0) { st[2] = xb_add(&bar[XB_XCNT(b.x)], 1u); st[3] = b.x; }
    return b;
}
__device__ __forceinline__ void xcd_barrier_complete(unsigned* bar, unsigned x, unsigned& nloc, unsigned& nx) {
    const unsigned G = gridDim.x * gridDim.y * gridDim.z;
    unsigned sum, cnt, mine, sp = 0u;
    for (;;) {
        sum = 0u; cnt = 0u; mine = 0u;
#pragma unroll
        for (unsigned j = 0; j < 16; ++j) { const unsigned c = xb_ld(&bar[XB_XCNT(j)]); sum += c; cnt += (c > 0u) ? 1u : 0u; mine = (j == x) ? c : mine; }
        if (sum == G) break;
        __builtin_amdgcn_s_sleep(1);
        if ((++sp & 255u) == 0u) { if (xb_ld(&bar[XB_TMO])) break; if (sp > XB_SPIN_CAP) { atomicAdd(&bar[XB_TMO], 1u); break; } }
    }
    nloc = mine > 0u ? mine : 1u; nx = cnt > 0u ? cnt : 1u;
}

__device__ __forceinline__ void xcd_barrier(const XcdBarrier& b) {
    asm volatile("s_waitcnt vmcnt(0)" ::: "memory");
    __syncthreads();
    if (threadIdx.x == 0) {
        unsigned* bar = b.bar;
        __builtin_amdgcn_s_waitcnt(0);
        unsigned nloc = b.st[0], nx = b.st[1];
        if (nloc == 0u) { xcd_barrier_complete(bar, b.x, nloc, nx); b.st[0] = nloc; b.st[1] = nx; }
        const unsigned old = xb_add(&bar[XB_XSUB(b.x)], 1u);
        const unsigned gen = old / nloc;
        if (old + 1u == (gen + 1u) * nloc) {
            __builtin_amdgcn_fence(__ATOMIC_RELEASE, "agent");
            asm volatile("s_waitcnt vmcnt(0)" ::: "memory");
            const unsigned og = xb_add(&bar[XB_TOP], 1u);
            const unsigned tg = og / nx;
            if (og + 1u == (tg + 1u) * nx) xb_add(&bar[XB_TOPGEN], 1u);
            else XB_SPIN(xb_ld(&bar[XB_TOPGEN]) == tg, bar);
            __builtin_amdgcn_fence(__ATOMIC_ACQUIRE, "agent");
            xb_add(&bar[XB_XGEN(b.x)], 1u);
            asm volatile("s_waitcnt vmcnt(0)" ::: "memory");
        } else {
            XB_SPIN(xb_ld(&bar[XB_XGEN(b.x)]) == gen, bar);
            __builtin_amdgcn_fence(__ATOMIC_ACQUIRE, "agent");
            asm volatile("s_waitcnt vmcnt(0)" ::: "memory");
        }
    }
    __syncthreads();
}

#ifndef PROBE
#define PROBE 0
#endif
#ifndef PM
#define PM 511
#endif
#ifndef ONE_LAUNCH
#define ONE_LAUNCH 1
#endif
constexpr int LDS_X = pg8::STAGE_BYTES + 64, LDS_BYTES = LDS_X + 4096;
constexpr size_t WS_BAR = (WS_END + 255) & ~(size_t)255, WS_TOTAL = WS_BAR + (size_t)XCD_BAR_WORDS * 4;
constexpr int N_PHASES = 2 + 8 * NL;

__global__ void __launch_bounds__(512, 2) mk_fwd(Args a) {
    extern __shared__ __attribute__((aligned(16))) unsigned char lds_raw[];
    PG8_LAS unsigned char* lds = (PG8_LAS unsigned char*)lds_raw;
    volatile PG8_LAS unsigned* bst = (volatile PG8_LAS unsigned*)(lds + pg8::STAGE_BYTES);
    if (threadIdx.x < 16) bst[threadIdx.x] = 0u;
    __syncthreads();
    const XcdBarrier gbar = xcd_barrier_post((unsigned*)(a.ws + WS_BAR), bst);
    if (a.ph_hi > 1000) cg::this_grid().sync();
    for (int ph = a.ph_lo; ph < a.ph_hi; ++ph) {
        if (ph > 0 && ph < N_PHASES - 1 && ((ph - 1) & 7) == 2) continue;
        size_t zoff_ = 0; int G = gridDim.x, bx = blockIdx.x; asm volatile("" : "+s"(zoff_), "+s"(G), "+s"(bx)); unsigned char* ws = a.ws + zoff_;
        bf16_t* XB = (bf16_t*)(ws + WS_XB); float* RS = (float*)(ws + WS_ROWSS);
        for (int rep = 0; rep < (((PROBE == 2 && ph == 0) || (PROBE == 3 && ph > 0 && ph < N_PHASES - 1 && (((ph - 1) & 7) == 0 || ((ph - 1) & 7) == 6)) || (PROBE == 7 && ph > 0 && ph < N_PHASES - 1 && ((ph - 1) & 7) == 6) || (PROBE == 8 && ph > 0 && ph < N_PHASES - 1 && ((ph - 1) & 7) == 0) || (PROBE == 4 && ph > 0 && ph < N_PHASES - 1 && (((ph - 1) & 7) == 1 || ((ph - 1) & 7) == 2))) ? 2 : 1); ++rep) {
        if (rep) __syncthreads();
        if ((PM & 1) && ph == 0) { p0_weights(a, (float*)lds_raw, 0, P0_PER, bx, G); p0_ssm(a); p0_x(a); }
        else if ((PM & 2) && ph == N_PHASES - 1) { final_norm(a); }
        else {
            const int l = (ph - 1) >> 3, s = (ph - 1) & 7;
            if ((PM & 4) && s == 0) {
                pg8::Gemm g{XB, (const bf16_t*)(ws + WS_WIN + l * SZ_WIN), TP, 4096, 1024}; pg8::StaticOrder S; S.init(TP, 4096, G, bx);
                EpiIn E{ws, RS + (size_t)(2 * l) * MP, lds + LDS_X};
                if (PROBE == 11) { EpiNull EN{(float*)(ws + WS_E)}; pg8::gemm_phase<EpiNull, pg8::StaticOrder, false>(lds, g, S, EN, nullptr); }
                pg8::gemm_phase<EpiIn, pg8::StaticOrder, false>(lds, g, S, E, nullptr); __syncthreads();
                if (bx < 224) {
                    const int su = bx; int n0, n1, kind, dc;
                    if (su < 32) { kind = 0; dc = 16 * su; n0 = dc; n1 = n0; } else if (su < 64) { kind = 1; dc = 16 * (su - 32); n0 = 512 + (dc >> 7) * 256 + (dc & 127); n1 = n0 + 128; }
                    else if (su < 96) { kind = 2; dc = 16 * (su - 64); n0 = 1536 + dc; n1 = n0; } else if (su < 160) { kind = 3; dc = 16 * (su - 96); n0 = 2048 + dc; n1 = n0; } else { kind = 4; dc = 16 * (su - 160); n0 = 3072 + dc; n1 = n0; }
                    const float* rowss = RS + (size_t)(2 * l) * MP;
                    skinny_unit<true, 8>(lds, XB + (size_t)TP * 1024, (const bf16_t*)(ws + WS_WIN + l * SZ_WIN), 1024, n0, n1, 0, otid(), [=](const f32x4 s0, const f32x4 s1, int row, int c4) {
                        const float rs = rsqrtf(rowss[row] * (1.0f / 1024.0f) + EPS); f32x4 v = s0 * rs;
                        if (kind == 1) v = v * (s1 * rs);
                        if (kind >= 3) { _Pragma("unroll") for (int j = 0; j < 4; ++j) v[j] = sigm(v[j]); }
                        bf16_t* dst = kind == 0 ? (bf16_t*)(ws + WS_ZB) + (size_t)row * 512 : kind == 1 ? (bf16_t*)(ws + WS_CV) + (size_t)row * 512 : kind == 2 ? (bf16_t*)(ws + WS_U) + (size_t)row * 512 : kind == 3 ? (bf16_t*)(ws + WS_SGA) + (size_t)row * 1024 : (bf16_t*)(ws + WS_SGS) + (size_t)row * 1024;
                        *(u32x2*)(dst + dc + c4) = pack4(v); });
                }
            } else if ((PM & 8) && s == 1) { if (!rep) conv_phase(a, l); ssm_sample_phase(a, l); __syncthreads(); ssm_mfma_phase<false>(a, l, lds); __syncthreads(); ssm_mfma_phase<true>(a, l, lds); }
            else if ((PM & 16) && s == 2) { }
            else if ((PM & 32) && s == 3) {
                { pg8::Gemm g{(const bf16_t*)(ws + WS_ZB), (const bf16_t*)(ws + WS_WBA + l * SZ_WB), TP, 1024, 512}; pg8::StaticOrder S; S.init(TP, 1024, G, bx);
                  EpiBr<false> E{ws}; if (PROBE == 11) { EpiNull EN{(float*)(ws + WS_E)}; pg8::gemm_phase<EpiNull, pg8::StaticOrder, false>(lds, g, S, EN, nullptr); } pg8::gemm_phase<EpiBr<false>, pg8::StaticOrder, false>(lds, g, S, E, nullptr); __syncthreads(); }
                { pg8::Gemm g{(const bf16_t*)(ws + WS_GY), (const bf16_t*)(ws + WS_WGLU + l * SZ_WGLU), TP, 512, 512}; pg8::StaticOrder S; S.init(TP, 512, G, bx);
                  EpiGlu E{ws, a.in[I_BGLU] + (size_t)l * 512}; if (PROBE == 11) { EpiNull EN{(float*)(ws + WS_E)}; pg8::gemm_phase<EpiNull, pg8::StaticOrder, false>(lds, g, S, EN, nullptr); } pg8::gemm_phase<EpiGlu, pg8::StaticOrder, false>(lds, g, S, E, nullptr); __syncthreads(); }
                if (bx >= 128 && bx < 192) {
                    const int dc = 16 * (bx - 128);
                    skinny_unit<false, 8>(lds, (const bf16_t*)(ws + WS_ZB) + (size_t)TP * 512, (const bf16_t*)(ws + WS_WBA + l * SZ_WB), 512, dc, dc, 0, otid(), [=](const f32x4 s0, const f32x4 s1, int row, int c4) {
                        u32x2* p = (u32x2*)((bf16_t*)(ws + WS_SGA) + (size_t)row * 1024 + dc + c4); *p = pack4(unpack4(*p) * s0); });
                } else if (bx >= 192 && bx < 224) {
                    const int dc = 16 * (bx - 192); const float* bias = a.in[I_BGLU] + (size_t)l * 512;
                    skinny_unit<false, 8>(lds, (const bf16_t*)(ws + WS_GY) + (size_t)TP * 512, (const bf16_t*)(ws + WS_WGLU + l * SZ_WGLU), 512, dc, dc, 0, otid(), [=](const f32x4 s0, const f32x4 s1, int row, int c4) {
                        const f32x4 gy = unpack4(*(const u32x2*)((const bf16_t*)(ws + WS_GY) + (size_t)row * 512 + dc + c4)); f32x4 v = s0 + *(const f32x4*)(bias + dc + c4);
                        _Pragma("unroll") for (int j = 0; j < 4; ++j) v[j] = gy[j] * sigm(v[j]);
                        *(u32x2*)((bf16_t*)(ws + WS_YS2) + (size_t)row * 512 + dc + c4) = pack4(v); });
                }
                if (l + 1 < NL && bx >= 128) { __syncthreads(); p0_weights(a, (float*)lds_raw, (l + 1) * P0_PER, (l + 1) * P0_PER + 340, bx - 128, 128); }
            } else if ((PM & 64) && s == 4) {
                pg8::Gemm g{(const bf16_t*)(ws + WS_YS2), (const bf16_t*)(ws + WS_WBB + l * SZ_WB), TP, 1024, 512}; pg8::StaticOrder S; S.init(TP, 1024, G, bx);
                EpiBr<true> E{ws}; if (PROBE == 11) { EpiNull EN{(float*)(ws + WS_E)}; pg8::gemm_phase<EpiNull, pg8::StaticOrder, false>(lds, g, S, EN, nullptr); } pg8::gemm_phase<EpiBr<true>, pg8::StaticOrder, false>(lds, g, S, E, nullptr); __syncthreads();
                {
                    const int dc = 16 * (bx & 63);
                    skinny_unit<false, 2>(lds, (const bf16_t*)(ws + WS_YS2) + (size_t)TP * 512, (const bf16_t*)(ws + WS_WBB + l * SZ_WB), 512, dc, dc, 32 * (bx >> 6), otid(), [=](const f32x4 s0, const f32x4 s1, int row, int c4) {
                        const size_t off = (size_t)row * 1024 + dc + c4; u32x2* p = (u32x2*)((bf16_t*)(ws + WS_SGS) + off); const f32x4 t = unpack4(*(const u32x2*)((const bf16_t*)(ws + WS_SGA) + off));
                        *p = pack4(t + unpack4(*p) * s0); });
                }
            } else if ((PM & 128) && (s == 5 || s == 7)) {
                const bool dn = s == 7;
                pg8::Gemm g{(const bf16_t*)(dn ? ws + WS_FF : ws + WS_SGS), (const bf16_t*)(dn ? ws + WS_WDN + l * SZ_WDN : ws + WS_WOUT + l * SZ_WOUT), TP, 1024, dn ? DFF : 1024}; pg8::StaticOrder S; S.init(TP, 1024, G, bx);
                EpiRes E{a.out, ws, RS + (size_t)(2 * l + (dn ? 2 : 1)) * MP};
                if (PROBE == 5) { EpiProbe<1> EN{ws, (float*)(ws + WS_E)}; pg8::gemm_phase<EpiProbe<1>, pg8::StaticOrder, false>(lds, g, S, EN, nullptr); }
                if (PROBE == 11) { EpiNull EN{(float*)(ws + WS_E)}; pg8::gemm_phase<EpiNull, pg8::StaticOrder, false>(lds, g, S, EN, nullptr); }
                pg8::gemm_phase<EpiRes, pg8::StaticOrder, false>(lds, g, S, E, nullptr); __syncthreads();
                {
                    const int dc = 16 * (bx & 63), Ks = dn ? DFF : 1024; float* rso = RS + (size_t)(2 * l + (dn ? 2 : 1)) * MP; float* X = a.out;
                    skinny_unit<false, 2>(lds, (const bf16_t*)(dn ? ws + WS_FF : ws + WS_SGS) + (size_t)TP * Ks, (const bf16_t*)(dn ? ws + WS_WDN + l * SZ_WDN : ws + WS_WOUT + l * SZ_WOUT), Ks, dc, dc, 32 * (bx >> 6), otid(), [=](const f32x4 s0, const f32x4 s1, int row, int c4) {
                        const size_t off = (size_t)row * 1024 + dc + c4; const f32x4 x = *(const f32x4*)(X + off) + s0; *(f32x4*)(X + off) = x; *(u32x2*)(XB + off) = pack4(x);
                        float ss = (x[0] * x[0] + x[1] * x[1]) + (x[2] * x[2] + x[3] * x[3]); ss += __shfl_xor(ss, 16); ss += __shfl_xor(ss, 32);
                        if (c4 == 0) atomicAdd(rso + row, ss); });
                }
            } else if (PM & 256) {
                pg8::Gemm g{XB, (const bf16_t*)(ws + WS_WGU + l * SZ_WGU), TP, 2 * DFF, 1024}; pg8::StaticOrder S; S.init(TP, 2 * DFF, G, bx);
                EpiGU E{ws, RS + (size_t)(2 * l + 1) * MP, lds + LDS_X};
                if (PROBE == 11) { EpiNull EN{(float*)(ws + WS_E)}; pg8::gemm_phase<EpiNull, pg8::StaticOrder, false>(lds, g, S, EN, nullptr); }
                if (PROBE == 20) { EpiProbe<0> EP{ws, (float*)(ws + WS_E)}; pg8::gemm_phase<EpiProbe<0>, pg8::StaticOrder, false>(lds, g, S, EP, nullptr); }
                if (PROBE == 21) { EpiProbe<1> EP{ws, (float*)(ws + WS_E)}; pg8::gemm_phase<EpiProbe<1>, pg8::StaticOrder, false>(lds, g, S, EP, nullptr); }
                if (PROBE == 22 || PROBE == 24 || PROBE == 26) { pg8::gemm_phase<EpiGU, pg8::StaticOrder, false>(lds, g, S, E, nullptr); __syncthreads(); if (PROBE == 26) __syncthreads(); }
                pg8::gemm_phase<EpiGU, pg8::StaticOrder, false>(lds, g, S, E, nullptr); __syncthreads();
                if (bx >= 80) {
                    const int dc = 16 * (255 - bx), n0 = (dc >> 7) * 256 + (dc & 127); const float* rowss = RS + (size_t)(2 * l + 1) * MP;
                    skinny_unit<true, 8>(lds, XB + (size_t)TP * 1024, (const bf16_t*)(ws + WS_WGU + l * SZ_WGU), 1024, n0, n0 + 128, 0, otid(), [=](const f32x4 s0, const f32x4 s1, int row, int c4) {
                        const float rs = rsqrtf(rowss[row] * (1.0f / 1024.0f) + EPS); const f32x4 g = s0 * rs, up = s1 * rs; f32x4 v;
                        _Pragma("unroll") for (int j = 0; j < 4; ++j) v[j] = g[j] * sigm(g[j]) * up[j];
                        *(u32x2*)((bf16_t*)(ws + WS_FF) + (size_t)row * DFF + dc + c4) = pack4(v); });
                }
                if (l + 1 < NL && bx >= 128) { __syncthreads(); p0_weights(a, (float*)lds_raw, (l + 1) * P0_PER + 340, (l + 2) * P0_PER, bx - 128, 128); }
            }
        }
        }
        if (ph + 1 < a.ph_hi) { xcd_barrier(gbar); if (PROBE == 1) xcd_barrier(gbar); }
        if (ph == a.ph_lo) {
            if (threadIdx.x == 0) { bool ok = true; unsigned* bw = (unsigned*)(a.ws + WS_BAR);
                for (unsigned j = 0; j < 16; ++j) { const unsigned cnt = xb_ld(&bw[XB_XCNT(j)]); ok = ok && (j < 8 ? cnt == 32u : cnt == 0u); }
                bst[4] = ok ? (bst[2] * 8u + bst[3]) : (unsigned)blockIdx.x; }
            __syncthreads();
        }
    }
}

extern "C" void kernel_launch(void* const* d_in, const int* in_sizes, int n_in, void* d_out, int out_size, void* d_ws, size_t ws_size, hipStream_t stream) {
    static int grid = 0;
    if (grid == 0) {
        if (n_in != 25 || (size_t)out_size != O_END || ws_size < WS_TOTAL) { fprintf(stderr, "kernel_launch: unexpected shapes: n_in %d out %d ws %zu (need %zu)\n", n_in, out_size, ws_size, (size_t)WS_TOTAL); grid = -1; return; }
        int dev = 0, cus = 0, per_cu = 0;
        hipGetDevice(&dev); hipDeviceGetAttribute(&cus, hipDeviceAttributeMultiprocessorCount, dev);
        if (hipFuncSetAttribute((const void*)mk_fwd, hipFuncAttributeMaxDynamicSharedMemorySize, LDS_BYTES) != hipSuccess) { fprintf(stderr, "kernel_launch: hipFuncSetAttribute failed\n"); grid = -1; return; }
        if (hipOccupancyMaxActiveBlocksPerMultiprocessor(&per_cu, (const void*)mk_fwd, 512, LDS_BYTES) != hipSuccess || per_cu < 1) { fprintf(stderr, "kernel_launch: occupancy query says %d\n", per_cu); per_cu = 1; }
        (void)hipGetLastError();
        grid = 256;
        if (cus < 256) fprintf(stderr, "kernel_launch: %d CUs, need 256\n", cus);
    }
    if (grid < 0) return;
    if (hipMemsetAsync((char*)d_ws + WS_BAR, 0, (size_t)XCD_BAR_WORDS * 4, stream) != hipSuccess) { fprintf(stderr, "kernel_launch: memset of the barrier words failed\n"); return; }
    Args a{};
    for (int i = 0; i < 25; ++i) a.in[i] = (const float*)d_in[i];
    a.out = (float*)d_out; a.ws = (unsigned char*)d_ws;
#if ONE_LAUNCH
    a.ph_lo = 0; a.ph_hi = N_PHASES;
    void* args[] = {&a};
    hipError_t e = hipLaunchCooperativeKernel((const void*)mk_fwd, dim3(grid), dim3(512), args, LDS_BYTES, stream);
    if (e != hipSuccess) fprintf(stderr, "cooperative launch failed: %s (grid %d)\n", hipGetErrorString(e), grid);
#else
    for (int ph = 0; ph < N_PHASES; ++ph) { a.ph_lo = ph; a.ph_hi = ph + 1; hipLaunchKernelGGL(mk_fwd, dim3(grid), dim3(512), LDS_BYTES, stream, a); }
#endif
}
```

```cpp
#include <hip/hip_runtime.h>
#include <hip/hip_cooperative_groups.h>
#include <cstdio>
namespace cg = cooperative_groups;
namespace pg8 {
#define PG8_LAS __attribute__((address_space(3)))
typedef unsigned short bf16_t;
typedef short bf16x8 __attribute__((ext_vector_type(8)));
typedef float f32x4 __attribute__((ext_vector_type(4)));
typedef unsigned u32x4 __attribute__((ext_vector_type(4)));
constexpr int BM = 256, BK = 64, HALF = 128, HTB = HALF * BK * 2  , STAGE_BYTES = 8 * HTB, NXCD = 8, WGM = 8;

__host__ __device__ __forceinline__ int lds_byte(int r, int c) { const int st = (r >> 4) * 2 + (c >> 5), rr = r & 15, cc = c & 31, ob = rr * 64 + cc * 2; return st * 1024 + (ob ^ (((ob >> 9) & 1) << 5)); }
__host__ __device__ __forceinline__ void stage_rc(int b, int& R, int& C) { const int st = b / 1024, sb = b % 1024, swz = sb ^ (((sb >> 9) & 1) << 5); R = (st >> 1) * 16 + swz / 64; C = (st & 1) * 32 + (swz % 64) / 2; }
__host__ __device__ __forceinline__ int perm32(int rho) { const int n = rho >> 4, i = rho & 15; return 8 * (i >> 2) + 4 * n + (i & 3); }

struct Unit { int pm, pn; };
struct Gemm { const bf16_t* A; const bf16_t* Bt; int M, N, K; };

struct StaticOrder {
    int nM, nN, nwg, G, c;
    __host__ __device__ void init(int M, int N, int G_, int c_) { nM = M / BM; nN = N / BM; nwg = nM * nN; G = G_; c = c_; }
    __host__ __device__ bool next(int i, Unit& u) const {
        const long L = (long)i * G + c; if (L >= nwg) return false;
        int wgid = (int)L; { const int q = nwg / NXCD, r = nwg % NXCD, xcd = wgid % NXCD, off = wgid / NXCD; wgid = (xcd < r ? xcd * (q + 1) : r * (q + 1) + (xcd - r) * q) + off; }
        const int nig = WGM * nN, gid = wgid / nig, fm = gid * WGM, gsz = (nM - fm) < WGM ? (nM - fm) : WGM;
        u.pm = fm + ((wgid % nig) % gsz); u.pn = (wgid % nig) / gsz; return true;
    }
    __device__ __forceinline__ void a_ready(const Unit&) const {}
    __device__ __forceinline__ void done(const Unit&) const {}
};
__device__ __forceinline__ unsigned cvt_pk_bf16(float lo, float hi) { unsigned r; asm volatile("v_cvt_pk_bf16_f32 %0, %1, %2" : "=v"(r) : "v"(lo), "v"(hi)); return r; }
typedef float f32x2 __attribute__((ext_vector_type(2)));
__device__ __forceinline__ f32x2 gelu_pk(f32x2 v) {
    const f32x2 av = __builtin_elementwise_abs(v), d = av * 0.2316418882f + 1.0f;
    f32x2 t; t.x = __builtin_amdgcn_rcpf(d.x); t.y = __builtin_amdgcn_rcpf(d.y);
    f32x2 q = t * 0.5307027145f + (-0.7265760135f); q = q * t + 0.7107068705f; q = q * t + (-0.142248368f); q = q * t + 0.127414796f; q = q * t;
    const f32x2 s = (v * v) * (-0.72134752044f);
    f32x2 e; e.x = __builtin_amdgcn_exp2f(s.x); e.y = __builtin_amdgcn_exp2f(s.y);
    const f32x2 m = v * (q * e), r = v - m;
    f32x2 o; o.x = v.x < 0.f ? m.x : r.x; o.y = v.y < 0.f ? m.y : r.y; return o;
}

template <class Epi, class Sched, bool STAMP = false>
__device__ __forceinline__ void gemm_phase(PG8_LAS unsigned char* lds, const Gemm g, const Sched& S, const Epi& E, unsigned long long* stamps) {
    int tid_ = threadIdx.x; asm volatile("" : "+v"(tid_));
    const int tid = tid_, wid = __builtin_amdgcn_readfirstlane(tid >> 6), lane = tid & 63, wr = wid >> 2, wc = wid & 3, fr = lane & 15, fq = lane >> 4;
    const int K = g.K, nt = K / BK;
    int ts_lo = 0, ts_hi = 0, nts = 0; const unsigned long long rt_entry = STAMP ? (unsigned long long)wall_clock64() : 0ull;
#define PG8_STAMP() do { if (STAMP && wid == 0 && nts < 64) { const unsigned long long _c = (unsigned long long)clock64(); \
        ts_lo = (lane == nts) ? (int)(unsigned)_c : ts_lo; ts_hi = (lane == nts) ? (int)(unsigned)(_c >> 32) : ts_hi; ++nts; } } while (0)
    PG8_STAMP();
    unsigned voffA[2], voffB[2];
#pragma unroll
    for (int i = 0; i < 2; ++i) { int R, C; stage_rc(tid * 16 + i * 8192, R, C); const int Rb = Epi::PERM ? ((R & ~31) + perm32(R & 31)) : R;
        voffA[i] = (unsigned)(R * K + C) * 2u; voffB[i] = (unsigned)(Rb * K + C) * 2u; }
    const size_t kstep = (size_t)(BK * 2);
    const size_t hstep = (size_t)HALF * K * 2;
    const size_t tstep = 2 * hstep;
    const unsigned ldsw = (unsigned)wid * 1024u;
    const int aoff = lds_byte(wr * 64 + fr, fq * 8), boff = lds_byte(wc * 32 + fr, fq * 8);
#define PG8_SA(b, h) (((b) * 2 + (h)) * HTB)
#define PG8_SB(b, h) ((4 + (b) * 2 + (h)) * HTB)
#define PG8_STAGE(bufoff, gbase, voff) do { _Pragma("unroll") for (int _i = 0; _i < 2; ++_i) \
        __builtin_amdgcn_global_load_lds((const unsigned*)((const char*)(gbase) + (voff)[_i]), (PG8_LAS unsigned*)(lds + (bufoff) + ldsw + _i * 8192), 16, 0, 0); } while (0)
#define PG8_LDA(dst, b, h) do { _Pragma("unroll") for (int m = 0; m < 4; ++m) _Pragma("unroll") for (int k = 0; k < 2; ++k) dst[m][k] = *(const PG8_LAS bf16x8*)(lds + PG8_SA(b, h) + aoff + m * 2048 + k * 1024); } while (0)
#define PG8_LDB(dst, b, h) do { _Pragma("unroll") for (int n = 0; n < 2; ++n) _Pragma("unroll") for (int k = 0; k < 2; ++k) dst[n][k] = *(const PG8_LAS bf16x8*)(lds + PG8_SB(b, h) + boff + n * 2048 + k * 1024); } while (0)
#define PG8_MMA(ai, bj, At, Bt) do { __builtin_amdgcn_s_setprio(1); _Pragma("unroll") for (int m = 0; m < 4; ++m) _Pragma("unroll") for (int n = 0; n < 2; ++n) _Pragma("unroll") for (int k = 0; k < 2; ++k) \
        acc[ai][bj][m][n] = __builtin_amdgcn_mfma_f32_16x16x32_bf16(Bt[n][k], At[m][k], acc[ai][bj][m][n], 0, 0, 0); __builtin_amdgcn_s_setprio(0); } while (0)
#define PG8_WAIT_V(n) asm volatile("s_waitcnt vmcnt(" #n ")" ::: "memory")
#define PG8_WAIT_L(n) asm volatile("s_waitcnt lgkmcnt(" #n ")" ::: "memory")
#define PG8_BAR __builtin_amdgcn_s_barrier()
#define PG8_SCHED __builtin_amdgcn_sched_barrier(0)
    Unit cur, nxt; int ui = 0;
    if (!S.next(0, cur)) return;
    f32x4 acc[2][2][4][2];
#pragma unroll
    for (int a = 0; a < 2; ++a)
#pragma unroll
        for (int b = 0; b < 2; ++b)
#pragma unroll
            for (int m = 0; m < 4; ++m)
#pragma unroll
                for (int n = 0; n < 2; ++n) acc[a][b][m][n] = (f32x4){0.f, 0.f, 0.f, 0.f};
    bf16x8 At[4][2], B0[2][2], B1[2][2];
    const char* cA = (const char*)g.A + (size_t)cur.pm * tstep; const char* cB = (const char*)g.Bt + (size_t)cur.pn * tstep;
    S.a_ready(cur);
    PG8_STAGE(PG8_SB(0, 0), cB, voffB); PG8_STAGE(PG8_SA(0, 0), cA, voffA); PG8_STAGE(PG8_SB(0, 1), cB + hstep, voffB); PG8_STAGE(PG8_SA(0, 1), cA + hstep, voffA);
    if (wr == 1) PG8_BAR;
    PG8_WAIT_V(4); PG8_BAR;
    PG8_STAGE(PG8_SB(1, 0), cB + kstep, voffB); PG8_STAGE(PG8_SA(1, 0), cA + kstep, voffA); PG8_STAGE(PG8_SB(1, 1), cB + hstep + kstep, voffB);
    PG8_WAIT_V(6); PG8_BAR;
    PG8_STAMP();
    for (;;) {
        const bool has_next = S.next(ui + 1, nxt);
        const char* nA = has_next ? (const char*)g.A + (size_t)nxt.pm * tstep : cA; const char* nB = has_next ? (const char*)g.Bt + (size_t)nxt.pn * tstep : cB;
        for (int t = 0; t < nt; t += 2) {
            const bool last = (t == nt - 2);
            const char* a1 = cA + (size_t)(t + 1) * kstep;
            const char* a2 = last ? nA : cA + (size_t)(t + 2) * kstep; const char* b2 = last ? nB : cB + (size_t)(t + 2) * kstep;
            const char* a3 = a2 + kstep; const char* b3 = b2 + kstep;
            if (last && has_next) S.a_ready(nxt);
            if constexpr (Epi::PREFETCH) { if (last) E.prefetch(cur, wid, lane); }
            PG8_LDB(B0, 0, 0); PG8_SCHED; PG8_LDA(At, 0, 0); PG8_STAGE(PG8_SA(1, 1), a1 + hstep, voffA);
            PG8_WAIT_L(8); PG8_BAR; PG8_WAIT_L(0); PG8_MMA(0, 0, At, B0); PG8_BAR; PG8_SCHED;
            PG8_LDB(B1, 0, 1); PG8_STAGE(PG8_SB(0, 0), b2, voffB);
            PG8_BAR; PG8_WAIT_L(0); PG8_MMA(0, 1, At, B1); PG8_BAR;
            PG8_LDA(At, 0, 1); PG8_STAGE(PG8_SA(0, 0), a2, voffA);
            PG8_BAR; PG8_WAIT_L(0); PG8_MMA(1, 0, At, B0); PG8_BAR; PG8_SCHED;
            PG8_STAGE(PG8_SB(0, 1), b2 + hstep, voffB);
            PG8_WAIT_V(6); PG8_BAR; PG8_MMA(1, 1, At, B1); PG8_BAR;
            PG8_LDB(B0, 1, 0); PG8_SCHED; PG8_LDA(At, 1, 0); PG8_STAGE(PG8_SA(0, 1), a2 + hstep, voffA);
            PG8_WAIT_L(8); PG8_BAR; PG8_WAIT_L(0); PG8_MMA(0, 0, At, B0); PG8_BAR; PG8_SCHED;
            PG8_LDB(B1, 1, 1); PG8_STAGE(PG8_SB(1, 0), b3, voffB);
            PG8_BAR; PG8_WAIT_L(0); PG8_MMA(0, 1, At, B1); PG8_BAR;
            PG8_LDA(At, 1, 1); PG8_STAGE(PG8_SA(1, 0), a3, voffA);
            PG8_BAR; PG8_WAIT_L(0); PG8_MMA(1, 0, At, B0); PG8_BAR; PG8_SCHED;
            PG8_STAGE(PG8_SB(1, 1), b3 + hstep, voffB);
            PG8_WAIT_V(6); PG8_BAR; PG8_MMA(1, 1, At, B1); PG8_BAR;
        }
        PG8_STAMP();
        if (wr == 0) PG8_BAR;
        if constexpr (!Epi::AFTER_DRAIN) { E(acc, cur, wr, wc, fr, fq); S.done(cur); }
        PG8_STAMP();
        if (!has_next) break;
#pragma unroll
        for (int a = 0; a < 2; ++a)
#pragma unroll
            for (int b = 0; b < 2; ++b)
#pragma unroll
                for (int m = 0; m < 4; ++m)
#pragma unroll
                    for (int n = 0; n < 2; ++n) acc[a][b][m][n] = (f32x4){0.f, 0.f, 0.f, 0.f};
        cur = nxt; cA = nA; cB = nB; ++ui;
        if (wr == 1) PG8_BAR;
    }
    PG8_WAIT_V(0);
    PG8_BAR;
    if constexpr (Epi::AFTER_DRAIN) { E.fused(acc, cur, wr, wc, fr, fq, lds, wid, lane); S.done(cur); }
    PG8_STAMP();
    if (STAMP && wid == 0) { stamps[lane] = lane < nts ? (((unsigned long long)(unsigned)ts_hi << 32) | (unsigned)ts_lo) : 0ull;
        if (lane == 62) stamps[62] = rt_entry; if (lane == 63) stamps[63] = (unsigned long long)wall_clock64(); }
#undef PG8_STAMP
#undef PG8_SA
#undef PG8_SB
#undef PG8_STAGE
#undef PG8_LDA
#undef PG8_LDB
#undef PG8_MMA
#undef PG8_WAIT_V
#undef PG8_WAIT_L
#undef PG8_BAR
#undef PG8_SCHED
}
}
using pg8::bf16_t; using pg8::f32x4; using pg8::u32x4; using pg8::Unit; using pg8::cvt_pk_bf16;
typedef unsigned u32x2 __attribute__((ext_vector_type(2)));
constexpr int D = 1024, TP = 16384, TS = 128, T = TP + TS, MP = 16640, NL = 4, CW = 512, NG = 32, NP = 64, DFF = 2816, SEQ = 2048, NB = 8, LC = 64, NCH = SEQ / LC;
constexpr float EPS = 1e-6f;
constexpr size_t O_YP = 0, O_YS = (size_t)TP * D, O_PC = O_YS + (size_t)TS * D, O_PRE = O_PC + (size_t)NL * NB * 2 * CW, O_PIM = O_PRE + (size_t)NL * NB * NG * NP,
                 O_SC = O_PIM + (size_t)NL * NB * NG * NP, O_SRE = O_SC + (size_t)NL * TS * 2 * CW, O_SIM = O_SRE + (size_t)NL * TS * NG * NP, O_END = O_SIM + (size_t)NL * TS * NG * NP;
constexpr size_t SZ_WIN = (size_t)4096 * 1024 * 2, SZ_WGLU = (size_t)512 * 512 * 2, SZ_WB = (size_t)1024 * 512 * 2, SZ_WOUT = (size_t)1024 * 1024 * 2, SZ_WGU = (size_t)5632 * 1024 * 2, SZ_WDN = (size_t)1024 * 2816 * 2;
constexpr size_t WS_WIN = 0, WS_WGLU = WS_WIN + NL * SZ_WIN, WS_WBA = WS_WGLU + NL * SZ_WGLU, WS_WBB = WS_WBA + NL * SZ_WB, WS_WOUT = WS_WBB + NL * SZ_WB, WS_WGU = WS_WOUT + NL * SZ_WOUT,
                 WS_WDN = WS_WGU + NL * SZ_WGU, WS_XB = WS_WDN + NL * SZ_WDN;
constexpr size_t SZ_H = (size_t)MP * 512 * 2, SZ_F = (size_t)MP * 1024 * 2;
constexpr size_t WS_ZB = WS_XB + SZ_F, WS_CV = WS_ZB + SZ_H, WS_U = WS_CV + SZ_H, WS_SGA = WS_U + SZ_H, WS_SGS = WS_SGA + SZ_F, WS_GY = WS_SGS + SZ_F, WS_YS2 = WS_GY + SZ_H, WS_ZEND = WS_YS2 + SZ_H;
constexpr size_t WS_FF = WS_ZB;
static_assert((size_t)MP * DFF * 2 <= WS_ZEND - WS_ZB, "F alias");
constexpr size_t WS_ROWSS = WS_ZEND, SZ_ROWSS = (size_t)MP * 4, WS_ABAR = WS_ROWSS + 9 * SZ_ROWSS, WS_APOW = WS_ABAR + (size_t)NL * NG * NP * 8, WS_BBAR = WS_APOW + (size_t)NL * NG * NP * 8,
                 WS_E = WS_BBAR + (size_t)NL * NG * NP * 32 * 4, WS_BBF = WS_E + (size_t)NB * NG * NCH * NP * 8, WS_CMF = WS_BBF + (size_t)NL * NG * 4 * 64 * 16, WS_END = WS_CMF + (size_t)NL * NG * 5 * 64 * 16;

__device__ __forceinline__ float bf_lo(unsigned w) { return __uint_as_float(w << 16); }
__device__ __forceinline__ float bf_hi(unsigned w) { return __uint_as_float(w & 0xffff0000u); }
__device__ __forceinline__ float sigm(float x) { return __builtin_amdgcn_rcpf(1.0f + __expf(-x)); }
__device__ __forceinline__ u32x4 pack8(const f32x4 a, const f32x4 b) { u32x4 w; w.x = cvt_pk_bf16(a[0], a[1]); w.y = cvt_pk_bf16(a[2], a[3]); w.z = cvt_pk_bf16(b[0], b[1]); w.w = cvt_pk_bf16(b[2], b[3]); return w; }
__device__ __forceinline__ void unpack8(const u32x4 w, f32x4& a, f32x4& b) { a = (f32x4){bf_lo(w.x), bf_hi(w.x), bf_lo(w.y), bf_hi(w.y)}; b = (f32x4){bf_lo(w.z), bf_hi(w.z), bf_lo(w.w), bf_hi(w.w)}; }

__device__ __forceinline__ float nr_rcp(float d) { float r = __uint_as_float(0x7EF311C7u - __float_as_uint(d)); r = r * fmaf(-d, r, 2.0f); r = r * fmaf(-d, r, 2.0f); return r; }
#define WT_FLAGS 0x00020000
__device__ __forceinline__ void wt16s(const __amdgpu_buffer_rsrc_t r, const void* base, const void* p, const u32x4 v) { __builtin_amdgcn_raw_buffer_store_b128(v, r, (unsigned)((const char*)p - (const char*)base), 0, 16); }
__device__ __forceinline__ void wt16(const __amdgpu_buffer_rsrc_t r, const void* base, const void* p, const u32x4 v) { (void)r; (void)base; *(u32x4*)p = v; }
#define EPI_FENCE asm volatile("" ::: "memory")
#define EPI_G(g) const int ai = (g) >> 2, m = (g) & 3, row = row0 + ai * 128 + m * 16
struct EpiIn {
    static constexpr bool PERM = true, AFTER_DRAIN = false, PREFETCH = true;
    unsigned char* ws; const float* rowss; PG8_LAS unsigned char* ldsx;
    __device__ __forceinline__ void prefetch(const Unit& u, int wid, int lane) const { const float* src = rowss + u.pm * 256 + (wid >> 2) * 64 + lane;
        __builtin_amdgcn_global_load_lds((const unsigned*)src, (PG8_LAS unsigned*)(ldsx + wid * 512), 4, 0, 0); __builtin_amdgcn_global_load_lds((const unsigned*)(src + 128), (PG8_LAS unsigned*)(ldsx + wid * 512 + 256), 4, 0, 0); }
    __device__ __forceinline__ void operator()(const f32x4 (&acc)[2][2][4][2], const Unit& u, int wr, int wc, int fr, int fq) const {
        bf16_t* const ZB = (bf16_t*)(ws + WS_ZB); bf16_t* const CV = (bf16_t*)(ws + WS_CV); bf16_t* const U = (bf16_t*)(ws + WS_U); bf16_t* const SGA = (bf16_t*)(ws + WS_SGA); bf16_t* const SGS = (bf16_t*)(ws + WS_SGS);
        const int row0 = u.pm * 256 + wr * 64 + fr, pn = u.pn, cw = wc * 32 + 8 * fq;
        const __amdgpu_buffer_rsrc_t rw = __builtin_amdgcn_make_buffer_rsrc(ws, 0, (int)WS_ZEND, WT_FLAGS);
        float rs[8];
#pragma unroll
        for (int g = 0; g < 8; ++g) { EPI_G(g); (void)row; rs[g] = *(const PG8_LAS float*)(ldsx + (wr * 4 + wc) * 512 + ai * 256 + (16 * m + fr) * 4); }
#pragma unroll
        for (int g = 0; g < 8; ++g) rs[g] = rsqrtf(rs[g] * (1.0f / 1024.0f) + EPS);
        if (pn >= 2 && pn < 6) {
            bf16_t* base = CV + (pn - 2) * 128 + cw;
#pragma unroll
            for (int g = 0; g < 8; ++g) { EPI_G(g); const float rs2 = rs[g] * rs[g];
                wt16(rw, ws, base + (size_t)row * 512, pack8(acc[ai][0][m][0] * acc[ai][1][m][0] * rs2, acc[ai][0][m][1] * acc[ai][1][m][1] * rs2)); }
        } else {
            bf16_t* base; int ldc; const bool sg = pn >= 8;
            if (pn < 2) { base = ZB + pn * 256; ldc = 512; } else if (pn < 8) { base = U + (pn - 6) * 256; ldc = 512; } else if (pn < 12) { base = SGA + (pn - 8) * 256; ldc = 1024; } else { base = SGS + (pn - 12) * 256; ldc = 1024; }
            base += cw;
#pragma unroll
            for (int g = 0; g < 8; ++g) { EPI_G(g);
#pragma unroll
                for (int bj = 0; bj < 2; ++bj) { f32x4 v0, v1;
                    if (sg) { const float rl = rs[g] * -1.4426950408889634f; const f32x4 x0 = acc[ai][bj][m][0] * rl, x1 = acc[ai][bj][m][1] * rl;
                        f32x4 e0, e1;
#pragma unroll
                        for (int j = 0; j < 4; ++j) { e0[j] = __builtin_amdgcn_exp2f(x0[j]); e1[j] = __builtin_amdgcn_exp2f(x1[j]); }
                        const f32x4 d0 = e0 + 1.0f, d1 = e1 + 1.0f;
#pragma unroll
                        for (int j = 0; j < 4; ++j) { v0[j] = __builtin_amdgcn_rcpf(d0[j]); v1[j] = __builtin_amdgcn_rcpf(d1[j]); } }
                    else { v0 = acc[ai][bj][m][0] * rs[g]; v1 = acc[ai][bj][m][1] * rs[g]; }
                    wt16(rw, ws, base + (size_t)row * ldc + bj * 128, pack8(v0, v1)); } }
        }
    }
};
#ifndef PROBE
#define PROBE 0
#endif
struct EpiGU {
    static constexpr bool PERM = true, AFTER_DRAIN = false, PREFETCH = (PROBE != 24);
    unsigned char* ws; const float* rowss; PG8_LAS unsigned char* ldsx;
    __device__ __forceinline__ void prefetch(const Unit& u, int wid, int lane) const { const float* src = rowss + u.pm * 256 + (wid >> 2) * 64 + lane;
        __builtin_amdgcn_global_load_lds((const unsigned*)src, (PG8_LAS unsigned*)(ldsx + wid * 512), 4, 0, 0); __builtin_amdgcn_global_load_lds((const unsigned*)(src + 128), (PG8_LAS unsigned*)(ldsx + wid * 512 + 256), 4, 0, 0); }
    __device__ __forceinline__ void operator()(const f32x4 (&acc)[2][2][4][2], const Unit& u, int wr, int wc, int fr, int fq) const {
        const int row0 = u.pm * 256 + wr * 64 + fr; bf16_t* base = (bf16_t*)(ws + WS_FF) + u.pn * 128 + wc * 32 + 8 * fq;
        const __amdgpu_buffer_rsrc_t rw = __builtin_amdgcn_make_buffer_rsrc(ws, 0, (int)WS_ZEND, WT_FLAGS);
        float rs[8];
#pragma unroll
        for (int g = 0; g < 8; ++g) { EPI_G(g); rs[g] = PREFETCH ? *(const PG8_LAS float*)(ldsx + (wr * 4 + wc) * 512 + ai * 256 + (16 * m + fr) * 4) : rowss[row]; }
        EPI_FENCE;
#pragma unroll
        for (int g = 0; g < 8; ++g) { EPI_G(g); const float r = rsqrtf(rs[g] * (1.0f / 1024.0f) + EPS), r2 = r * r, rl = r * -1.4426950408889634f; f32x4 o[2];
#pragma unroll
            for (int n = 0; n < 2; ++n) { const f32x4 t = acc[ai][0][m][n] * acc[ai][1][m][n] * r2, xe = acc[ai][0][m][n] * rl;
                f32x4 e, q;
#pragma unroll
                for (int j = 0; j < 4; ++j) e[j] = __builtin_amdgcn_exp2f(xe[j]);
                const f32x4 d = e + 1.0f;
#pragma unroll
                for (int j = 0; j < 4; ++j) q[j] = __builtin_amdgcn_rcpf(d[j]);
                o[n] = t * q; }
            wt16(rw, ws, base + (size_t)row * DFF, pack8(o[0], o[1])); }
    }
};
struct EpiGlu {
    static constexpr bool PERM = true, AFTER_DRAIN = false, PREFETCH = false;
    unsigned char* ws; const float* bias;
    __device__ __forceinline__ void operator()(const f32x4 (&acc)[2][2][4][2], const Unit& u, int wr, int wc, int fr, int fq) const {
        const bf16_t* const GY = (const bf16_t*)(ws + WS_GY); bf16_t* const YS2 = (bf16_t*)(ws + WS_YS2);
        const int row0 = u.pm * 256 + wr * 64 + fr, col0 = u.pn * 256 + wc * 32 + 8 * fq;
        const __amdgpu_buffer_rsrc_t rw = __builtin_amdgcn_make_buffer_rsrc(ws, 0, (int)WS_ZEND, WT_FLAGS);
        f32x4 bv[2][2];
#pragma unroll
        for (int bj = 0; bj < 2; ++bj) { bv[bj][0] = *(const f32x4*)(bias + col0 + bj * 128); bv[bj][1] = *(const f32x4*)(bias + col0 + bj * 128 + 4); }
        u32x4 buf[4][2];
#define GLU_LOAD(g) { EPI_G(g); (void)ai; (void)m; buf[(g) & 3][0] = *(const u32x4*)(GY + (size_t)row * 512 + col0); buf[(g) & 3][1] = *(const u32x4*)(GY + (size_t)row * 512 + col0 + 128); }
        GLU_LOAD(0) GLU_LOAD(1) GLU_LOAD(2)
#pragma unroll
        for (int g = 0; g < 8; ++g) { if (g + 3 < 8) GLU_LOAD(g + 3)
            EPI_FENCE; EPI_G(g);
#pragma unroll
            for (int bj = 0; bj < 2; ++bj) { f32x4 g0, g1; unpack8(buf[g & 3][bj], g0, g1); f32x4 v0 = acc[ai][bj][m][0] + bv[bj][0], v1 = acc[ai][bj][m][1] + bv[bj][1];
#pragma unroll
                for (int j = 0; j < 4; ++j) { v0[j] = g0[j] * sigm(v0[j]); v1[j] = g1[j] * sigm(v1[j]); }
                wt16(rw, ws, YS2 + (size_t)row * 512 + col0 + bj * 128, pack8(v0, v1)); } }
#undef GLU_LOAD
    }
};
template <bool SECOND> struct EpiBr {
    static constexpr bool PERM = true, AFTER_DRAIN = false, PREFETCH = false;
    unsigned char* ws;
    __device__ __forceinline__ void operator()(const f32x4 (&acc)[2][2][4][2], const Unit& u, int wr, int wc, int fr, int fq) const {
        bf16_t* const SGA = (bf16_t*)(ws + WS_SGA); bf16_t* const SGS = (bf16_t*)(ws + WS_SGS);
        const int row0 = u.pm * 256 + wr * 64 + fr, col0 = u.pn * 256 + wc * 32 + 8 * fq;
        const __amdgpu_buffer_rsrc_t rw = __builtin_amdgcn_make_buffer_rsrc(ws, 0, (int)WS_ZEND, WT_FLAGS);
        constexpr int DP = SECOND ? 3 : 4;
        u32x4 sb[DP][2], tb[SECOND ? DP : 1][2];
#define BR_LOAD(g) { EPI_G(g); (void)ai; (void)m; const size_t off = (size_t)row * 1024 + col0; sb[(g) % DP][0] = *(const u32x4*)((SECOND ? SGS : SGA) + off); sb[(g) % DP][1] = *(const u32x4*)((SECOND ? SGS : SGA) + off + 128); \
            if (SECOND) { tb[(g) % DP][0] = *(const u32x4*)(SGA + off); tb[(g) % DP][1] = *(const u32x4*)(SGA + off + 128); } }
        BR_LOAD(0) BR_LOAD(1) if (DP > 3) BR_LOAD(2)
#pragma unroll
        for (int g = 0; g < 8; ++g) { if (g + DP - 1 < 8) BR_LOAD(g + DP - 1)
            EPI_FENCE; EPI_G(g);
#pragma unroll
            for (int bj = 0; bj < 2; ++bj) { const size_t off = (size_t)row * 1024 + col0 + bj * 128; f32x4 s0, s1; unpack8(sb[g % DP][bj], s0, s1);
                if (!SECOND) wt16(rw, ws, SGA + off, pack8(s0 * acc[ai][bj][m][0], s1 * acc[ai][bj][m][1]));
                else { f32x4 t0, t1; unpack8(tb[g % DP][bj], t0, t1); wt16(rw, ws, SGS + off, pack8(t0 + s0 * acc[ai][bj][m][0], t1 + s1 * acc[ai][bj][m][1])); } } }
#undef BR_LOAD
    }
};
struct EpiRes {
    static constexpr bool PERM = true, AFTER_DRAIN = false, PREFETCH = false;
    float* X; unsigned char* ws; float* rowss_out;
    __device__ __forceinline__ void operator()(const f32x4 (&acc)[2][2][4][2], const Unit& u, int wr, int wc, int fr, int fq) const {
        const int row0 = u.pm * 256 + wr * 64 + fr, col0 = u.pn * 256 + wc * 32 + 8 * fq; bf16_t* const XB = (bf16_t*)(ws + WS_XB);
        const __amdgpu_buffer_rsrc_t rw = __builtin_amdgcn_make_buffer_rsrc(ws, 0, (int)WS_ZEND, WT_FLAGS), ro = __builtin_amdgcn_make_buffer_rsrc(X, 0, (int)((size_t)T * D * 4), WT_FLAGS);
        f32x4 xb[3][2][2];
#define RES_LOAD(g) { EPI_G(g); (void)ai; (void)m; const size_t off = (size_t)row * 1024 + col0; xb[(g) % 3][0][0] = *(const f32x4*)(X + off); xb[(g) % 3][0][1] = *(const f32x4*)(X + off + 4); \
            xb[(g) % 3][1][0] = *(const f32x4*)(X + off + 128); xb[(g) % 3][1][1] = *(const f32x4*)(X + off + 132); }
        RES_LOAD(0) RES_LOAD(1)
#pragma unroll
        for (int g = 0; g < 8; ++g) { if (g + 2 < 8) RES_LOAD(g + 2)
            EPI_FENCE; EPI_G(g); float ss = 0.f;
#pragma unroll
            for (int bj = 0; bj < 2; ++bj) { const size_t off = (size_t)row * 1024 + col0 + bj * 128;
                const f32x4 x0 = xb[g % 3][bj][0] + acc[ai][bj][m][0], x1 = xb[g % 3][bj][1] + acc[ai][bj][m][1];
                wt16(ro, X, X + off, __builtin_bit_cast(u32x4, x0)); wt16(ro, X, X + off + 4, __builtin_bit_cast(u32x4, x1)); wt16(rw, ws, XB + off, pack8(x0, x1));
                ss += (x0[0] * x0[0] + x0[1] * x0[1]) + (x0[2] * x0[2] + x0[3] * x0[3]) + (x1[0] * x1[0] + x1[1] * x1[1]) + (x1[2] * x1[2] + x1[3] * x1[3]); }
            ss += __shfl_xor(ss, 16); ss += __shfl_xor(ss, 32);
            if (fq == 0) atomicAdd(rowss_out + row, ss); }
#undef RES_LOAD
    }
};
template <bool PAIRED, int NTB, class F> __device__ __forceinline__ void skinny_unit(PG8_LAS unsigned char* lds, const bf16_t* Act, const bf16_t* Bt, int K, int n0, int n1, int tok0, int tid, const F& epi) {
    const int lane = tid & 63, w = __builtin_amdgcn_readfirstlane(tid >> 6), r16 = lane & 15, q = lane >> 4, ks = K >> 3;
    const bf16_t* wp0 = Bt + (size_t)(n0 + r16) * K + w * ks + 8 * q;
    const bf16_t* wp1 = Bt + (size_t)(n1 + r16) * K + w * ks + 8 * q;
    const bf16_t* ap = Act + (size_t)(tok0 + r16) * K + w * ks + 8 * q;
    f32x4 acc0[NTB], acc1[NTB];
#pragma unroll
    for (int tb = 0; tb < NTB; ++tb) { acc0[tb] = (f32x4){0.f, 0.f, 0.f, 0.f}; acc1[tb] = acc0[tb]; }
#pragma unroll (NTB > 4 ? 2 : 6)
    for (int k0 = 0; k0 < ks; k0 += 32) {
        const pg8::bf16x8 wf0 = __builtin_bit_cast(pg8::bf16x8, *(const u32x4*)(wp0 + k0));
        pg8::bf16x8 wf1 = wf0; if (PAIRED) wf1 = __builtin_bit_cast(pg8::bf16x8, *(const u32x4*)(wp1 + k0));
        pg8::bf16x8 af[NTB];
#pragma unroll
        for (int tb = 0; tb < NTB; ++tb) af[tb] = __builtin_bit_cast(pg8::bf16x8, *(const u32x4*)(ap + (size_t)(tb * 16) * K + k0));
#pragma unroll
        for (int tb = 0; tb < NTB; ++tb) { acc0[tb] = __builtin_amdgcn_mfma_f32_16x16x32_bf16(wf0, af[tb], acc0[tb], 0, 0, 0);
            if (PAIRED) acc1[tb] = __builtin_amdgcn_mfma_f32_16x16x32_bf16(wf1, af[tb], acc1[tb], 0, 0, 0); }
    }
    __syncthreads();
#pragma unroll
    for (int tb = 0; tb < NTB; ++tb) { *(PG8_LAS f32x4*)(lds + ((w * NTB + tb) * 64 + lane) * 16) = acc0[tb]; if (PAIRED) *(PG8_LAS f32x4*)(lds + 65536 + ((w * NTB + tb) * 64 + lane) * 16) = acc1[tb]; }
    __syncthreads();
    if (w < NTB) {
        f32x4 s0 = (f32x4){0.f, 0.f, 0.f, 0.f}, s1 = s0;
#pragma unroll
        for (int ww = 0; ww < 8; ++ww) { s0 += *(const PG8_LAS f32x4*)(lds + ((ww * NTB + w) * 64 + lane) * 16); if (PAIRED) s1 += *(const PG8_LAS f32x4*)(lds + 65536 + ((ww * NTB + w) * 64 + lane) * 16); }
        epi(s0, s1, TP + tok0 + 16 * w + r16, 4 * q);
    }
}
__device__ __forceinline__ u32x2 pack4(const f32x4 v) { u32x2 w; w.x = cvt_pk_bf16(v[0], v[1]); w.y = cvt_pk_bf16(v[2], v[3]); return w; }
__device__ __forceinline__ f32x4 unpack4(const u32x2 w) { return (f32x4){bf_lo(w.x), bf_hi(w.x), bf_lo(w.y), bf_hi(w.y)}; }

struct EpiNull {
    static constexpr bool PERM = true, AFTER_DRAIN = false, PREFETCH = false;
    float* sink;
    __device__ __forceinline__ void operator()(const f32x4 (&acc)[2][2][4][2], const Unit& u, int wr, int wc, int fr, int fq) const {
        if (acc[0][0][0][0][0] == 1.2345e-33f) *sink = 1.f;
    }
};

template <int MODE> struct EpiProbe {
    static constexpr bool PERM = true, AFTER_DRAIN = false, PREFETCH = false;
    unsigned char* ws; float* sink;
    __device__ __forceinline__ void operator()(const f32x4 (&acc)[2][2][4][2], const Unit& u, int wr, int wc, int fr, int fq) const {
        const int row0 = u.pm * 256 + wr * 64 + fr; bf16_t* base = (bf16_t*)(ws + WS_FF) + u.pn * 128 + wc * 32 + 8 * fq;
        if (MODE == 0) {
#pragma unroll
            for (int g = 0; g < 8; ++g) { EPI_G(g); *(u32x4*)(base + (size_t)row * DFF) = pack8(acc[ai][0][m][0] + acc[ai][1][m][0], acc[ai][0][m][1] + acc[ai][1][m][1]); }
        } else {
            f32x4 s = (f32x4){0.f, 0.f, 0.f, 0.f};
#pragma unroll
            for (int g = 0; g < 8; ++g) { EPI_G(g); (void)row; s += acc[ai][0][m][0] + acc[ai][1][m][0] + acc[ai][0][m][1] + acc[ai][1][m][1]; }
            if (s[0] + s[1] + s[2] + s[3] == 1.2345e-33f) *sink = 1.f;
        }
    }
};
__device__ __forceinline__ int otid() { int t = threadIdx.x; asm volatile("" : "+v"(t)); return t; }
struct Args { const float* in[25]; float* out; unsigned char* ws; int ph_lo, ph_hi; };
enum { I_XP = 0, I_XS, I_SCONV, I_SRE, I_SIM, I_N1G, I_WIN, I_CONVW, I_CONVB, I_LRE, I_LIM, I_LDT, I_BRE, I_BIM, I_CRE, I_CIM, I_SD, I_WGLU, I_BGLU, I_WBR, I_WOUT, I_N2G, I_WGU, I_WDN, I_FG };

__device__ __forceinline__ int perm_in(int n0) { if (n0 < 512 || n0 >= 1536) return n0; const int q = n0 - 512, tl = q >> 8, rr = q & 255; return rr < 128 ? 512 + tl * 128 + rr : 1024 + tl * 128 + (rr - 128); }
__device__ __forceinline__ int perm_gu(int n0) { const int tl = n0 >> 8, rr = n0 & 255; return rr < 128 ? tl * 128 + rr : DFF + tl * 128 + (rr - 128); }

constexpr int P0_PER = 256 + 16 + 32 + 32 + 64 + 352 + 176;
__device__ __forceinline__ void p0_weights(const Args& a, float* tile, int it_lo, int it_hi, int vb, int nvb) {
    constexpr int PER = P0_PER, TP_ = 260;
    unsigned char* ws = a.ws; const int tid = otid(); const __amdgpu_buffer_rsrc_t rwp = __builtin_amdgcn_make_buffer_rsrc(ws, 0, (int)WS_ZEND, WT_FLAGS);
    for (int it = it_lo + vb; it < it_hi; it += nvb) {
        const int l = it / PER; int r = it % PER;
        const float* src; const float* gs = nullptr; bf16_t* dst; int ldn, K, n0, k0, sn0, sn1;
        if (r < 256) { n0 = (r >> 4) * 256; k0 = (r & 15) * 64; src = a.in[I_WIN] + (size_t)l * 1024 * 4096; ldn = 4096; K = 1024; dst = (bf16_t*)(ws + WS_WIN + l * SZ_WIN); gs = a.in[I_N1G] + l * 1024; sn0 = perm_in(n0); sn1 = perm_in(n0 + 128); }
        else if ((r -= 256) < 16) { n0 = (r >> 3) * 256; k0 = (r & 7) * 64; src = a.in[I_WGLU] + (size_t)l * 512 * 512; ldn = 512; K = 512; dst = (bf16_t*)(ws + WS_WGLU + l * SZ_WGLU); sn0 = n0; sn1 = n0 + 128; }
        else if ((r -= 16) < 32) { n0 = (r >> 3) * 256; k0 = (r & 7) * 64; src = a.in[I_WBR] + (size_t)l * 1024 * 1024; ldn = 1024; K = 512; dst = (bf16_t*)(ws + WS_WBA + l * SZ_WB); sn0 = n0; sn1 = n0 + 128; }
        else if ((r -= 32) < 32) { n0 = (r >> 3) * 256; k0 = (r & 7) * 64; src = a.in[I_WBR] + (size_t)l * 1024 * 1024 + (size_t)512 * 1024; ldn = 1024; K = 512; dst = (bf16_t*)(ws + WS_WBB + l * SZ_WB); sn0 = n0; sn1 = n0 + 128; }
        else if ((r -= 32) < 64) { n0 = (r >> 4) * 256; k0 = (r & 15) * 64; src = a.in[I_WOUT] + (size_t)l * 1024 * 1024; ldn = 1024; K = 1024; dst = (bf16_t*)(ws + WS_WOUT + l * SZ_WOUT); sn0 = n0; sn1 = n0 + 128; }
        else if ((r -= 64) < 352) { n0 = (r >> 4) * 256; k0 = (r & 15) * 64; src = a.in[I_WGU] + (size_t)l * 1024 * 5632; ldn = 5632; K = 1024; dst = (bf16_t*)(ws + WS_WGU + l * SZ_WGU); gs = a.in[I_N2G] + l * 1024; sn0 = perm_gu(n0); sn1 = perm_gu(n0 + 128); }
        else { r -= 352; n0 = (r / 44) * 256; k0 = (r % 44) * 64; src = a.in[I_WDN] + (size_t)l * DFF * 1024; ldn = 1024; K = DFF; dst = (bf16_t*)(ws + WS_WDN + l * SZ_WDN); sn0 = n0; sn1 = n0 + 128; }
        f32x4 v[8];
#pragma unroll
        for (int j = 0; j < 8; ++j) { const int idx = tid + 512 * j, k = idx >> 6, n = (idx & 63) * 4; v[j] = *(const f32x4*)(src + (size_t)(k0 + k) * ldn + (n < 128 ? sn0 + n : sn1 + n - 128)); }
        __syncthreads();
#pragma unroll
        for (int j = 0; j < 8; ++j) { const int idx = tid + 512 * j, k = idx >> 6, n = (idx & 63) * 4; f32x4 x = v[j]; if (gs) x *= gs[k0 + k]; *(f32x4*)(tile + k * TP_ + n) = x; }
        __syncthreads();
#pragma unroll
        for (int j = 0; j < 4; ++j) { const int idx = tid + 512 * j, n = idx & 255, kg = idx >> 8; const float* tp = tile + (8 * kg) * TP_ + n; u32x4 w;
            w.x = cvt_pk_bf16(tp[0], tp[TP_]); w.y = cvt_pk_bf16(tp[2 * TP_], tp[3 * TP_]); w.z = cvt_pk_bf16(tp[4 * TP_], tp[5 * TP_]); w.w = cvt_pk_bf16(tp[6 * TP_], tp[7 * TP_]);
            wt16(rwp, ws, dst + (size_t)(n0 + n) * K + k0 + 8 * kg, w); }
    }
}
__device__ __forceinline__ void p0_ssm(const Args& a) {
    float* ABAR = (float*)(a.ws + WS_ABAR); float* APOW = (float*)(a.ws + WS_APOW); float* BBAR = (float*)(a.ws + WS_BBAR); u32x4* BBF = (u32x4*)(a.ws + WS_BBF); const int tx0_ = otid();
    for (int i = blockIdx.x * 512 + tx0_; i < NL * NG * NP; i += gridDim.x * 512) {
        const int lg = i >> 6;
        const float dt = expf(a.in[I_LDT][lg]), lr = a.in[I_LRE][i], li = a.in[I_LIM][i];
        const float mag = expf(lr * dt), ang = li * dt; float sn, cs; sincosf(ang, &sn, &cs);
        const float ar = mag * cs, ai = mag * sn, nr = ar - 1.0f, ni = ai, den = lr * lr + li * li, fr = (nr * lr + ni * li) / den, fi = (ni * lr - nr * li) / den;
        ABAR[2 * i] = ar; ABAR[2 * i + 1] = ai;
        float pr = ar, pi = ai;
#pragma unroll
        for (int s = 0; s < 6; ++s) { const float tr = pr * pr - pi * pi, ti = 2.0f * pr * pi; pr = tr; pi = ti; }
        APOW[2 * i] = pr; APOW[2 * i + 1] = pi;
        float bbr[16], bbi[16];
#pragma unroll
        for (int c = 0; c < 16; ++c) { const float br = a.in[I_BRE][(size_t)i * 16 + c], bi = a.in[I_BIM][(size_t)i * 16 + c]; bbr[c] = fr * br - fi * bi; bbi[c] = fr * bi + fi * br; BBAR[((size_t)lg * 32 + c) * NP + (i & 63)] = bbr[c]; BBAR[((size_t)lg * 32 + 16 + c) * NP + (i & 63)] = bbi[c]; }
        const int p = i & 63, sh = p >> 5, n = p & 31;
#pragma unroll
        for (int h = 0; h < 2; ++h) {
            u32x4 wr_, wi_; wr_.x = cvt_pk_bf16(bbr[8 * h], bbr[8 * h + 1]); wr_.y = cvt_pk_bf16(bbr[8 * h + 2], bbr[8 * h + 3]); wr_.z = cvt_pk_bf16(bbr[8 * h + 4], bbr[8 * h + 5]); wr_.w = cvt_pk_bf16(bbr[8 * h + 6], bbr[8 * h + 7]);
            wi_.x = cvt_pk_bf16(bbi[8 * h], bbi[8 * h + 1]); wi_.y = cvt_pk_bf16(bbi[8 * h + 2], bbi[8 * h + 3]); wi_.z = cvt_pk_bf16(bbi[8 * h + 4], bbi[8 * h + 5]); wi_.w = cvt_pk_bf16(bbi[8 * h + 6], bbi[8 * h + 7]);
            BBF[((size_t)lg * 4 + 2 * sh) * 64 + 32 * h + n] = wr_; BBF[((size_t)lg * 4 + 2 * sh + 1) * 64 + 32 * h + n] = wi_; }
    }
    u32x4* CMF = (u32x4*)(a.ws + WS_CMF);
    for (int i = blockIdx.x * 512 + tx0_; i < NL * NG * 5 * 64; i += gridDim.x * 512) {
        const int lane = i & 63, ks = (i >> 6) % 5, lg = i / 320, ch = lane & 15, q = lane >> 4; float v[8];
#pragma unroll
        for (int j = 0; j < 8; ++j) {
            if (ks < 4) { const int k = 32 * ks + 8 * q + j, sh = k >> 6, kk = k & 63, p = sh * 32 + (kk >> 1); const size_t ci = ((size_t)lg * 16 + ch) * NP + p; v[j] = (kk & 1) ? -a.in[I_CIM][ci] : a.in[I_CRE][ci]; }
            else v[j] = (8 * q + j == ch) ? a.in[I_SD][(size_t)lg * 16 + ch] : 0.f; }
        u32x4 w; w.x = cvt_pk_bf16(v[0], v[1]); w.y = cvt_pk_bf16(v[2], v[3]); w.z = cvt_pk_bf16(v[4], v[5]); w.w = cvt_pk_bf16(v[6], v[7]); CMF[i] = w;
    }
}
__device__ __forceinline__ void p0_x(const Args& a) {
    float* X = a.out; bf16_t* XB = (bf16_t*)(a.ws + WS_XB); float* RS = (float*)(a.ws + WS_ROWSS);
    int tx_ = threadIdx.x; asm volatile("" : "+v"(tx_)); const int lane = tx_ & 63, gw = blockIdx.x * 8 + (tx_ >> 6), nw = gridDim.x * 8;
    for (int i = blockIdx.x * 512 + tx_; i < 9 * MP; i += gridDim.x * 512) if (i >= T) RS[i] = 0.f;
    for (int r0 = gw; r0 < T; r0 += 2 * nw) {
        f32x4 v[2][4];
#pragma unroll
        for (int k = 0; k < 2; ++k) { const int row = r0 + k * nw; if (row < T) { const float* src = row < TP ? a.in[I_XP] + (size_t)row * D : a.in[I_XS] + (size_t)(row - TP) * D;
#pragma unroll
            for (int j = 0; j < 2; ++j) { const int c = j * 512 + lane * 8; v[k][2 * j] = *(const f32x4*)(src + c); v[k][2 * j + 1] = *(const f32x4*)(src + c + 4); } } }
#pragma unroll
        for (int k = 0; k < 2; ++k) { const int row = r0 + k * nw; if (row < T) { float ss = 0.f;
#pragma unroll
            for (int j = 0; j < 2; ++j) { const int c = j * 512 + lane * 8; const f32x4 v0 = v[k][2 * j], v1 = v[k][2 * j + 1];
                *(f32x4*)(X + (size_t)row * D + c) = v0; *(f32x4*)(X + (size_t)row * D + c + 4) = v1; *(u32x4*)(XB + (size_t)row * D + c) = pack8(v0, v1);
                ss += (v0[0] * v0[0] + v0[1] * v0[1]) + (v0[2] * v0[2] + v0[3] * v0[3]) + (v1[0] * v1[0] + v1[1] * v1[1]) + (v1[2] * v1[2] + v1[3] * v1[3]); }
#pragma unroll
            for (int o = 32; o >= 1; o >>= 1) ss += __shfl_xor(ss, o);
            if (lane == 0) RS[row] = ss; } }
    }
}
__device__ __forceinline__ void final_norm(const Args& a) {
    float* X = a.out; const float* RS = (const float*)(a.ws + WS_ROWSS) + 8 * (size_t)MP; const float* g = a.in[I_FG];
    int tx_ = threadIdx.x; asm volatile("" : "+v"(tx_)); const int lane = tx_ & 63, gw = blockIdx.x * 8 + (tx_ >> 6), nw = gridDim.x * 8;
    f32x4 gg[4];
#pragma unroll
    for (int j = 0; j < 4; ++j) gg[j] = *(const f32x4*)(g + j * 256 + lane * 4);
    for (int r0 = gw; r0 < T; r0 += 2 * nw) {
        f32x4 v[2][4]; float rsv[2];
#pragma unroll
        for (int k = 0; k < 2; ++k) { const int row = r0 + k * nw; if (row < T) { rsv[k] = RS[row];
#pragma unroll
            for (int j = 0; j < 4; ++j) v[k][j] = *(const f32x4*)(X + (size_t)row * D + j * 256 + lane * 4); } }
#pragma unroll
        for (int k = 0; k < 2; ++k) { const int row = r0 + k * nw; if (row < T) { const float rs = rsqrtf(rsv[k] * (1.0f / 1024.0f) + EPS);
#pragma unroll
            for (int j = 0; j < 4; ++j) *(f32x4*)(X + (size_t)row * D + j * 256 + lane * 4) = v[k][j] * rs * gg[j]; } }
    }
}
__device__ __forceinline__ void conv_phase(const Args& a, int l) {
    bf16_t* ZB = (bf16_t*)(a.ws + WS_ZB); const bf16_t* CV = (const bf16_t*)(a.ws + WS_CV);
    const float* cw = a.in[I_CONVW] + (size_t)l * 3 * CW; const float* cb = a.in[I_CONVB] + (size_t)l * CW; const float* sc = a.in[I_SCONV] + (size_t)l * TS * 2 * CW;
    const int txc_ = otid(); const int c8 = (txc_ & 63) * 8; const __amdgpu_buffer_rsrc_t rwc = __builtin_amdgcn_make_buffer_rsrc(a.ws, 0, (int)WS_ZEND, WT_FLAGS);
    const f32x4 w0a = *(const f32x4*)(cw + c8), w0b = *(const f32x4*)(cw + c8 + 4), w1a = *(const f32x4*)(cw + CW + c8), w1b = *(const f32x4*)(cw + CW + c8 + 4),
                w2a = *(const f32x4*)(cw + 2 * CW + c8), w2b = *(const f32x4*)(cw + 2 * CW + c8 + 4), ba = *(const f32x4*)(cb + c8), bb = *(const f32x4*)(cb + c8 + 4);
    const f32x4 zero = (f32x4){0.f, 0.f, 0.f, 0.f};
    for (int r0 = blockIdx.x * 8 + (txc_ >> 6); r0 < T; r0 += gridDim.x * 32) {
        u32x4 zr[4], x0r[4], x1r[4], x2r[4]; f32x4 s1a[4], s1b[4], s2a[4], s2b[4];
#pragma unroll
        for (int k = 0; k < 4; ++k) { const int row = r0 + k * gridDim.x * 8; if (row < T) { const size_t off = (size_t)row * 512 + c8;
            zr[k] = *(const u32x4*)(ZB + off); x0r[k] = *(const u32x4*)(CV + off);
            if (row < TP) { const int t = row & (SEQ - 1); x1r[k] = (u32x4){0u, 0u, 0u, 0u}; x2r[k] = x1r[k]; if (t >= 1) x1r[k] = *(const u32x4*)(CV + off - 512); if (t >= 2) x2r[k] = *(const u32x4*)(CV + off - 1024); }
            else { const float* s0 = sc + (size_t)(row - TP) * 2 * CW + c8; s2a[k] = *(const f32x4*)s0; s2b[k] = *(const f32x4*)(s0 + 4); s1a[k] = *(const f32x4*)(s0 + CW); s1b[k] = *(const f32x4*)(s0 + CW + 4); } } }
        asm volatile("" ::: "memory");
#pragma unroll
        for (int k = 0; k < 4; ++k) { const int row = r0 + k * gridDim.x * 8; if (row < T) { const size_t off = (size_t)row * 512 + c8;
            f32x4 z0, z1, x0a, x0b, x1a, x1b, x2a, x2b; unpack8(zr[k], z0, z1); unpack8(x0r[k], x0a, x0b);
            if (row < TP) { const int t = row & (SEQ - 1); unpack8(x1r[k], x1a, x1b); unpack8(x2r[k], x2a, x2b);
                if (t >= SEQ - 2) { float* o = a.out + O_PC + ((size_t)(l * NB + (row >> 11)) * 2 + (t - (SEQ - 2))) * CW + c8; *(f32x4*)o = x0a; *(f32x4*)(o + 4) = x0b; } }
            else { const int b = row - TP; x1a = s1a[k]; x1b = s1b[k]; x2a = s2a[k]; x2b = s2b[k];
                float* o = a.out + O_SC + (size_t)(l * TS + b) * 2 * CW + c8; *(f32x4*)o = x1a; *(f32x4*)(o + 4) = x1b; *(f32x4*)(o + CW) = x0a; *(f32x4*)(o + CW + 4) = x0b; }
            const f32x4 oa = z0 * (ba + w0a * x2a + w1a * x1a + w2a * x0a), ob = z1 * (bb + w0b * x2b + w1b * x1b + w2b * x0b);
            wt16(rwc, a.ws, ZB + off, pack8(oa, ob)); } }
    }
}
struct SsmW { float ar, ai; float bbr[16], bbi[16]; };
template <bool OUT> __device__ __forceinline__ void ssm_run(const bf16_t* U, bf16_t* GY, int row0, int ntok, int g, float& hr, float& hi, const float ar, const float ai,
                                                            const float (&bbr)[16], const float (&bbi)[16], const float (&cr)[16], const float (&ci)[16], const float (&dl)[16], int lane) {
    for (int t0 = 0; t0 < ntok; t0 += 64) {
        const int nt = (ntok - t0) < 64 ? (ntok - t0) : 64;
        u32x4 w0 = (u32x4){0u, 0u, 0u, 0u}, w1 = w0;
        if (lane < nt) { const u32x4* up = (const u32x4*)(U + (size_t)(row0 + t0 + lane) * 512 + g * 16); w0 = up[0]; w1 = up[1]; }
        for (int j = 0; j < nt; ++j) {
            unsigned ws_[8]; ws_[0] = __builtin_amdgcn_readlane(w0.x, j); ws_[1] = __builtin_amdgcn_readlane(w0.y, j); ws_[2] = __builtin_amdgcn_readlane(w0.z, j); ws_[3] = __builtin_amdgcn_readlane(w0.w, j);
            ws_[4] = __builtin_amdgcn_readlane(w1.x, j); ws_[5] = __builtin_amdgcn_readlane(w1.y, j); ws_[6] = __builtin_amdgcn_readlane(w1.z, j); ws_[7] = __builtin_amdgcn_readlane(w1.w, j);
            float uu[16];
#pragma unroll
            for (int q = 0; q < 8; ++q) { uu[2 * q] = bf_lo(ws_[q]); uu[2 * q + 1] = bf_hi(ws_[q]); }
            float bur = 0.f, bui = 0.f;
#pragma unroll
            for (int c = 0; c < 16; ++c) { bur = fmaf(bbr[c], uu[c], bur); bui = fmaf(bbi[c], uu[c], bui); }
            const float nhr = ar * hr - ai * hi + bur, nhi = ar * hi + ai * hr + bui; hr = nhr; hi = nhi;
            if (OUT) {
                float v[16];
#pragma unroll
                for (int c = 0; c < 16; ++c) v[c] = fmaf(dl[c], uu[c], cr[c] * hr - ci[c] * hi);
                float w8[8], w4[4], w2[2], w1_;
                { const bool up = lane & 32;
#pragma unroll
                  for (int k = 0; k < 8; ++k) { const float send = up ? v[k] : v[k + 8], keep = up ? v[k + 8] : v[k]; w8[k] = keep + __shfl_xor(send, 32); } }
                { const bool up = lane & 16;
#pragma unroll
                  for (int k = 0; k < 4; ++k) { const float send = up ? w8[k] : w8[k + 4], keep = up ? w8[k + 4] : w8[k]; w4[k] = keep + __shfl_xor(send, 16); } }
                { const bool up = lane & 8;
#pragma unroll
                  for (int k = 0; k < 2; ++k) { const float send = up ? w4[k] : w4[k + 2], keep = up ? w4[k + 2] : w4[k]; w2[k] = keep + __shfl_xor(send, 8); } }
                { const bool up = lane & 4; const float send = up ? w2[0] : w2[1], keep = up ? w2[1] : w2[0]; w1_ = keep + __shfl_xor(send, 4); }
                w1_ += __shfl_xor(w1_, 2); w1_ += __shfl_xor(w1_, 1);
                const float gy = 0.5f * w1_ * (1.0f + erff(w1_ * 0.70710678118f));
                if ((lane & 3) == 0) GY[(size_t)(row0 + t0 + j) * 512 + g * 16 + (lane >> 2)] = (bf16_t)(cvt_pk_bf16(gy, gy) & 0xffffu);
            }
        }
    }
}
__device__ __forceinline__ void ssm_sample_phase(const Args& a, int l) {
    const bf16_t* U = (const bf16_t*)(a.ws + WS_U); bf16_t* GY = (bf16_t*)(a.ws + WS_GY);
    const float* ABAR = (const float*)(a.ws + WS_ABAR); const float* BBAR = (const float*)(a.ws + WS_BBAR);
    int tx_ = threadIdx.x; asm volatile("" : "+v"(tx_)); const int lane = tx_ & 63, gw = blockIdx.x * 8 + (tx_ >> 6), nw = gridDim.x * 8;
    for (int item = gw; item < TS * NG; item += nw) {
        const int b = item >> 5, g = item & 31, i = (l * NG + g) * NP + lane;
        const float ar = ABAR[2 * i], ai = ABAR[2 * i + 1];
        float bbr[16], bbi[16], cr[16], ci[16], dl[16];
#pragma unroll
        for (int c = 0; c < 16; ++c) { bbr[c] = BBAR[((size_t)(l * NG + g) * 32 + c) * NP + lane]; bbi[c] = BBAR[((size_t)(l * NG + g) * 32 + 16 + c) * NP + lane]; const size_t ci_ = ((size_t)(l * NG + g) * 16 + c) * NP + lane; cr[c] = a.in[I_CRE][ci_]; ci[c] = a.in[I_CIM][ci_]; dl[c] = lane == 0 ? a.in[I_SD][(size_t)l * 512 + g * 16 + c] : 0.f; }
        const size_t si = ((size_t)(l * TS + b) * NG + g) * NP + lane; float hr = a.in[I_SRE][si], hi = a.in[I_SIM][si];
        ssm_run<true>(U, GY, TP + b, 1, g, hr, hi, ar, ai, bbr, bbi, cr, ci, dl, lane);
        a.out[O_SRE + si] = hr; a.out[O_SIM + si] = hi;
    }
}
typedef float f32x16 __attribute__((ext_vector_type(16)));
constexpr int SSM_HP = 272, SSM_WAVE_LDS = 32 * SSM_HP;
__device__ __forceinline__ void ssm_pass1_dual(const Args& a, int l) {
    const bf16_t* U = (const bf16_t*)(a.ws + WS_U); const float* ABAR = (const float*)(a.ws + WS_ABAR); float* E = (float*)(a.ws + WS_E); const u32x4* BBF = (const u32x4*)(a.ws + WS_BBF);
    int tx_ = threadIdx.x; asm volatile("" : "+v"(tx_)); const int lane = tx_ & 63, gw = blockIdx.x * 8 + (tx_ >> 6), nw = gridDim.x * 8, n = lane & 31, hh = lane >> 5;
    for (int item = gw; item < NB * NG * 8; item += nw) {
        const int b0 = item >> 9, g = (item >> 4) & 31, ch = item & 15, lg = l * NG + g;
        float ar[2], ai[2], hr[2][2] = {{0.f, 0.f}, {0.f, 0.f}}, hi[2][2] = {{0.f, 0.f}, {0.f, 0.f}};
#pragma unroll
        for (int sh = 0; sh < 2; ++sh) { const int i = lg * NP + sh * 32 + n; ar[sh] = ABAR[2 * i]; ai[sh] = ABAR[2 * i + 1]; }
        pg8::bf16x8 bf[4];
#pragma unroll
        for (int ct = 0; ct < 4; ++ct) bf[ct] = __builtin_bit_cast(pg8::bf16x8, BBF[((size_t)lg * 4 + ct) * 64 + lane]);
        const bf16_t* up0 = U + (size_t)(b0 * SEQ + ch * 128 + 64 * ((n >> 2) & 1) + 4 * (n >> 3) + (n & 3)) * 512 + g * 16 + 8 * hh;
        u32x4 cur0 = *(const u32x4*)up0, cur1 = *(const u32x4*)(up0 + (size_t)4 * SEQ * 512);
#pragma unroll 1
        for (int rt = 0; rt < 4; ++rt) {
            const int rn = rt < 3 ? rt + 1 : 3;
            const u32x4 nxt0 = *(const u32x4*)(up0 + (size_t)(16 * rn) * 512), nxt1 = *(const u32x4*)(up0 + (size_t)(4 * SEQ + 16 * rn) * 512);
            f32x16 acc[2][4];
#pragma unroll
            for (int ct = 0; ct < 4; ++ct) { f32x16 z;
#pragma unroll
                for (int i = 0; i < 16; ++i) z[i] = 0.f;
                acc[0][ct] = __builtin_amdgcn_mfma_f32_32x32x16_bf16(__builtin_bit_cast(pg8::bf16x8, cur0), bf[ct], z, 0, 0, 0);
                acc[1][ct] = __builtin_amdgcn_mfma_f32_32x32x16_bf16(__builtin_bit_cast(pg8::bf16x8, cur1), bf[ct], z, 0, 0, 0); }
#pragma unroll
            for (int i = 0; i < 16; ++i)
#pragma unroll
                for (int sh = 0; sh < 2; ++sh)
#pragma unroll
                    for (int it = 0; it < 2; ++it) { const float nr = ar[sh] * hr[it][sh] - ai[sh] * hi[it][sh] + acc[it][2 * sh][i], ni = ar[sh] * hi[it][sh] + ai[sh] * hr[it][sh] + acc[it][2 * sh + 1][i]; hr[it][sh] = nr; hi[it][sh] = ni; }
            cur0 = nxt0; cur1 = nxt1;
        }
#pragma unroll
        for (int it = 0; it < 2; ++it)
#pragma unroll
            for (int sh = 0; sh < 2; ++sh) { const size_t ei = (((size_t)((b0 + 4 * it) * NG + g) * NCH + 2 * ch + hh) * NP + sh * 32 + n) * 2; E[ei] = hr[it][sh]; E[ei + 1] = hi[it][sh]; }
    }
}
template <bool PASS2> __device__ __forceinline__ void ssm_mfma_phase(const Args& a, int l, PG8_LAS unsigned char* lds) {
    const bf16_t* U = (const bf16_t*)(a.ws + WS_U); bf16_t* GY = (bf16_t*)(a.ws + WS_GY);
    const float* ABAR = (const float*)(a.ws + WS_ABAR); const float* APOW = (const float*)(a.ws + WS_APOW); float* E = (float*)(a.ws + WS_E);
    const u32x4* BBF = (const u32x4*)(a.ws + WS_BBF); const u32x4* CMF = (const u32x4*)(a.ws + WS_CMF);
    int tx_ = threadIdx.x; asm volatile("" : "+v"(tx_)); const int lane = tx_ & 63, wid = tx_ >> 6, gw = blockIdx.x * 8 + wid, nw = gridDim.x * 8;
    const int n = lane & 31, hh = lane >> 5, t16 = lane & 15, q = lane >> 4;
    PG8_LAS unsigned char* hl = lds + wid * SSM_WAVE_LDS;
    PG8_LAS float* Elds = (PG8_LAS float*)(lds + 81920);
    (void)gw; (void)nw; (void)E;
#pragma unroll 1
    for (int kk = 0; kk < 2; ++kk) {
        const int b = blockIdx.x >> 5, g = blockIdx.x & 31, ch = 2 * wid + kk, lg = l * NG + g;
        float ar[2], ai[2], hr[2] = {0.f, 0.f}, hi[2] = {0.f, 0.f};
#pragma unroll
        for (int sh = 0; sh < 2; ++sh) { const int i = lg * NP + sh * 32 + n; ar[sh] = ABAR[2 * i]; ai[sh] = ABAR[2 * i + 1]; }
        pg8::bf16x8 bf[4];
#pragma unroll
        for (int ct = 0; ct < 4; ++ct) bf[ct] = __builtin_bit_cast(pg8::bf16x8, BBF[((size_t)lg * 4 + ct) * 64 + lane]);
        pg8::bf16x8 cm[5];
        if (PASS2) {
#pragma unroll
            for (int ks = 0; ks < 5; ++ks) cm[ks] = __builtin_bit_cast(pg8::bf16x8, CMF[((size_t)lg * 5 + ks) * 64 + lane]);
            const int sc = 2 * ch + hh; float pr[2], pi[2];
#pragma unroll
            for (int sh = 0; sh < 2; ++sh) { const int i = lg * NP + sh * 32 + n; pr[sh] = APOW[2 * i]; pi[sh] = APOW[2 * i + 1]; }
            typedef float f32x2_ __attribute__((ext_vector_type(2)));
            const PG8_LAS f32x2_* Eb = (const PG8_LAS f32x2_*)Elds + n;
            for (int jb = 0; jb < 2 * ch + 1; jb += 8) {
                f32x2_ e0[8], e1[8];
#pragma unroll
                for (int jj = 0; jj < 8; ++jj) { e0[jj] = Eb[(jb + jj) * NP]; e1[jj] = Eb[(jb + jj) * NP + 32]; }
#pragma unroll
                for (int jj = 0; jj < 8; ++jj) if (jb + jj < sc) {
                    const float tr0 = pr[0] * hr[0] - pi[0] * hi[0] + e0[jj].x, ti0 = pr[0] * hi[0] + pi[0] * hr[0] + e0[jj].y; hr[0] = tr0; hi[0] = ti0;
                    const float tr1 = pr[1] * hr[1] - pi[1] * hi[1] + e1[jj].x, ti1 = pr[1] * hi[1] + pi[1] * hr[1] + e1[jj].y; hr[1] = tr1; hi[1] = ti1; }
            }
        }
        const int row0 = b * SEQ + ch * 128;
        u32x4 afr4[4], uw4[4][2];
#pragma unroll
        for (int rt = 0; rt < 4; ++rt) {
            const int tau = 64 * ((n >> 2) & 1) + 16 * rt + 4 * (n >> 3) + (n & 3);
            afr4[rt] = *(const u32x4*)(U + (size_t)(row0 + tau) * 512 + g * 16 + 8 * hh);
            if (PASS2) {
#pragma unroll
                for (int tb = 0; tb < 2; ++tb) { uw4[rt][tb] = (u32x4){0u, 0u, 0u, 0u}; if (q < 2) uw4[rt][tb] = *(const u32x4*)(U + (size_t)(row0 + 64 * tb + 16 * rt + t16) * 512 + g * 16 + 8 * q); } }
        }
#pragma unroll
        for (int rt = 0; rt < 4; ++rt) {
            const pg8::bf16x8 afr = __builtin_bit_cast(pg8::bf16x8, afr4[rt]);
            f32x16 acc[4];
#pragma unroll
            for (int ct = 0; ct < 4; ++ct) { f32x16 z;
#pragma unroll
                for (int i = 0; i < 16; ++i) z[i] = 0.f;
                acc[ct] = __builtin_amdgcn_mfma_f32_32x32x16_bf16(afr, bf[ct], z, 0, 0, 0); }
#pragma unroll
            for (int sh = 0; sh < 2; ++sh)
#pragma unroll
                for (int i = 0; i < 16; ++i) { const float nr = ar[sh] * hr[sh] - ai[sh] * hi[sh] + acc[2 * sh][i], ni = ar[sh] * hi[sh] + ai[sh] * hr[sh] + acc[2 * sh + 1][i]; hr[sh] = nr; hi[sh] = ni;
                    if (PASS2) *(PG8_LAS unsigned*)(hl + (16 * hh + i) * SSM_HP + sh * 128 + 4 * n) = cvt_pk_bf16(nr, ni); }
            if (PASS2) {
                asm volatile("s_waitcnt lgkmcnt(0)" ::: "memory");
#pragma unroll
                for (int tb = 0; tb < 2; ++tb) {
                    f32x4 y = (f32x4){0.f, 0.f, 0.f, 0.f};
#pragma unroll
                    for (int ks = 0; ks < 4; ++ks) { const pg8::bf16x8 hf = __builtin_bit_cast(pg8::bf16x8, *(const PG8_LAS u32x4*)(hl + (16 * tb + t16) * SSM_HP + (32 * ks + 8 * q) * 2)); y = __builtin_amdgcn_mfma_f32_16x16x32_bf16(cm[ks], hf, y, 0, 0, 0); }
                    const size_t trow = (size_t)(row0 + 64 * tb + 16 * rt + t16) * 512 + g * 16;
                    y = __builtin_amdgcn_mfma_f32_16x16x32_bf16(cm[4], __builtin_bit_cast(pg8::bf16x8, uw4[rt][tb]), y, 0, 0, 0);
                    const pg8::f32x2 ga = pg8::gelu_pk((pg8::f32x2){y[0], y[1]}), gb = pg8::gelu_pk((pg8::f32x2){y[2], y[3]});
                    u32x2 w; w.x = cvt_pk_bf16(ga.x, ga.y); w.y = cvt_pk_bf16(gb.x, gb.y); *(u32x2*)(GY + trow + 4 * q) = w;
                }
                asm volatile("s_waitcnt lgkmcnt(0)" ::: "memory");
            }
        }
        if (!PASS2) {
#pragma unroll
            for (int sh = 0; sh < 2; ++sh) { const int ei = ((2 * ch + hh) * NP + sh * 32 + n) * 2; Elds[ei] = hr[sh]; Elds[ei + 1] = hi[sh]; }
        } else if (ch == 15 && hh == 1) {
#pragma unroll
            for (int sh = 0; sh < 2; ++sh) { const size_t oi = ((size_t)(l * NB + b) * NG + g) * NP + sh * 32 + n; a.out[O_PRE + oi] = hr[sh]; a.out[O_PIM + oi] = hi[sh]; }
        }
    }
}
#define XB_TMO      128
#define XB_XCNT(j)  (256  + 64 * (j))
#define XB_XSUB(j)  (1280 + 64 * (j))
#define XB_XGEN(j)  (2304 + 64 * (j))
#define XB_TOP      3328
#define XB_TOPGEN   3392
#define XCD_BAR_WORDS 3456
#define XB_SPIN_CAP (1u << 18)

__device__ __forceinline__ unsigned xb_ld(unsigned* p)              { return __hip_atomic_load(p, __ATOMIC_RELAXED, __HIP_MEMORY_SCOPE_AGENT); }
__device__ __forceinline__ unsigned xb_add(unsigned* p, unsigned v) { return __hip_atomic_fetch_add(p, v, __ATOMIC_RELAXED, __HIP_MEMORY_SCOPE_AGENT); }
__device__ __forceinline__ unsigned xb_xcc_id() { return (unsigned)__builtin_amdgcn_s_getreg((3 << 11) | 20) & 0xFu; }
#define XB_SPIN(cond, bar) do { unsigned _sp = 0; while (cond) { __builtin_amdgcn_s_sleep(1); \
    if ((++_sp & 255u) == 0u) { if (xb_ld(&(bar)[XB_TMO])) break; if (_sp > XB_SPIN_CAP) { atomicAdd(&(bar)[XB_TMO], 1u); break; } } } } while (0)

struct XcdBarrier {
    unsigned* bar; unsigned x;
    volatile PG8_LAS unsigned* st;
};

__device__ __forceinline__ XcdBarrier xcd_barrier_post(unsigned* bar, volatile PG8_LAS unsigned* st) {
    XcdBarrier b; b.bar = bar; b.x = xb_xcc_id(); b.st = st;
    if (threadIdx.x == 0) { st[2] = xb_add(&bar[XB_XCNT(b.x)], 1u); st[3] = b.x; }
    return b;
}
__device__ __forceinline__ void xcd_barrier_complete(unsigned* bar, unsigned x, unsigned& nloc, unsigned& nx) {
    const unsigned G = gridDim.x * gridDim.y * gridDim.z;
    unsigned sum, cnt, mine, sp = 0u;
    for (;;) {
        sum = 0u; cnt = 0u; mine = 0u;
#pragma unroll
        for (unsigned j = 0; j < 16; ++j) { const unsigned c = xb_ld(&bar[XB_XCNT(j)]); sum += c; cnt += (c > 0u) ? 1u : 0u; mine = (j == x) ? c : mine; }
        if (sum == G) break;
        __builtin_amdgcn_s_sleep(1);
        if ((++sp & 255u) == 0u) { if (xb_ld(&bar[XB_TMO])) break; if (sp > XB_SPIN_CAP) { atomicAdd(&bar[XB_TMO], 1u); break; } }
    }
    nloc = mine > 0u ? mine : 1u; nx = cnt > 0u ? cnt : 1u;
}

__device__ __forceinline__ void xcd_barrier(const XcdBarrier& b) {
    asm volatile("s_waitcnt vmcnt(0)" ::: "memory");
    __syncthreads();
    if (threadIdx.x == 0) {
        unsigned* bar = b.bar;
        __builtin_amdgcn_s_waitcnt(0);
        unsigned nloc = b.st[0], nx = b.st[1];
        if (nloc == 0u) { xcd_barrier_complete(bar, b.x, nloc, nx); b.st[0] = nloc; b.st[1] = nx; }
        const unsigned old = xb_add(&bar[XB_XSUB(b.x)], 1u);
        const unsigned gen = old / nloc;
        if (old + 1u == (gen + 1u) * nloc) {
            __builtin_amdgcn_fence(__ATOMIC_RELEASE, "agent");
            asm volatile("s_waitcnt vmcnt(0)" ::: "memory");
            const unsigned og = xb_add(&bar[XB_TOP], 1u);
            const unsigned tg = og / nx;
            if (og + 1u == (tg + 1u) * nx) xb_add(&bar[XB_TOPGEN], 1u);
            else XB_SPIN(xb_ld(&bar[XB_TOPGEN]) == tg, bar);
            __builtin_amdgcn_fence(__ATOMIC_ACQUIRE, "agent");
            xb_add(&bar[XB_XGEN(b.x)], 1u);
            asm volatile("s_waitcnt vmcnt(0)" ::: "memory");
        } else {
            XB_SPIN(xb_ld(&bar[XB_XGEN(b.x)]) == gen, bar);
            __builtin_amdgcn_fence(__ATOMIC_ACQUIRE, "agent");
            asm volatile("s_waitcnt vmcnt(0)" ::: "memory");
        }
    }
    __syncthreads();
}

#ifndef PROBE
#define PROBE 0
#endif
#ifndef PM
#define PM 511
#endif
#ifndef ONE_LAUNCH
#define ONE_LAUNCH 1
#endif
constexpr int LDS_X = pg8::STAGE_BYTES + 64, LDS_BYTES = LDS_X + 4096;
constexpr size_t WS_BAR = (WS_END + 255) & ~(size_t)255, WS_TOTAL = WS_BAR + (size_t)XCD_BAR_WORDS * 4;
constexpr int N_PHASES = 2 + 8 * NL;

__global__ void __launch_bounds__(512, 2) mk_fwd(Args a) {
    extern __shared__ __attribute__((aligned(16))) unsigned char lds_raw[];
    PG8_LAS unsigned char* lds = (PG8_LAS unsigned char*)lds_raw;
    volatile PG8_LAS unsigned* bst = (volatile PG8_LAS unsigned*)(lds + pg8::STAGE_BYTES);
    if (threadIdx.x < 16) bst[threadIdx.x] = 0u;
    __syncthreads();
    const XcdBarrier gbar = xcd_barrier_post((unsigned*)(a.ws + WS_BAR), bst);
    if (a.ph_hi > 1000) cg::this_grid().sync();
    for (int ph = a.ph_lo; ph < a.ph_hi; ++ph) {
        if (ph > 0 && ph < N_PHASES - 1 && ((ph - 1) & 7) == 2) continue;
        size_t zoff_ = 0; int G = gridDim.x, bx = blockIdx.x; asm volatile("" : "+s"(zoff_), "+s"(G), "+s"(bx)); unsigned char* ws = a.ws + zoff_;
        bf16_t* XB = (bf16_t*)(ws + WS_XB); float* RS = (float*)(ws + WS_ROWSS);
        for (int rep = 0; rep < (((PROBE == 2 && ph == 0) || (PROBE == 3 && ph > 0 && ph < N_PHASES - 1 && (((ph - 1) & 7) == 0 || ((ph - 1) & 7) == 6)) || (PROBE == 7 && ph > 0 && ph < N_PHASES - 1 && ((ph - 1) & 7) == 6) || (PROBE == 8 && ph > 0 && ph < N_PHASES - 1 && ((ph - 1) & 7) == 0) || (PROBE == 4 && ph > 0 && ph < N_PHASES - 1 && (((ph - 1) & 7) == 1 || ((ph - 1) & 7) == 2))) ? 2 : 1); ++rep) {
        if (rep) __syncthreads();
        if ((PM & 1) && ph == 0) { p0_weights(a, (float*)lds_raw, 0, P0_PER, bx, G); p0_ssm(a); p0_x(a); }
        else if ((PM & 2) && ph == N_PHASES - 1) { final_norm(a); }
        else {
            const int l = (ph - 1) >> 3, s = (ph - 1) & 7;
            if ((PM & 4) && s == 0) {
                pg8::Gemm g{XB, (const bf16_t*)(ws + WS_WIN + l * SZ_WIN), TP, 4096, 1024}; pg8::StaticOrder S; S.init(TP, 4096, G, bx);
                EpiIn E{ws, RS + (size_t)(2 * l) * MP, lds + LDS_X};
                if (PROBE == 11) { EpiNull EN{(float*)(ws + WS_E)}; pg8::gemm_phase<EpiNull, pg8::StaticOrder, false>(lds, g, S, EN, nullptr); }
                pg8::gemm_phase<EpiIn, pg8::StaticOrder, false>(lds, g, S, E, nullptr); __syncthreads();
                if (bx < 224) {
                    const int su = bx; int n0, n1, kind, dc;
                    if (su < 32) { kind = 0; dc = 16 * su; n0 = dc; n1 = n0; } else if (su < 64) { kind = 1; dc = 16 * (su - 32); n0 = 512 + (dc >> 7) * 256 + (dc & 127); n1 = n0 + 128; }
                    else if (su < 96) { kind = 2; dc = 16 * (su - 64); n0 = 1536 + dc; n1 = n0; } else if (su < 160) { kind = 3; dc = 16 * (su - 96); n0 = 2048 + dc; n1 = n0; } else { kind = 4; dc = 16 * (su - 160); n0 = 3072 + dc; n1 = n0; }
                    const float* rowss = RS + (size_t)(2 * l) * MP;
                    skinny_unit<true, 8>(lds, XB + (size_t)TP * 1024, (const bf16_t*)(ws + WS_WIN + l * SZ_WIN), 1024, n0, n1, 0, otid(), [=](const f32x4 s0, const f32x4 s1, int row, int c4) {
                        const float rs = rsqrtf(rowss[row] * (1.0f / 1024.0f) + EPS); f32x4 v = s0 * rs;
                        if (kind == 1) v = v * (s1 * rs);
                        if (kind >= 3) { _Pragma("unroll") for (int j = 0; j < 4; ++j) v[j] = sigm(v[j]); }
                        bf16_t* dst = kind == 0 ? (bf16_t*)(ws + WS_ZB) + (size_t)row * 512 : kind == 1 ? (bf16_t*)(ws + WS_CV) + (size_t)row * 512 : kind == 2 ? (bf16_t*)(ws + WS_U) + (size_t)row * 512 : kind == 3 ? (bf16_t*)(ws + WS_SGA) + (size_t)row * 1024 : (bf16_t*)(ws + WS_SGS) + (size_t)row * 1024;
                        *(u32x2*)(dst + dc + c4) = pack4(v); });
                }
            } else if ((PM & 8) && s == 1) { if (!rep) conv_phase(a, l); ssm_sample_phase(a, l); __syncthreads(); ssm_mfma_phase<false>(a, l, lds); __syncthreads(); ssm_mfma_phase<true>(a, l, lds); }
            else if ((PM & 16) && s == 2) { }
            else if ((PM & 32) && s == 3) {
                { pg8::Gemm g{(const bf16_t*)(ws + WS_ZB), (const bf16_t*)(ws + WS_WBA + l * SZ_WB), TP, 1024, 512}; pg8::StaticOrder S; S.init(TP, 1024, G, bx);
                  EpiBr<false> E{ws}; if (PROBE == 11) { EpiNull EN{(float*)(ws + WS_E)}; pg8::gemm_phase<EpiNull, pg8::StaticOrder, false>(lds, g, S, EN, nullptr); } pg8::gemm_phase<EpiBr<false>, pg8::StaticOrder, false>(lds, g, S, E, nullptr); __syncthreads(); }
                { pg8::Gemm g{(const bf16_t*)(ws + WS_GY), (const bf16_t*)(ws + WS_WGLU + l * SZ_WGLU), TP, 512, 512}; pg8::StaticOrder S; S.init(TP, 512, G, bx);
                  EpiGlu E{ws, a.in[I_BGLU] + (size_t)l * 512}; if (PROBE == 11) { EpiNull EN{(float*)(ws + WS_E)}; pg8::gemm_phase<EpiNull, pg8::StaticOrder, false>(lds, g, S, EN, nullptr); } pg8::gemm_phase<EpiGlu, pg8::StaticOrder, false>(lds, g, S, E, nullptr); __syncthreads(); }
                if (bx >= 128 && bx < 192) {
                    const int dc = 16 * (bx - 128);
                    skinny_unit<false, 8>(lds, (const bf16_t*)(ws + WS_ZB) + (size_t)TP * 512, (const bf16_t*)(ws + WS_WBA + l * SZ_WB), 512, dc, dc, 0, otid(), [=](const f32x4 s0, const f32x4 s1, int row, int c4) {
                        u32x2* p = (u32x2*)((bf16_t*)(ws + WS_SGA) + (size_t)row * 1024 + dc + c4); *p = pack4(unpack4(*p) * s0); });
                } else if (bx >= 192 && bx < 224) {
                    const int dc = 16 * (bx - 192); const float* bias = a.in[I_BGLU] + (size_t)l * 512;
                    skinny_unit<false, 8>(lds, (const bf16_t*)(ws + WS_GY) + (size_t)TP * 512, (const bf16_t*)(ws + WS_WGLU + l * SZ_WGLU), 512, dc, dc, 0, otid(), [=](const f32x4 s0, const f32x4 s1, int row, int c4) {
                        const f32x4 gy = unpack4(*(const u32x2*)((const bf16_t*)(ws + WS_GY) + (size_t)row * 512 + dc + c4)); f32x4 v = s0 + *(const f32x4*)(bias + dc + c4);
                        _Pragma("unroll") for (int j = 0; j < 4; ++j) v[j] = gy[j] * sigm(v[j]);
                        *(u32x2*)((bf16_t*)(ws + WS_YS2) + (size_t)row * 512 + dc + c4) = pack4(v); });
                }
                if (l + 1 < NL && bx >= 128) { __syncthreads(); p0_weights(a, (float*)lds_raw, (l + 1) * P0_PER, (l + 1) * P0_PER + 340, bx - 128, 128); }
            } else if ((PM & 64) && s == 4) {
                pg8::Gemm g{(const bf16_t*)(ws + WS_YS2), (const bf16_t*)(ws + WS_WBB + l * SZ_WB), TP, 1024, 512}; pg8::StaticOrder S; S.init(TP, 1024, G, bx);
                EpiBr<true> E{ws}; if (PROBE == 11) { EpiNull EN{(float*)(ws + WS_E)}; pg8::gemm_phase<EpiNull, pg8::StaticOrder, false>(lds, g, S, EN, nullptr); } pg8::gemm_phase<EpiBr<true>, pg8::StaticOrder, false>(lds, g, S, E, nullptr); __syncthreads();
                {
                    const int dc = 16 * (bx & 63);
                    skinny_unit<false, 2>(lds, (const bf16_t*)(ws + WS_YS2) + (size_t)TP * 512, (const bf16_t*)(ws + WS_WBB + l * SZ_WB), 512, dc, dc, 32 * (bx >> 6), otid(), [=](const f32x4 s0, const f32x4 s1, int row, int c4) {
                        const size_t off = (size_t)row * 1024 + dc + c4; u32x2* p = (u32x2*)((bf16_t*)(ws + WS_SGS) + off); const f32x4 t = unpack4(*(const u32x2*)((const bf16_t*)(ws + WS_SGA) + off));
                        *p = pack4(t + unpack4(*p) * s0); });
                }
            } else if ((PM & 128) && (s == 5 || s == 7)) {
                const bool dn = s == 7;
                pg8::Gemm g{(const bf16_t*)(dn ? ws + WS_FF : ws + WS_SGS), (const bf16_t*)(dn ? ws + WS_WDN + l * SZ_WDN : ws + WS_WOUT + l * SZ_WOUT), TP, 1024, dn ? DFF : 1024}; pg8::StaticOrder S; S.init(TP, 1024, G, bx);
                EpiRes E{a.out, ws, RS + (size_t)(2 * l + (dn ? 2 : 1)) * MP};
                if (PROBE == 5) { EpiProbe<1> EN{ws, (float*)(ws + WS_E)}; pg8::gemm_phase<EpiProbe<1>, pg8::StaticOrder, false>(lds, g, S, EN, nullptr); }
                if (PROBE == 11) { EpiNull EN{(float*)(ws + WS_E)}; pg8::gemm_phase<EpiNull, pg8::StaticOrder, false>(lds, g, S, EN, nullptr); }
                pg8::gemm_phase<EpiRes, pg8::StaticOrder, false>(lds, g, S, E, nullptr); __syncthreads();
                {
                    const int dc = 16 * (bx & 63), Ks = dn ? DFF : 1024; float* rso = RS + (size_t)(2 * l + (dn ? 2 : 1)) * MP; float* X = a.out;
                    skinny_unit<false, 2>(lds, (const bf16_t*)(dn ? ws + WS_FF : ws + WS_SGS) + (size_t)TP * Ks, (const bf16_t*)(dn ? ws + WS_WDN + l * SZ_WDN : ws + WS_WOUT + l * SZ_WOUT), Ks, dc, dc, 32 * (bx >> 6), otid(), [=](const f32x4 s0, const f32x4 s1, int row, int c4) {
                        const size_t off = (size_t)row * 1024 + dc + c4; const f32x4 x = *(const f32x4*)(X + off) + s0; *(f32x4*)(X + off) = x; *(u32x2*)(XB + off) = pack4(x);
                        float ss = (x[0] * x[0] + x[1] * x[1]) + (x[2] * x[2] + x[3] * x[3]); ss += __shfl_xor(ss, 16); ss += __shfl_xor(ss, 32);
                        if (c4 == 0) atomicAdd(rso + row, ss); });
                }
            } else if (PM & 256) {
                pg8::Gemm g{XB, (const bf16_t*)(ws + WS_WGU + l * SZ_WGU), TP, 2 * DFF, 1024}; pg8::StaticOrder S; S.init(TP, 2 * DFF, G, bx);
                EpiGU E{ws, RS + (size_t)(2 * l + 1) * MP, lds + LDS_X};
                if (PROBE == 11) { EpiNull EN{(float*)(ws + WS_E)}; pg8::gemm_phase<EpiNull, pg8::StaticOrder, false>(lds, g, S, EN, nullptr); }
                if (PROBE == 20) { EpiProbe<0> EP{ws, (float*)(ws + WS_E)}; pg8::gemm_phase<EpiProbe<0>, pg8::StaticOrder, false>(lds, g, S, EP, nullptr); }
                if (PROBE == 21) { EpiProbe<1> EP{ws, (float*)(ws + WS_E)}; pg8::gemm_phase<EpiProbe<1>, pg8::StaticOrder, false>(lds, g, S, EP, nullptr); }
                if (PROBE == 22 || PROBE == 24 || PROBE == 26) { pg8::gemm_phase<EpiGU, pg8::StaticOrder, false>(lds, g, S, E, nullptr); __syncthreads(); if (PROBE == 26) __syncthreads(); }
                pg8::gemm_phase<EpiGU, pg8::StaticOrder, false>(lds, g, S, E, nullptr); __syncthreads();
                if (bx >= 80) {
                    const int dc = 16 * (255 - bx), n0 = (dc >> 7) * 256 + (dc & 127); const float* rowss = RS + (size_t)(2 * l + 1) * MP;
                    skinny_unit<true, 8>(lds, XB + (size_t)TP * 1024, (const bf16_t*)(ws + WS_WGU + l * SZ_WGU), 1024, n0, n0 + 128, 0, otid(), [=](const f32x4 s0, const f32x4 s1, int row, int c4) {
                        const float rs = rsqrtf(rowss[row] * (1.0f / 1024.0f) + EPS); const f32x4 g = s0 * rs, up = s1 * rs; f32x4 v;
                        _Pragma("unroll") for (int j = 0; j < 4; ++j) v[j] = g[j] * sigm(g[j]) * up[j];
                        *(u32x2*)((bf16_t*)(ws + WS_FF) + (size_t)row * DFF + dc + c4) = pack4(v); });
                }
                if (l + 1 < NL && bx >= 128) { __syncthreads(); p0_weights(a, (float*)lds_raw, (l + 1) * P0_PER + 340, (l + 2) * P0_PER, bx - 128, 128); }
            }
        }
        }
        if (ph + 1 < a.ph_hi) { xcd_barrier(gbar); if (PROBE == 1) xcd_barrier(gbar); }
        if (ph == a.ph_lo) {
            if (threadIdx.x == 0) { bool ok = true; unsigned* bw = (unsigned*)(a.ws + WS_BAR);
                for (unsigned j = 0; j < 16; ++j) { const unsigned cnt = xb_ld(&bw[XB_XCNT(j)]); ok = ok && (j < 8 ? cnt == 32u : cnt == 0u); }
                bst[4] = ok ? (bst[2] * 8u + bst[3]) : (unsigned)blockIdx.x; }
            __syncthreads();
        }
    }
}

extern "C" void kernel_launch(void* const* d_in, const int* in_sizes, int n_in, void* d_out, int out_size, void* d_ws, size_t ws_size, hipStream_t stream) {
    static int grid = 0;
    if (grid == 0) {
        if (n_in != 25 || (size_t)out_size != O_END || ws_size < WS_TOTAL) { fprintf(stderr, "kernel_launch: unexpected shapes: n_in %d out %d ws %zu (need %zu)\n", n_in, out_size, ws_size, (size_t)WS_TOTAL); grid = -1; return; }
        int dev = 0, cus = 0, per_cu = 0;
        hipGetDevice(&dev); hipDeviceGetAttribute(&cus, hipDeviceAttributeMultiprocessorCount, dev);
        if (hipFuncSetAttribute((const void*)mk_fwd, hipFuncAttributeMaxDynamicSharedMemorySize, LDS_BYTES) != hipSuccess) { fprintf(stderr, "kernel_launch: hipFuncSetAttribute failed\n"); grid = -1; return; }
        if (hipOccupancyMaxActiveBlocksPerMultiprocessor(&per_cu, (const void*)mk_fwd, 512, LDS_BYTES) != hipSuccess || per_cu < 1) { fprintf(stderr, "kernel_launch: occupancy query says %d\n", per_cu); per_cu = 1; }
        (void)hipGetLastError();
        grid = 256;
        if (cus < 256) fprintf(stderr, "kernel_launch: %d CUs, need 256\n", cus);
    }
    if (grid < 0) return;
    if (hipMemsetAsync((char*)d_ws + WS_BAR, 0, (size_t)XCD_BAR_WORDS * 4, stream) != hipSuccess) { fprintf(stderr, "kernel_launch: memset of the barrier words failed\n"); return; }
    Args a{};
    for (int i = 0; i < 25; ++i) a.in[i] = (const float*)d_in[i];
    a.out = (float*)d_out; a.ws = (unsigned char*)d_ws;
#if ONE_LAUNCH
    a.ph_lo = 0; a.ph_hi = N_PHASES;
    void* args[] = {&a};
    hipError_t e = hipLaunchCooperativeKernel((const void*)mk_fwd, dim3(grid), dim3(512), args, LDS_BYTES, stream);
    if (e != hipSuccess) fprintf(stderr, "cooperative launch failed: %s (grid %d)\n", hipGetErrorString(e), grid);
#else
    for (int ph = 0; ph < N_PHASES; ++ph) { a.ph_lo = ph; a.ph_hi = ph + 1; hipLaunchKernelGGL(mk_fwd, dim3(grid), dim3(512), LDS_BYTES, stream, a); }
#endif
}
```

```cpp
#include <hip/hip_runtime.h>
#include <hip/hip_cooperative_groups.h>
#include <cstdio>
namespace cg = cooperative_groups;
namespace pg8 {
#define PG8_LAS __attribute__((address_space(3)))
typedef unsigned short bf16_t;
typedef short bf16x8 __attribute__((ext_vector_type(8)));
typedef float f32x4 __attribute__((ext_vector_type(4)));
typedef unsigned u32x4 __attribute__((ext_vector_type(4)));
constexpr int BM = 256, BK = 64, HALF = 128, HTB = HALF * BK * 2  , STAGE_BYTES = 8 * HTB, NXCD = 8, WGM = 8;

__host__ __device__ __forceinline__ int lds_byte(int r, int c) { const int st = (r >> 4) * 2 + (c >> 5), rr = r & 15, cc = c & 31, ob = rr * 64 + cc * 2; return st * 1024 + (ob ^ (((ob >> 9) & 1) << 5)); }
__host__ __device__ __forceinline__ void stage_rc(int b, int& R, int& C) { const int st = b / 1024, sb = b % 1024, swz = sb ^ (((sb >> 9) & 1) << 5); R = (st >> 1) * 16 + swz / 64; C = (st & 1) * 32 + (swz % 64) / 2; }
__host__ __device__ __forceinline__ int perm32(int rho) { const int n = rho >> 4, i = rho & 15; return 8 * (i >> 2) + 4 * n + (i & 3); }

struct Unit { int pm, pn; };
struct Gemm { const bf16_t* A; const bf16_t* Bt; int M, N, K; };

struct StaticOrder {
    int nM, nN, nwg, G, c;
    __host__ __device__ void init(int M, int N, int G_, int c_) { nM = M / BM; nN = N / BM; nwg = nM * nN; G = G_; c = c_; }
    __host__ __device__ bool next(int i, Unit& u) const {
        const long L = (long)i * G + c; if (L >= nwg) return false;
        int wgid = (int)L; { const int q = nwg / NXCD, r = nwg % NXCD, xcd = wgid % NXCD, off = wgid / NXCD; wgid = (xcd < r ? xcd * (q + 1) : r * (q + 1) + (xcd - r) * q) + off; }
        const int nig = WGM * nN, gid = wgid / nig, fm = gid * WGM, gsz = (nM - fm) < WGM ? (nM - fm) : WGM;
        u.pm = fm + ((wgid % nig) % gsz); u.pn = (wgid % nig) / gsz; return true;
    }
    __device__ __forceinline__ void a_ready(const Unit&) const {}
    __device__ __forceinline__ void done(const Unit&) const {}
};
__device__ __forceinline__ unsigned cvt_pk_bf16(float lo, float hi) { unsigned r; asm volatile("v_cvt_pk_bf16_f32 %0, %1, %2" : "=v"(r) : "v"(lo), "v"(hi)); return r; }
typedef float f32x2 __attribute__((ext_vector_type(2)));
__device__ __forceinline__ f32x2 gelu_pk(f32x2 v) {
    const f32x2 av = __builtin_elementwise_abs(v), d = av * 0.2316418882f + 1.0f;
    f32x2 t; t.x = __builtin_amdgcn_rcpf(d.x); t.y = __builtin_amdgcn_rcpf(d.y);
    f32x2 q = t * 0.5307027145f + (-0.7265760135f); q = q * t + 0.7107068705f; q = q * t + (-0.142248368f); q = q * t + 0.127414796f; q = q * t;
    const f32x2 s = (v * v) * (-0.72134752044f);
    f32x2 e; e.x = __builtin_amdgcn_exp2f(s.x); e.y = __builtin_amdgcn_exp2f(s.y);
    const f32x2 m = v * (q * e), r = v - m;
    f32x2 o; o.x = v.x < 0.f ? m.x : r.x; o.y = v.y < 0.f ? m.y : r.y; return o;
}

template <class Epi, class Sched, bool STAMP = false>
__device__ __forceinline__ void gemm_phase(PG8_LAS unsigned char* lds, const Gemm g, const Sched& S, const Epi& E, unsigned long long* stamps) {
    int tid_ = threadIdx.x; asm volatile("" : "+v"(tid_));
    const int tid = tid_, wid = __builtin_amdgcn_readfirstlane(tid >> 6), lane = tid & 63, wr = wid >> 2, wc = wid & 3, fr = lane & 15, fq = lane >> 4;
    const int K = g.K, nt = K / BK;
    int ts_lo = 0, ts_hi = 0, nts = 0; const unsigned long long rt_entry = STAMP ? (unsigned long long)wall_clock64() : 0ull;
#define PG8_STAMP() do { if (STAMP && wid == 0 && nts < 64) { const unsigned long long _c = (unsigned long long)clock64(); \
        ts_lo = (lane == nts) ? (int)(unsigned)_c : ts_lo; ts_hi = (lane == nts) ? (int)(unsigned)(_c >> 32) : ts_hi; ++nts; } } while (0)
    PG8_STAMP();
    unsigned voffA[2], voffB[2];
#pragma unroll
    for (int i = 0; i < 2; ++i) { int R, C; stage_rc(tid * 16 + i * 8192, R, C); const int Rb = Epi::PERM ? ((R & ~31) + perm32(R & 31)) : R;
        voffA[i] = (unsigned)(R * K + C) * 2u; voffB[i] = (unsigned)(Rb * K + C) * 2u; }
    const size_t kstep = (size_t)(BK * 2);
    const size_t hstep = (size_t)HALF * K * 2;
    const size_t tstep = 2 * hstep;
    const unsigned ldsw = (unsigned)wid * 1024u;
    const int aoff = lds_byte(wr * 64 + fr, fq * 8), boff = lds_byte(wc * 32 + fr, fq * 8);
#define PG8_SA(b, h) (((b) * 2 + (h)) * HTB)
#define PG8_SB(b, h) ((4 + (b) * 2 + (h)) * HTB)
#define PG8_STAGE(bufoff, gbase, voff) do { _Pragma("unroll") for (int _i = 0; _i < 2; ++_i) \
        __builtin_amdgcn_global_load_lds((const unsigned*)((const char*)(gbase) + (voff)[_i]), (PG8_LAS unsigned*)(lds + (bufoff) + ldsw + _i * 8192), 16, 0, 0); } while (0)
#define PG8_LDA(dst, b, h) do { _Pragma("unroll") for (int m = 0; m < 4; ++m) _Pragma("unroll") for (int k = 0; k < 2; ++k) dst[m][k] = *(const PG8_LAS bf16x8*)(lds + PG8_SA(b, h) + aoff + m * 2048 + k * 1024); } while (0)
#define PG8_LDB(dst, b, h) do { _Pragma("unroll") for (int n = 0; n < 2; ++n) _Pragma("unroll") for (int k = 0; k < 2; ++k) dst[n][k] = *(const PG8_LAS bf16x8*)(lds + PG8_SB(b, h) + boff + n * 2048 + k * 1024); } while (0)
#define PG8_MMA(ai, bj, At, Bt) do { __builtin_amdgcn_s_setprio(1); _Pragma("unroll") for (int m = 0; m < 4; ++m) _Pragma("unroll") for (int n = 0; n < 2; ++n) _Pragma("unroll") for (int k = 0; k < 2; ++k) \
        acc[ai][bj][m][n] = __builtin_amdgcn_mfma_f32_16x16x32_bf16(Bt[n][k], At[m][k], acc[ai][bj][m][n], 0, 0, 0); __builtin_amdgcn_s_setprio(0); } while (0)
#define PG8_WAIT_V(n) asm volatile("s_waitcnt vmcnt(" #n ")" ::: "memory")
#define PG8_WAIT_L(n) asm volatile("s_waitcnt lgkmcnt(" #n ")" ::: "memory")
#define PG8_BAR __builtin_amdgcn_s_barrier()
#define PG8_SCHED __builtin_amdgcn_sched_barrier(0)
    Unit cur, nxt; int ui = 0;
    if (!S.next(0, cur)) return;
    f32x4 acc[2][2][4][2];
#pragma unroll
    for (int a = 0; a < 2; ++a)
#pragma unroll
        for (int b = 0; b < 2; ++b)
#pragma unroll
            for (int m = 0; m < 4; ++m)
#pragma unroll
                for (int n = 0; n < 2; ++n) acc[a][b][m][n] = (f32x4){0.f, 0.f, 0.f, 0.f};
    bf16x8 At[4][2], B0[2][2], B1[2][2];
    const char* cA = (const char*)g.A + (size_t)cur.pm * tstep; const char* cB = (const char*)g.Bt + (size_t)cur.pn * tstep;
    S.a_ready(cur);
    PG8_STAGE(PG8_SB(0, 0), cB, voffB); PG8_STAGE(PG8_SA(0, 0), cA, voffA); PG8_STAGE(PG8_SB(0, 1), cB + hstep, voffB); PG8_STAGE(PG8_SA(0, 1), cA + hstep, voffA);
    if (wr == 1) PG8_BAR;
    PG8_WAIT_V(4); PG8_BAR;
    PG8_STAGE(PG8_SB(1, 0), cB + kstep, voffB); PG8_STAGE(PG8_SA(1, 0), cA + kstep, voffA); PG8_STAGE(PG8_SB(1, 1), cB + hstep + kstep, voffB);
    PG8_WAIT_V(6); PG8_BAR;
    PG8_STAMP();
    for (;;) {
        const bool has_next = S.next(ui + 1, nxt);
        const char* nA = has_next ? (const char*)g.A + (size_t)nxt.pm * tstep : cA; const char* nB = has_next ? (const char*)g.Bt + (size_t)nxt.pn * tstep : cB;
        for (int t = 0; t < nt; t += 2) {
            const bool last = (t == nt - 2);
            const char* a1 = cA + (size_t)(t + 1) * kstep;
            const char* a2 = last ? nA : cA + (size_t)(t + 2) * kstep; const char* b2 = last ? nB : cB + (size_t)(t + 2) * kstep;
            const char* a3 = a2 + kstep; const char* b3 = b2 + kstep;
            if (last && has_next) S.a_ready(nxt);
            if constexpr (Epi::PREFETCH) { if (last) E.prefetch(cur, wid, lane); }
            PG8_LDB(B0, 0, 0); PG8_SCHED; PG8_LDA(At, 0, 0); PG8_STAGE(PG8_SA(1, 1), a1 + hstep, voffA);
            PG8_WAIT_L(8); PG8_BAR; PG8_WAIT_L(0); PG8_MMA(0, 0, At, B0); PG8_BAR; PG8_SCHED;
            PG8_LDB(B1, 0, 1); PG8_STAGE(PG8_SB(0, 0), b2, voffB);
            PG8_BAR; PG8_WAIT_L(0); PG8_MMA(0, 1, At, B1); PG8_BAR;
            PG8_LDA(At, 0, 1); PG8_STAGE(PG8_SA(0, 0), a2, voffA);
            PG8_BAR; PG8_WAIT_L(0); PG8_MMA(1, 0, At, B0); PG8_BAR; PG8_SCHED;
            PG8_STAGE(PG8_SB(0, 1), b2 + hstep, voffB);
            PG8_WAIT_V(6); PG8_BAR; PG8_MMA(1, 1, At, B1); PG8_BAR;
            PG8_LDB(B0, 1, 0); PG8_SCHED; PG8_LDA(At, 1, 0); PG8_STAGE(PG8_SA(0, 1), a2 + hstep, voffA);
            PG8_WAIT_L(8); PG8_BAR; PG8_WAIT_L(0); PG8_MMA(0, 0, At, B0); PG8_BAR; PG8_SCHED;
            PG8_LDB(B1, 1, 1); PG8_STAGE(PG8_SB(1, 0), b3, voffB);
            PG8_BAR; PG8_WAIT_L(0); PG8_MMA(0, 1, At, B1); PG8_BAR;
            PG8_LDA(At, 1, 1); PG8_STAGE(PG8_SA(1, 0), a3, voffA);
            PG8_BAR; PG8_WAIT_L(0); PG8_MMA(1, 0, At, B0); PG8_BAR; PG8_SCHED;
            PG8_STAGE(PG8_SB(1, 1), b3 + hstep, voffB);
            PG8_WAIT_V(6); PG8_BAR; PG8_MMA(1, 1, At, B1); PG8_BAR;
        }
        PG8_STAMP();
        if (wr == 0) PG8_BAR;
        if constexpr (!Epi::AFTER_DRAIN) { E(acc, cur, wr, wc, fr, fq); S.done(cur); }
        PG8_STAMP();
        if (!has_next) break;
#pragma unroll
        for (int a = 0; a < 2; ++a)
#pragma unroll
            for (int b = 0; b < 2; ++b)
#pragma unroll
                for (int m = 0; m < 4; ++m)
#pragma unroll
                    for (int n = 0; n < 2; ++n) acc[a][b][m][n] = (f32x4){0.f, 0.f, 0.f, 0.f};
        cur = nxt; cA = nA; cB = nB; ++ui;
        if (wr == 1) PG8_BAR;
    }
    PG8_WAIT_V(0);
    PG8_BAR;
    if constexpr (Epi::AFTER_DRAIN) { E.fused(acc, cur, wr, wc, fr, fq, lds, wid, lane); S.done(cur); }
    PG8_STAMP();
    if (STAMP && wid == 0) { stamps[lane] = lane < nts ? (((unsigned long long)(unsigned)ts_hi << 32) | (unsigned)ts_lo) : 0ull;
        if (lane == 62) stamps[62] = rt_entry; if (lane == 63) stamps[63] = (unsigned long long)wall_clock64(); }
#undef PG8_STAMP
#undef PG8_SA
#undef PG8_SB
#undef PG8_STAGE
#undef PG8_LDA
#undef PG8_LDB
#undef PG8_MMA
#undef PG8_WAIT_V
#undef PG8_WAIT_L
#undef PG8_BAR
#undef PG8_SCHED
}
}
using pg8::bf16_t; using pg8::f32x4; using pg8::u32x4; using pg8::Unit; using pg8::cvt_pk_bf16;
typedef unsigned u32x2 __attribute__((ext_vector_type(2)));
constexpr int D = 1024, TP = 16384, TS = 128, T = TP + TS, MP = 16640, NL = 4, CW = 512, NG = 32, NP = 64, DFF = 2816, SEQ = 2048, NB = 8, LC = 64, NCH = SEQ / LC;
constexpr float EPS = 1e-6f;
constexpr size_t O_YP = 0, O_YS = (size_t)TP * D, O_PC = O_YS + (size_t)TS * D, O_PRE = O_PC + (size_t)NL * NB * 2 * CW, O_PIM = O_PRE + (size_t)NL * NB * NG * NP,
                 O_SC = O_PIM + (size_t)NL * NB * NG * NP, O_SRE = O_SC + (size_t)NL * TS * 2 * CW, O_SIM = O_SRE + (size_t)NL * TS * NG * NP, O_END = O_SIM + (size_t)NL * TS * NG * NP;
constexpr size_t SZ_WIN = (size_t)4096 * 1024 * 2, SZ_WGLU = (size_t)512 * 512 * 2, SZ_WB = (size_t)1024 * 512 * 2, SZ_WOUT = (size_t)1024 * 1024 * 2, SZ_WGU = (size_t)5632 * 1024 * 2, SZ_WDN = (size_t)1024 * 2816 * 2;
constexpr size_t WS_WIN = 0, WS_WGLU = WS_WIN + NL * SZ_WIN, WS_WBA = WS_WGLU + NL * SZ_WGLU, WS_WBB = WS_WBA + NL * SZ_WB, WS_WOUT = WS_WBB + NL * SZ_WB, WS_WGU = WS_WOUT + NL * SZ_WOUT,
                 WS_WDN = WS_WGU + NL * SZ_WGU, WS_XB = WS_WDN + NL * SZ_WDN;
constexpr size_t SZ_H = (size_t)MP * 512 * 2, SZ_F = (size_t)MP * 1024 * 2;
constexpr size_t WS_ZB = WS_XB + SZ_F, WS_CV = WS_ZB + SZ_H, WS_U = WS_CV + SZ_H, WS_SGA = WS_U + SZ_H, WS_SGS = WS_SGA + SZ_F, WS_GY = WS_SGS + SZ_F, WS_YS2 = WS_GY + SZ_H, WS_ZEND = WS_YS2 + SZ_H;
constexpr size_t WS_FF = WS_ZB;
static_assert((size_t)MP * DFF * 2 <= WS_ZEND - WS_ZB, "F alias");
constexpr size_t WS_ROWSS = WS_ZEND, SZ_ROWSS = (size_t)MP * 8, WS_ABAR = WS_ROWSS + 9 * SZ_ROWSS, WS_APOW = WS_ABAR + (size_t)NL * NG * NP * 8, WS_BBAR = WS_APOW + (size_t)NL * NG * NP * 8,
                 WS_E = WS_BBAR + (size_t)NL * NG * NP * 32 * 4, WS_BBF = WS_E + (size_t)NB * NG * NCH * NP * 8, WS_CMF = WS_BBF + (size_t)NL * NG * 4 * 64 * 16, WS_END = WS_CMF + (size_t)NL * NG * 5 * 64 * 16;

typedef unsigned long long rsum_t;
__device__ __forceinline__ rsum_t rs_enc(float ss) { return (rsum_t)(ss * 16777216.0f); }
__device__ __forceinline__ float rs_ms(rsum_t v) { return (float)v * (1.0f / (16777216.0f * 1024.0f)) + EPS; }
__device__ __forceinline__ float bf_lo(unsigned w) { return __uint_as_float(w << 16); }
__device__ __forceinline__ float bf_hi(unsigned w) { return __uint_as_float(w & 0xffff0000u); }
__device__ __forceinline__ float sigm(float x) { return __builtin_amdgcn_rcpf(1.0f + __expf(-x)); }
__device__ __forceinline__ u32x4 pack8(const f32x4 a, const f32x4 b) { u32x4 w; w.x = cvt_pk_bf16(a[0], a[1]); w.y = cvt_pk_bf16(a[2], a[3]); w.z = cvt_pk_bf16(b[0], b[1]); w.w = cvt_pk_bf16(b[2], b[3]); return w; }
__device__ __forceinline__ void unpack8(const u32x4 w, f32x4& a, f32x4& b) { a = (f32x4){bf_lo(w.x), bf_hi(w.x), bf_lo(w.y), bf_hi(w.y)}; b = (f32x4){bf_lo(w.z), bf_hi(w.z), bf_lo(w.w), bf_hi(w.w)}; }

__device__ __forceinline__ float nr_rcp(float d) { float r = __uint_as_float(0x7EF311C7u - __float_as_uint(d)); r = r * fmaf(-d, r, 2.0f); r = r * fmaf(-d, r, 2.0f); return r; }
#define WT_FLAGS 0x00020000
__device__ __forceinline__ void wt16s(const __amdgpu_buffer_rsrc_t r, const void* base, const void* p, const u32x4 v) { __builtin_amdgcn_raw_buffer_store_b128(v, r, (unsigned)((const char*)p - (const char*)base), 0, 16); }
__device__ __forceinline__ void wt16(const __amdgpu_buffer_rsrc_t r, const void* base, const void* p, const u32x4 v) { (void)r; (void)base; *(u32x4*)p = v; }
#define EPI_FENCE asm volatile("" ::: "memory")
#define EPI_G(g) const int ai = (g) >> 2, m = (g) & 3, row = row0 + ai * 128 + m * 16
struct EpiIn {
    static constexpr bool PERM = true, AFTER_DRAIN = false, PREFETCH = true;
    unsigned char* ws; const rsum_t* rowss; PG8_LAS unsigned char* ldsx;
    __device__ __forceinline__ void prefetch(const Unit& u, int wid, int lane) const { const unsigned* src = (const unsigned*)(rowss + u.pm * 256 + (wid >> 2) * 64 + lane);
        __builtin_amdgcn_global_load_lds(src, (PG8_LAS unsigned*)(ldsx + wid * 1024), 4, 0, 0); __builtin_amdgcn_global_load_lds(src + 1, (PG8_LAS unsigned*)(ldsx + wid * 1024 + 256), 4, 0, 0);
        __builtin_amdgcn_global_load_lds(src + 256, (PG8_LAS unsigned*)(ldsx + wid * 1024 + 512), 4, 0, 0); __builtin_amdgcn_global_load_lds(src + 257, (PG8_LAS unsigned*)(ldsx + wid * 1024 + 768), 4, 0, 0); }
    __device__ __forceinline__ float ms_lds(int wid, int ai, int idx) const { const PG8_LAS unsigned* p = (const PG8_LAS unsigned*)(ldsx + wid * 1024 + ai * 512 + idx * 4); return rs_ms(((rsum_t)p[64] << 32) | (rsum_t)p[0]); }
    __device__ __forceinline__ void operator()(const f32x4 (&acc)[2][2][4][2], const Unit& u, int wr, int wc, int fr, int fq) const {
        bf16_t* const ZB = (bf16_t*)(ws + WS_ZB); bf16_t* const CV = (bf16_t*)(ws + WS_CV); bf16_t* const U = (bf16_t*)(ws + WS_U); bf16_t* const SGA = (bf16_t*)(ws + WS_SGA); bf16_t* const SGS = (bf16_t*)(ws + WS_SGS);
        const int row0 = u.pm * 256 + wr * 64 + fr, pn = u.pn, cw = wc * 32 + 8 * fq;
        const __amdgpu_buffer_rsrc_t rw = __builtin_amdgcn_make_buffer_rsrc(ws, 0, (int)WS_ZEND, WT_FLAGS);
        float rs[8];
#pragma unroll
        for (int g = 0; g < 8; ++g) { EPI_G(g); (void)row; rs[g] = ms_lds(wr * 4 + wc, ai, 16 * m + fr); }
#pragma unroll
        for (int g = 0; g < 8; ++g) rs[g] = rsqrtf(rs[g]);
        if (pn >= 2 && pn < 6) {
            bf16_t* base = CV + (pn - 2) * 128 + cw;
#pragma unroll
            for (int g = 0; g < 8; ++g) { EPI_G(g); const float rs2 = rs[g] * rs[g];
                wt16(rw, ws, base + (size_t)row * 512, pack8(acc[ai][0][m][0] * acc[ai][1][m][0] * rs2, acc[ai][0][m][1] * acc[ai][1][m][1] * rs2)); }
        } else {
            bf16_t* base; int ldc; const bool sg = pn >= 8;
            if (pn < 2) { base = ZB + pn * 256; ldc = 512; } else if (pn < 8) { base = U + (pn - 6) * 256; ldc = 512; } else if (pn < 12) { base = SGA + (pn - 8) * 256; ldc = 1024; } else { base = SGS + (pn - 12) * 256; ldc = 1024; }
            base += cw;
#pragma unroll
            for (int g = 0; g < 8; ++g) { EPI_G(g);
#pragma unroll
                for (int bj = 0; bj < 2; ++bj) { f32x4 v0, v1;
                    if (sg) { const float rl = rs[g] * -1.4426950408889634f; const f32x4 x0 = acc[ai][bj][m][0] * rl, x1 = acc[ai][bj][m][1] * rl;
                        f32x4 e0, e1;
#pragma unroll
                        for (int j = 0; j < 4; ++j) { e0[j] = __builtin_amdgcn_exp2f(x0[j]); e1[j] = __builtin_amdgcn_exp2f(x1[j]); }
                        const f32x4 d0 = e0 + 1.0f, d1 = e1 + 1.0f;
#pragma unroll
                        for (int j = 0; j < 4; ++j) { v0[j] = __builtin_amdgcn_rcpf(d0[j]); v1[j] = __builtin_amdgcn_rcpf(d1[j]); } }
                    else { v0 = acc[ai][bj][m][0] * rs[g]; v1 = acc[ai][bj][m][1] * rs[g]; }
                    wt16(rw, ws, base + (size_t)row * ldc + bj * 128, pack8(v0, v1)); } }
        }
    }
};
#ifndef PROBE
#define PROBE 0
#endif
struct EpiGU {
    static constexpr bool PERM = true, AFTER_DRAIN = false, PREFETCH = (PROBE != 24);
    unsigned char* ws; const rsum_t* rowss; PG8_LAS unsigned char* ldsx;
    __device__ __forceinline__ void prefetch(const Unit& u, int wid, int lane) const { const unsigned* src = (const unsigned*)(rowss + u.pm * 256 + (wid >> 2) * 64 + lane);
        __builtin_amdgcn_global_load_lds(src, (PG8_LAS unsigned*)(ldsx + wid * 1024), 4, 0, 0); __builtin_amdgcn_global_load_lds(src + 1, (PG8_LAS unsigned*)(ldsx + wid * 1024 + 256), 4, 0, 0);
        __builtin_amdgcn_global_load_lds(src + 256, (PG8_LAS unsigned*)(ldsx + wid * 1024 + 512), 4, 0, 0); __builtin_amdgcn_global_load_lds(src + 257, (PG8_LAS unsigned*)(ldsx + wid * 1024 + 768), 4, 0, 0); }
    __device__ __forceinline__ float ms_lds(int wid, int ai, int idx) const { const PG8_LAS unsigned* p = (const PG8_LAS unsigned*)(ldsx + wid * 1024 + ai * 512 + idx * 4); return rs_ms(((rsum_t)p[64] << 32) | (rsum_t)p[0]); }
    __device__ __forceinline__ void operator()(const f32x4 (&acc)[2][2][4][2], const Unit& u, int wr, int wc, int fr, int fq) const {
        const int row0 = u.pm * 256 + wr * 64 + fr; bf16_t* base = (bf16_t*)(ws + WS_FF) + u.pn * 128 + wc * 32 + 8 * fq;
        const __amdgpu_buffer_rsrc_t rw = __builtin_amdgcn_make_buffer_rsrc(ws, 0, (int)WS_ZEND, WT_FLAGS);
        float rs[8];
#pragma unroll
        for (int g = 0; g < 8; ++g) { EPI_G(g); rs[g] = PREFETCH ? ms_lds(wr * 4 + wc, ai, 16 * m + fr) : rs_ms(rowss[row]); }
        EPI_FENCE;
#pragma unroll
        for (int g = 0; g < 8; ++g) { EPI_G(g); const float r = rsqrtf(rs[g]), r2 = r * r, rl = r * -1.4426950408889634f; f32x4 o[2];
#pragma unroll
            for (int n = 0; n < 2; ++n) { const f32x4 t = acc[ai][0][m][n] * acc[ai][1][m][n] * r2, xe = acc[ai][0][m][n] * rl;
                f32x4 e, q;
#pragma unroll
                for (int j = 0; j < 4; ++j) e[j] = __builtin_amdgcn_exp2f(xe[j]);
                const f32x4 d = e + 1.0f;
#pragma unroll
                for (int j = 0; j < 4; ++j) q[j] = __builtin_amdgcn_rcpf(d[j]);
                o[n] = t * q; }
            wt16(rw, ws, base + (size_t)row * DFF, pack8(o[0], o[1])); }
    }
};
struct EpiGlu {
    static constexpr bool PERM = true, AFTER_DRAIN = false, PREFETCH = false;
    unsigned char* ws; const float* bias;
    __device__ __forceinline__ void operator()(const f32x4 (&acc)[2][2][4][2], const Unit& u, int wr, int wc, int fr, int fq) const {
        const bf16_t* const GY = (const bf16_t*)(ws + WS_GY); bf16_t* const YS2 = (bf16_t*)(ws + WS_YS2);
        const int row0 = u.pm * 256 + wr * 64 + fr, col0 = u.pn * 256 + wc * 32 + 8 * fq;
        const __amdgpu_buffer_rsrc_t rw = __builtin_amdgcn_make_buffer_rsrc(ws, 0, (int)WS_ZEND, WT_FLAGS);
        f32x4 bv[2][2];
#pragma unroll
        for (int bj = 0; bj < 2; ++bj) { bv[bj][0] = *(const f32x4*)(bias + col0 + bj * 128); bv[bj][1] = *(const f32x4*)(bias + col0 + bj * 128 + 4); }
        u32x4 buf[4][2];
#define GLU_LOAD(g) { EPI_G(g); (void)ai; (void)m; buf[(g) & 3][0] = *(const u32x4*)(GY + (size_t)row * 512 + col0); buf[(g) & 3][1] = *(const u32x4*)(GY + (size_t)row * 512 + col0 + 128); }
        GLU_LOAD(0) GLU_LOAD(1) GLU_LOAD(2)
#pragma unroll
        for (int g = 0; g < 8; ++g) { if (g + 3 < 8) GLU_LOAD(g + 3)
            EPI_FENCE; EPI_G(g);
#pragma unroll
            for (int bj = 0; bj < 2; ++bj) { f32x4 g0, g1; unpack8(buf[g & 3][bj], g0, g1); f32x4 v0 = acc[ai][bj][m][0] + bv[bj][0], v1 = acc[ai][bj][m][1] + bv[bj][1];
#pragma unroll
                for (int j = 0; j < 4; ++j) { v0[j] = g0[j] * sigm(v0[j]); v1[j] = g1[j] * sigm(v1[j]); }
                wt16(rw, ws, YS2 + (size_t)row * 512 + col0 + bj * 128, pack8(v0, v1)); } }
#undef GLU_LOAD
    }
};
template <bool SECOND> struct EpiBr {
    static constexpr bool PERM = true, AFTER_DRAIN = false, PREFETCH = false;
    unsigned char* ws;
    __device__ __forceinline__ void operator()(const f32x4 (&acc)[2][2][4][2], const Unit& u, int wr, int wc, int fr, int fq) const {
        bf16_t* const SGA = (bf16_t*)(ws + WS_SGA); bf16_t* const SGS = (bf16_t*)(ws + WS_SGS);
        const int row0 = u.pm * 256 + wr * 64 + fr, col0 = u.pn * 256 + wc * 32 + 8 * fq;
        const __amdgpu_buffer_rsrc_t rw = __builtin_amdgcn_make_buffer_rsrc(ws, 0, (int)WS_ZEND, WT_FLAGS);
        constexpr int DP = SECOND ? 3 : 4;
        u32x4 sb[DP][2], tb[SECOND ? DP : 1][2];
#define BR_LOAD(g) { EPI_G(g); (void)ai; (void)m; const size_t off = (size_t)row * 1024 + col0; sb[(g) % DP][0] = *(const u32x4*)((SECOND ? SGS : SGA) + off); sb[(g) % DP][1] = *(const u32x4*)((SECOND ? SGS : SGA) + off + 128); \
            if (SECOND) { tb[(g) % DP][0] = *(const u32x4*)(SGA + off); tb[(g) % DP][1] = *(const u32x4*)(SGA + off + 128); } }
        BR_LOAD(0) BR_LOAD(1) if (DP > 3) BR_LOAD(2)
#pragma unroll
        for (int g = 0; g < 8; ++g) { if (g + DP - 1 < 8) BR_LOAD(g + DP - 1)
            EPI_FENCE; EPI_G(g);
#pragma unroll
            for (int bj = 0; bj < 2; ++bj) { const size_t off = (size_t)row * 1024 + col0 + bj * 128; f32x4 s0, s1; unpack8(sb[g % DP][bj], s0, s1);
                if (!SECOND) wt16(rw, ws, SGA + off, pack8(s0 * acc[ai][bj][m][0], s1 * acc[ai][bj][m][1]));
                else { f32x4 t0, t1; unpack8(tb[g % DP][bj], t0, t1); wt16(rw, ws, SGS + off, pack8(t0 + s0 * acc[ai][bj][m][0], t1 + s1 * acc[ai][bj][m][1])); } } }
#undef BR_LOAD
    }
};
struct EpiRes {
    static constexpr bool PERM = true, AFTER_DRAIN = false, PREFETCH = false;
    float* X; unsigned char* ws; rsum_t* rowss_out;
    __device__ __forceinline__ void operator()(const f32x4 (&acc)[2][2][4][2], const Unit& u, int wr, int wc, int fr, int fq) const {
        const int row0 = u.pm * 256 + wr * 64 + fr, col0 = u.pn * 256 + wc * 32 + 8 * fq; bf16_t* const XB = (bf16_t*)(ws + WS_XB);
        const __amdgpu_buffer_rsrc_t rw = __builtin_amdgcn_make_buffer_rsrc(ws, 0, (int)WS_ZEND, WT_FLAGS), ro = __builtin_amdgcn_make_buffer_rsrc(X, 0, (int)((size_t)T * D * 4), WT_FLAGS);
        f32x4 xb[3][2][2];
#define RES_LOAD(g) { EPI_G(g); (void)ai; (void)m; const size_t off = (size_t)row * 1024 + col0; xb[(g) % 3][0][0] = *(const f32x4*)(X + off); xb[(g) % 3][0][1] = *(const f32x4*)(X + off + 4); \
            xb[(g) % 3][1][0] = *(const f32x4*)(X + off + 128); xb[(g) % 3][1][1] = *(const f32x4*)(X + off + 132); }
        RES_LOAD(0) RES_LOAD(1)
#pragma unroll
        for (int g = 0; g < 8; ++g) { if (g + 2 < 8) RES_LOAD(g + 2)
            EPI_FENCE; EPI_G(g); float ss = 0.f;
#pragma unroll
            for (int bj = 0; bj < 2; ++bj) { const size_t off = (size_t)row * 1024 + col0 + bj * 128;
                const f32x4 x0 = xb[g % 3][bj][0] + acc[ai][bj][m][0], x1 = xb[g % 3][bj][1] + acc[ai][bj][m][1];
                wt16(ro, X, X + off, __builtin_bit_cast(u32x4, x0)); wt16(ro, X, X + off + 4, __builtin_bit_cast(u32x4, x1)); wt16(rw, ws, XB + off, pack8(x0, x1));
                ss += (x0[0] * x0[0] + x0[1] * x0[1]) + (x0[2] * x0[2] + x0[3] * x0[3]) + (x1[0] * x1[0] + x1[1] * x1[1]) + (x1[2] * x1[2] + x1[3] * x1[3]); }
            ss += __shfl_xor(ss, 16); ss += __shfl_xor(ss, 32);
            if (fq == 0) atomicAdd(rowss_out + row, rs_enc(ss)); }
#undef RES_LOAD
    }
};
template <bool PAIRED, int NTB, class F> __device__ __forceinline__ void skinny_unit(PG8_LAS unsigned char* lds, const bf16_t* Act, const bf16_t* Bt, int K, int n0, int n1, int tok0, int tid, const F& epi) {
    const int lane = tid & 63, w = __builtin_amdgcn_readfirstlane(tid >> 6), r16 = lane & 15, q = lane >> 4, ks = K >> 3;
    const bf16_t* wp0 = Bt + (size_t)(n0 + r16) * K + w * ks + 8 * q;
    const bf16_t* wp1 = Bt + (size_t)(n1 + r16) * K + w * ks + 8 * q;
    const bf16_t* ap = Act + (size_t)(tok0 + r16) * K + w * ks + 8 * q;
    f32x4 acc0[NTB], acc1[NTB];
#pragma unroll
    for (int tb = 0; tb < NTB; ++tb) { acc0[tb] = (f32x4){0.f, 0.f, 0.f, 0.f}; acc1[tb] = acc0[tb]; }
#pragma unroll (NTB > 4 ? 2 : 6)
    for (int k0 = 0; k0 < ks; k0 += 32) {
        const pg8::bf16x8 wf0 = __builtin_bit_cast(pg8::bf16x8, *(const u32x4*)(wp0 + k0));
        pg8::bf16x8 wf1 = wf0; if (PAIRED) wf1 = __builtin_bit_cast(pg8::bf16x8, *(const u32x4*)(wp1 + k0));
        pg8::bf16x8 af[NTB];
#pragma unroll
        for (int tb = 0; tb < NTB; ++tb) af[tb] = __builtin_bit_cast(pg8::bf16x8, *(const u32x4*)(ap + (size_t)(tb * 16) * K + k0));
#pragma unroll
        for (int tb = 0; tb < NTB; ++tb) { acc0[tb] = __builtin_amdgcn_mfma_f32_16x16x32_bf16(wf0, af[tb], acc0[tb], 0, 0, 0);
            if (PAIRED) acc1[tb] = __builtin_amdgcn_mfma_f32_16x16x32_bf16(wf1, af[tb], acc1[tb], 0, 0, 0); }
    }
    __syncthreads();
#pragma unroll
    for (int tb = 0; tb < NTB; ++tb) { *(PG8_LAS f32x4*)(lds + ((w * NTB + tb) * 64 + lane) * 16) = acc0[tb]; if (PAIRED) *(PG8_LAS f32x4*)(lds + 65536 + ((w * NTB + tb) * 64 + lane) * 16) = acc1[tb]; }
    __syncthreads();
    if (w < NTB) {
        f32x4 s0 = (f32x4){0.f, 0.f, 0.f, 0.f}, s1 = s0;
#pragma unroll
        for (int ww = 0; ww < 8; ++ww) { s0 += *(const PG8_LAS f32x4*)(lds + ((ww * NTB + w) * 64 + lane) * 16); if (PAIRED) s1 += *(const PG8_LAS f32x4*)(lds + 65536 + ((ww * NTB + w) * 64 + lane) * 16); }
        epi(s0, s1, TP + tok0 + 16 * w + r16, 4 * q);
    }
}
__device__ __forceinline__ u32x2 pack4(const f32x4 v) { u32x2 w; w.x = cvt_pk_bf16(v[0], v[1]); w.y = cvt_pk_bf16(v[2], v[3]); return w; }
__device__ __forceinline__ f32x4 unpack4(const u32x2 w) { return (f32x4){bf_lo(w.x), bf_hi(w.x), bf_lo(w.y), bf_hi(w.y)}; }

struct EpiNull {
    static constexpr bool PERM = true, AFTER_DRAIN = false, PREFETCH = false;
    float* sink;
    __device__ __forceinline__ void operator()(const f32x4 (&acc)[2][2][4][2], const Unit& u, int wr, int wc, int fr, int fq) const {
        if (acc[0][0][0][0][0] == 1.2345e-33f) *sink = 1.f;
    }
};

template <int MODE> struct EpiProbe {
    static constexpr bool PERM = true, AFTER_DRAIN = false, PREFETCH = false;
    unsigned char* ws; float* sink;
    __device__ __forceinline__ void operator()(const f32x4 (&acc)[2][2][4][2], const Unit& u, int wr, int wc, int fr, int fq) const {
        const int row0 = u.pm * 256 + wr * 64 + fr; bf16_t* base = (bf16_t*)(ws + WS_FF) + u.pn * 128 + wc * 32 + 8 * fq;
        if (MODE == 0) {
#pragma unroll
            for (int g = 0; g < 8; ++g) { EPI_G(g); *(u32x4*)(base + (size_t)row * DFF) = pack8(acc[ai][0][m][0] + acc[ai][1][m][0], acc[ai][0][m][1] + acc[ai][1][m][1]); }
        } else {
            f32x4 s = (f32x4){0.f, 0.f, 0.f, 0.f};
#pragma unroll
            for (int g = 0; g < 8; ++g) { EPI_G(g); (void)row; s += acc[ai][0][m][0] + acc[ai][1][m][0] + acc[ai][0][m][1] + acc[ai][1][m][1]; }
            if (s[0] + s[1] + s[2] + s[3] == 1.2345e-33f) *sink = 1.f;
        }
    }
};
__device__ __forceinline__ int otid() { int t = threadIdx.x; asm volatile("" : "+v"(t)); return t; }
struct Args { const float* in[25]; float* out; unsigned char* ws; int ph_lo, ph_hi; };
enum { I_XP = 0, I_XS, I_SCONV, I_SRE, I_SIM, I_N1G, I_WIN, I_CONVW, I_CONVB, I_LRE, I_LIM, I_LDT, I_BRE, I_BIM, I_CRE, I_CIM, I_SD, I_WGLU, I_BGLU, I_WBR, I_WOUT, I_N2G, I_WGU, I_WDN, I_FG };

__device__ __forceinline__ int perm_in(int n0) { if (n0 < 512 || n0 >= 1536) return n0; const int q = n0 - 512, tl = q >> 8, rr = q & 255; return rr < 128 ? 512 + tl * 128 + rr : 1024 + tl * 128 + (rr - 128); }
__device__ __forceinline__ int perm_gu(int n0) { const int tl = n0 >> 8, rr = n0 & 255; return rr < 128 ? tl * 128 + rr : DFF + tl * 128 + (rr - 128); }

constexpr int P0_PER = 256 + 16 + 32 + 32 + 64 + 352 + 176;
__device__ __forceinline__ void p0_weights(const Args& a, float* tile, int it_lo, int it_hi, int vb, int nvb) {
    constexpr int PER = P0_PER, TP_ = 260;
    unsigned char* ws = a.ws; const int tid = otid(); const __amdgpu_buffer_rsrc_t rwp = __builtin_amdgcn_make_buffer_rsrc(ws, 0, (int)WS_ZEND, WT_FLAGS);
    for (int it = it_lo + vb; it < it_hi; it += nvb) {
        const int l = it / PER; int r = it % PER;
        const float* src; const float* gs = nullptr; bf16_t* dst; int ldn, K, n0, k0, sn0, sn1;
        if (r < 256) { n0 = (r >> 4) * 256; k0 = (r & 15) * 64; src = a.in[I_WIN] + (size_t)l * 1024 * 4096; ldn = 4096; K = 1024; dst = (bf16_t*)(ws + WS_WIN + l * SZ_WIN); gs = a.in[I_N1G] + l * 1024; sn0 = perm_in(n0); sn1 = perm_in(n0 + 128); }
        else if ((r -= 256) < 16) { n0 = (r >> 3) * 256; k0 = (r & 7) * 64; src = a.in[I_WGLU] + (size_t)l * 512 * 512; ldn = 512; K = 512; dst = (bf16_t*)(ws + WS_WGLU + l * SZ_WGLU); sn0 = n0; sn1 = n0 + 128; }
        else if ((r -= 16) < 32) { n0 = (r >> 3) * 256; k0 = (r & 7) * 64; src = a.in[I_WBR] + (size_t)l * 1024 * 1024; ldn = 1024; K = 512; dst = (bf16_t*)(ws + WS_WBA + l * SZ_WB); sn0 = n0; sn1 = n0 + 128; }
        else if ((r -= 32) < 32) { n0 = (r >> 3) * 256; k0 = (r & 7) * 64; src = a.in[I_WBR] + (size_t)l * 1024 * 1024 + (size_t)512 * 1024; ldn = 1024; K = 512; dst = (bf16_t*)(ws + WS_WBB + l * SZ_WB); sn0 = n0; sn1 = n0 + 128; }
        else if ((r -= 32) < 64) { n0 = (r >> 4) * 256; k0 = (r & 15) * 64; src = a.in[I_WOUT] + (size_t)l * 1024 * 1024; ldn = 1024; K = 1024; dst = (bf16_t*)(ws + WS_WOUT + l * SZ_WOUT); sn0 = n0; sn1 = n0 + 128; }
        else if ((r -= 64) < 352) { n0 = (r >> 4) * 256; k0 = (r & 15) * 64; src = a.in[I_WGU] + (size_t)l * 1024 * 5632; ldn = 5632; K = 1024; dst = (bf16_t*)(ws + WS_WGU + l * SZ_WGU); gs = a.in[I_N2G] + l * 1024; sn0 = perm_gu(n0); sn1 = perm_gu(n0 + 128); }
        else { r -= 352; n0 = (r / 44) * 256; k0 = (r % 44) * 64; src = a.in[I_WDN] + (size_t)l * DFF * 1024; ldn = 1024; K = DFF; dst = (bf16_t*)(ws + WS_WDN + l * SZ_WDN); sn0 = n0; sn1 = n0 + 128; }
        f32x4 v[8];
#pragma unroll
        for (int j = 0; j < 8; ++j) { const int idx = tid + 512 * j, k = idx >> 6, n = (idx & 63) * 4; v[j] = *(const f32x4*)(src + (size_t)(k0 + k) * ldn + (n < 128 ? sn0 + n : sn1 + n - 128)); }
        __syncthreads();
#pragma unroll
        for (int j = 0; j < 8; ++j) { const int idx = tid + 512 * j, k = idx >> 6, n = (idx & 63) * 4; f32x4 x = v[j]; if (gs) x *= gs[k0 + k]; *(f32x4*)(tile + k * TP_ + n) = x; }
        __syncthreads();
#pragma unroll
        for (int j = 0; j < 4; ++j) { const int idx = tid + 512 * j, n = idx & 255, kg = idx >> 8; const float* tp = tile + (8 * kg) * TP_ + n; u32x4 w;
            w.x = cvt_pk_bf16(tp[0], tp[TP_]); w.y = cvt_pk_bf16(tp[2 * TP_], tp[3 * TP_]); w.z = cvt_pk_bf16(tp[4 * TP_], tp[5 * TP_]); w.w = cvt_pk_bf16(tp[6 * TP_], tp[7 * TP_]);
            wt16(rwp, ws, dst + (size_t)(n0 + n) * K + k0 + 8 * kg, w); }
    }
}
__device__ __forceinline__ void p0_ssm(const Args& a) {
    float* ABAR = (float*)(a.ws + WS_ABAR); float* APOW = (float*)(a.ws + WS_APOW); float* BBAR = (float*)(a.ws + WS_BBAR); u32x4* BBF = (u32x4*)(a.ws + WS_BBF); const int tx0_ = otid();
    for (int i = blockIdx.x * 512 + tx0_; i < NL * NG * NP; i += gridDim.x * 512) {
        const int lg = i >> 6;
        const float dt = expf(a.in[I_LDT][lg]), lr = a.in[I_LRE][i], li = a.in[I_LIM][i];
        const float mag = expf(lr * dt), ang = li * dt; float sn, cs; sincosf(ang, &sn, &cs);
        const float ar = mag * cs, ai = mag * sn, nr = ar - 1.0f, ni = ai, den = lr * lr + li * li, fr = (nr * lr + ni * li) / den, fi = (ni * lr - nr * li) / den;
        ABAR[2 * i] = ar; ABAR[2 * i + 1] = ai;
        float pr = ar, pi = ai;
#pragma unroll
        for (int s = 0; s < 6; ++s) { const float tr = pr * pr - pi * pi, ti = 2.0f * pr * pi; pr = tr; pi = ti; }
        APOW[2 * i] = pr; APOW[2 * i + 1] = pi;
        float bbr[16], bbi[16];
#pragma unroll
        for (int c = 0; c < 16; ++c) { const float br = a.in[I_BRE][(size_t)i * 16 + c], bi = a.in[I_BIM][(size_t)i * 16 + c]; bbr[c] = fr * br - fi * bi; bbi[c] = fr * bi + fi * br; BBAR[((size_t)lg * 32 + c) * NP + (i & 63)] = bbr[c]; BBAR[((size_t)lg * 32 + 16 + c) * NP + (i & 63)] = bbi[c]; }
        const int p = i & 63, sh = p >> 5, n = p & 31;
#pragma unroll
        for (int h = 0; h < 2; ++h) {
            u32x4 wr_, wi_; wr_.x = cvt_pk_bf16(bbr[8 * h], bbr[8 * h + 1]); wr_.y = cvt_pk_bf16(bbr[8 * h + 2], bbr[8 * h + 3]); wr_.z = cvt_pk_bf16(bbr[8 * h + 4], bbr[8 * h + 5]); wr_.w = cvt_pk_bf16(bbr[8 * h + 6], bbr[8 * h + 7]);
            wi_.x = cvt_pk_bf16(bbi[8 * h], bbi[8 * h + 1]); wi_.y = cvt_pk_bf16(bbi[8 * h + 2], bbi[8 * h + 3]); wi_.z = cvt_pk_bf16(bbi[8 * h + 4], bbi[8 * h + 5]); wi_.w = cvt_pk_bf16(bbi[8 * h + 6], bbi[8 * h + 7]);
            BBF[((size_t)lg * 4 + 2 * sh) * 64 + 32 * h + n] = wr_; BBF[((size_t)lg * 4 + 2 * sh + 1) * 64 + 32 * h + n] = wi_; }
    }
    u32x4* CMF = (u32x4*)(a.ws + WS_CMF);
    for (int i = blockIdx.x * 512 + tx0_; i < NL * NG * 5 * 64; i += gridDim.x * 512) {
        const int lane = i & 63, ks = (i >> 6) % 5, lg = i / 320, ch = lane & 15, q = lane >> 4; float v[8];
#pragma unroll
        for (int j = 0; j < 8; ++j) {
            if (ks < 4) { const int k = 32 * ks + 8 * q + j, sh = k >> 6, kk = k & 63, p = sh * 32 + (kk >> 1); const size_t ci = ((size_t)lg * 16 + ch) * NP + p; v[j] = (kk & 1) ? -a.in[I_CIM][ci] : a.in[I_CRE][ci]; }
            else v[j] = (8 * q + j == ch) ? a.in[I_SD][(size_t)lg * 16 + ch] : 0.f; }
        u32x4 w; w.x = cvt_pk_bf16(v[0], v[1]); w.y = cvt_pk_bf16(v[2], v[3]); w.z = cvt_pk_bf16(v[4], v[5]); w.w = cvt_pk_bf16(v[6], v[7]); CMF[i] = w;
    }
}
__device__ __forceinline__ void p0_x(const Args& a) {
    float* X = a.out; bf16_t* XB = (bf16_t*)(a.ws + WS_XB); rsum_t* RS = (rsum_t*)(a.ws + WS_ROWSS);
    int tx_ = threadIdx.x; asm volatile("" : "+v"(tx_)); const int lane = tx_ & 63, gw = blockIdx.x * 8 + (tx_ >> 6), nw = gridDim.x * 8;
    for (int i = blockIdx.x * 512 + tx_; i < 9 * MP; i += gridDim.x * 512) if (i >= T) RS[i] = 0ull;
    for (int r0 = gw; r0 < T; r0 += 2 * nw) {
        f32x4 v[2][4];
#pragma unroll
        for (int k = 0; k < 2; ++k) { const int row = r0 + k * nw; if (row < T) { const float* src = row < TP ? a.in[I_XP] + (size_t)row * D : a.in[I_XS] + (size_t)(row - TP) * D;
#pragma unroll
            for (int j = 0; j < 2; ++j) { const int c = j * 512 + lane * 8; v[k][2 * j] = *(const f32x4*)(src + c); v[k][2 * j + 1] = *(const f32x4*)(src + c + 4); } } }
#pragma unroll
        for (int k = 0; k < 2; ++k) { const int row = r0 + k * nw; if (row < T) { float ss = 0.f;
#pragma unroll
            for (int j = 0; j < 2; ++j) { const int c = j * 512 + lane * 8; const f32x4 v0 = v[k][2 * j], v1 = v[k][2 * j + 1];
                *(f32x4*)(X + (size_t)row * D + c) = v0; *(f32x4*)(X + (size_t)row * D + c + 4) = v1; *(u32x4*)(XB + (size_t)row * D + c) = pack8(v0, v1);
                ss += (v0[0] * v0[0] + v0[1] * v0[1]) + (v0[2] * v0[2] + v0[3] * v0[3]) + (v1[0] * v1[0] + v1[1] * v1[1]) + (v1[2] * v1[2] + v1[3] * v1[3]); }
#pragma unroll
            for (int o = 32; o >= 1; o >>= 1) ss += __shfl_xor(ss, o);
            if (lane == 0) RS[row] = rs_enc(ss); } }
    }
}
__device__ __forceinline__ void final_norm(const Args& a) {
    float* X = a.out; const rsum_t* RS = (const rsum_t*)(a.ws + WS_ROWSS) + 8 * (size_t)MP; const float* g = a.in[I_FG];
    int tx_ = threadIdx.x; asm volatile("" : "+v"(tx_)); const int lane = tx_ & 63, gw = blockIdx.x * 8 + (tx_ >> 6), nw = gridDim.x * 8;
    f32x4 gg[4];
#pragma unroll
    for (int j = 0; j < 4; ++j) gg[j] = *(const f32x4*)(g + j * 256 + lane * 4);
    for (int r0 = gw; r0 < T; r0 += 2 * nw) {
        f32x4 v[2][4]; float rsv[2];
#pragma unroll
        for (int k = 0; k < 2; ++k) { const int row = r0 + k * nw; if (row < T) { rsv[k] = rs_ms(RS[row]);
#pragma unroll
            for (int j = 0; j < 4; ++j) v[k][j] = *(const f32x4*)(X + (size_t)row * D + j * 256 + lane * 4); } }
#pragma unroll
        for (int k = 0; k < 2; ++k) { const int row = r0 + k * nw; if (row < T) { const float rs = rsqrtf(rsv[k]);
#pragma unroll
            for (int j = 0; j < 4; ++j) *(f32x4*)(X + (size_t)row * D + j * 256 + lane * 4) = v[k][j] * rs * gg[j]; } }
    }
}
__device__ __forceinline__ void conv_phase(const Args& a, int l) {
    bf16_t* ZB = (bf16_t*)(a.ws + WS_ZB); const bf16_t* CV = (const bf16_t*)(a.ws + WS_CV);
    const float* cw = a.in[I_CONVW] + (size_t)l * 3 * CW; const float* cb = a.in[I_CONVB] + (size_t)l * CW; const float* sc = a.in[I_SCONV] + (size_t)l * TS * 2 * CW;
    const int txc_ = otid(); const int c8 = (txc_ & 63) * 8; const __amdgpu_buffer_rsrc_t rwc = __builtin_amdgcn_make_buffer_rsrc(a.ws, 0, (int)WS_ZEND, WT_FLAGS);
    const f32x4 w0a = *(const f32x4*)(cw + c8), w0b = *(const f32x4*)(cw + c8 + 4), w1a = *(const f32x4*)(cw + CW + c8), w1b = *(const f32x4*)(cw + CW + c8 + 4),
                w2a = *(const f32x4*)(cw + 2 * CW + c8), w2b = *(const f32x4*)(cw + 2 * CW + c8 + 4), ba = *(const f32x4*)(cb + c8), bb = *(const f32x4*)(cb + c8 + 4);
    const f32x4 zero = (f32x4){0.f, 0.f, 0.f, 0.f};
    for (int r0 = blockIdx.x * 8 + (txc_ >> 6); r0 < T; r0 += gridDim.x * 32) {
        u32x4 zr[4], x0r[4], x1r[4], x2r[4]; f32x4 s1a[4], s1b[4], s2a[4], s2b[4];
#pragma unroll
        for (int k = 0; k < 4; ++k) { const int row = r0 + k * gridDim.x * 8; if (row < T) { const size_t off = (size_t)row * 512 + c8;
            zr[k] = *(const u32x4*)(ZB + off); x0r[k] = *(const u32x4*)(CV + off);
            if (row < TP) { const int t = row & (SEQ - 1); x1r[k] = (u32x4){0u, 0u, 0u, 0u}; x2r[k] = x1r[k]; if (t >= 1) x1r[k] = *(const u32x4*)(CV + off - 512); if (t >= 2) x2r[k] = *(const u32x4*)(CV + off - 1024); }
            else { const float* s0 = sc + (size_t)(row - TP) * 2 * CW + c8; s2a[k] = *(const f32x4*)s0; s2b[k] = *(const f32x4*)(s0 + 4); s1a[k] = *(const f32x4*)(s0 + CW); s1b[k] = *(const f32x4*)(s0 + CW + 4); } } }
        asm volatile("" ::: "memory");
#pragma unroll
        for (int k = 0; k < 4; ++k) { const int row = r0 + k * gridDim.x * 8; if (row < T) { const size_t off = (size_t)row * 512 + c8;
            f32x4 z0, z1, x0a, x0b, x1a, x1b, x2a, x2b; unpack8(zr[k], z0, z1); unpack8(x0r[k], x0a, x0b);
            if (row < TP) { const int t = row & (SEQ - 1); unpack8(x1r[k], x1a, x1b); unpack8(x2r[k], x2a, x2b);
                if (t >= SEQ - 2) { float* o = a.out + O_PC + ((size_t)(l * NB + (row >> 11)) * 2 + (t - (SEQ - 2))) * CW + c8; *(f32x4*)o = x0a; *(f32x4*)(o + 4) = x0b; } }
            else { const int b = row - TP; x1a = s1a[k]; x1b = s1b[k]; x2a = s2a[k]; x2b = s2b[k];
                float* o = a.out + O_SC + (size_t)(l * TS + b) * 2 * CW + c8; *(f32x4*)o = x1a; *(f32x4*)(o + 4) = x1b; *(f32x4*)(o + CW) = x0a; *(f32x4*)(o + CW + 4) = x0b; }
            const f32x4 oa = z0 * (ba + w0a * x2a + w1a * x1a + w2a * x0a), ob = z1 * (bb + w0b * x2b + w1b * x1b + w2b * x0b);
            wt16(rwc, a.ws, ZB + off, pack8(oa, ob)); } }
    }
}
struct SsmW { float ar, ai; float bbr[16], bbi[16]; };
template <bool OUT> __device__ __forceinline__ void ssm_run(const bf16_t* U, bf16_t* GY, int row0, int ntok, int g, float& hr, float& hi, const float ar, const float ai,
                                                            const float (&bbr)[16], const float (&bbi)[16], const float (&cr)[16], const float (&ci)[16], const float (&dl)[16], int lane) {
    for (int t0 = 0; t0 < ntok; t0 += 64) {
        const int nt = (ntok - t0) < 64 ? (ntok - t0) : 64;
        u32x4 w0 = (u32x4){0u, 0u, 0u, 0u}, w1 = w0;
        if (lane < nt) { const u32x4* up = (const u32x4*)(U + (size_t)(row0 + t0 + lane) * 512 + g * 16); w0 = up[0]; w1 = up[1]; }
        for (int j = 0; j < nt; ++j) {
            unsigned ws_[8]; ws_[0] = __builtin_amdgcn_readlane(w0.x, j); ws_[1] = __builtin_amdgcn_readlane(w0.y, j); ws_[2] = __builtin_amdgcn_readlane(w0.z, j); ws_[3] = __builtin_amdgcn_readlane(w0.w, j);
            ws_[4] = __builtin_amdgcn_readlane(w1.x, j); ws_[5] = __builtin_amdgcn_readlane(w1.y, j); ws_[6] = __builtin_amdgcn_readlane(w1.z, j); ws_[7] = __builtin_amdgcn_readlane(w1.w, j);
            float uu[16];
#pragma unroll
            for (int q = 0; q < 8; ++q) { uu[2 * q] = bf_lo(ws_[q]); uu[2 * q + 1] = bf_hi(ws_[q]); }
            float bur = 0.f, bui = 0.f;
#pragma unroll
            for (int c = 0; c < 16; ++c) { bur = fmaf(bbr[c], uu[c], bur); bui = fmaf(bbi[c], uu[c], bui); }
            const float nhr = ar * hr - ai * hi + bur, nhi = ar * hi + ai * hr + bui; hr = nhr; hi = nhi;
            if (OUT) {
                float v[16];
#pragma unroll
                for (int c = 0; c < 16; ++c) v[c] = fmaf(dl[c], uu[c], cr[c] * hr - ci[c] * hi);
                float w8[8], w4[4], w2[2], w1_;
                { const bool up = lane & 32;
#pragma unroll
                  for (int k = 0; k < 8; ++k) { const float send = up ? v[k] : v[k + 8], keep = up ? v[k + 8] : v[k]; w8[k] = keep + __shfl_xor(send, 32); } }
                { const bool up = lane & 16;
#pragma unroll
                  for (int k = 0; k < 4; ++k) { const float send = up ? w8[k] : w8[k + 4], keep = up ? w8[k + 4] : w8[k]; w4[k] = keep + __shfl_xor(send, 16); } }
                { const bool up = lane & 8;
#pragma unroll
                  for (int k = 0; k < 2; ++k) { const float send = up ? w4[k] : w4[k + 2], keep = up ? w4[k + 2] : w4[k]; w2[k] = keep + __shfl_xor(send, 8); } }
                { const bool up = lane & 4; const float send = up ? w2[0] : w2[1], keep = up ? w2[1] : w2[0]; w1_ = keep + __shfl_xor(send, 4); }
                w1_ += __shfl_xor(w1_, 2); w1_ += __shfl_xor(w1_, 1);
                const float gy = 0.5f * w1_ * (1.0f + erff(w1_ * 0.70710678118f));
                if ((lane & 3) == 0) GY[(size_t)(row0 + t0 + j) * 512 + g * 16 + (lane >> 2)] = (bf16_t)(cvt_pk_bf16(gy, gy) & 0xffffu);
            }
        }
    }
}
__device__ __forceinline__ void ssm_sample_phase(const Args& a, int l) {
    const bf16_t* U = (const bf16_t*)(a.ws + WS_U); bf16_t* GY = (bf16_t*)(a.ws + WS_GY);
    const float* ABAR = (const float*)(a.ws + WS_ABAR); const float* BBAR = (const float*)(a.ws + WS_BBAR);
    int tx_ = threadIdx.x; asm volatile("" : "+v"(tx_)); const int lane = tx_ & 63, gw = blockIdx.x * 8 + (tx_ >> 6), nw = gridDim.x * 8;
    for (int item = gw; item < TS * NG; item += nw) {
        const int b = item >> 5, g = item & 31, i = (l * NG + g) * NP + lane;
        const float ar = ABAR[2 * i], ai = ABAR[2 * i + 1];
        float bbr[16], bbi[16], cr[16], ci[16], dl[16];
#pragma unroll
        for (int c = 0; c < 16; ++c) { bbr[c] = BBAR[((size_t)(l * NG + g) * 32 + c) * NP + lane]; bbi[c] = BBAR[((size_t)(l * NG + g) * 32 + 16 + c) * NP + lane]; const size_t ci_ = ((size_t)(l * NG + g) * 16 + c) * NP + lane; cr[c] = a.in[I_CRE][ci_]; ci[c] = a.in[I_CIM][ci_]; dl[c] = lane == 0 ? a.in[I_SD][(size_t)l * 512 + g * 16 + c] : 0.f; }
        const size_t si = ((size_t)(l * TS + b) * NG + g) * NP + lane; float hr = a.in[I_SRE][si], hi = a.in[I_SIM][si];
        ssm_run<true>(U, GY, TP + b, 1, g, hr, hi, ar, ai, bbr, bbi, cr, ci, dl, lane);
        a.out[O_SRE + si] = hr; a.out[O_SIM + si] = hi;
    }
}
typedef float f32x16 __attribute__((ext_vector_type(16)));
constexpr int SSM_HP = 272, SSM_WAVE_LDS = 32 * SSM_HP;
__device__ __forceinline__ void ssm_pass1_dual(const Args& a, int l) {
    const bf16_t* U = (const bf16_t*)(a.ws + WS_U); const float* ABAR = (const float*)(a.ws + WS_ABAR); float* E = (float*)(a.ws + WS_E); const u32x4* BBF = (const u32x4*)(a.ws + WS_BBF);
    int tx_ = threadIdx.x; asm volatile("" : "+v"(tx_)); const int lane = tx_ & 63, gw = blockIdx.x * 8 + (tx_ >> 6), nw = gridDim.x * 8, n = lane & 31, hh = lane >> 5;
    for (int item = gw; item < NB * NG * 8; item += nw) {
        const int b0 = item >> 9, g = (item >> 4) & 31, ch = item & 15, lg = l * NG + g;
        float ar[2], ai[2], hr[2][2] = {{0.f, 0.f}, {0.f, 0.f}}, hi[2][2] = {{0.f, 0.f}, {0.f, 0.f}};
#pragma unroll
        for (int sh = 0; sh < 2; ++sh) { const int i = lg * NP + sh * 32 + n; ar[sh] = ABAR[2 * i]; ai[sh] = ABAR[2 * i + 1]; }
        pg8::bf16x8 bf[4];
#pragma unroll
        for (int ct = 0; ct < 4; ++ct) bf[ct] = __builtin_bit_cast(pg8::bf16x8, BBF[((size_t)lg * 4 + ct) * 64 + lane]);
        const bf16_t* up0 = U + (size_t)(b0 * SEQ + ch * 128 + 64 * ((n >> 2) & 1) + 4 * (n >> 3) + (n & 3)) * 512 + g * 16 + 8 * hh;
        u32x4 cur0 = *(const u32x4*)up0, cur1 = *(const u32x4*)(up0 + (size_t)4 * SEQ * 512);
#pragma unroll 1
        for (int rt = 0; rt < 4; ++rt) {
            const int rn = rt < 3 ? rt + 1 : 3;
            const u32x4 nxt0 = *(const u32x4*)(up0 + (size_t)(16 * rn) * 512), nxt1 = *(const u32x4*)(up0 + (size_t)(4 * SEQ + 16 * rn) * 512);
            f32x16 acc[2][4];
#pragma unroll
            for (int ct = 0; ct < 4; ++ct) { f32x16 z;
#pragma unroll
                for (int i = 0; i < 16; ++i) z[i] = 0.f;
                acc[0][ct] = __builtin_amdgcn_mfma_f32_32x32x16_bf16(__builtin_bit_cast(pg8::bf16x8, cur0), bf[ct], z, 0, 0, 0);
                acc[1][ct] = __builtin_amdgcn_mfma_f32_32x32x16_bf16(__builtin_bit_cast(pg8::bf16x8, cur1), bf[ct], z, 0, 0, 0); }
#pragma unroll
            for (int i = 0; i < 16; ++i)
#pragma unroll
                for (int sh = 0; sh < 2; ++sh)
#pragma unroll
                    for (int it = 0; it < 2; ++it) { const float nr = ar[sh] * hr[it][sh] - ai[sh] * hi[it][sh] + acc[it][2 * sh][i], ni = ar[sh] * hi[it][sh] + ai[sh] * hr[it][sh] + acc[it][2 * sh + 1][i]; hr[it][sh] = nr; hi[it][sh] = ni; }
            cur0 = nxt0; cur1 = nxt1;
        }
#pragma unroll
        for (int it = 0; it < 2; ++it)
#pragma unroll
            for (int sh = 0; sh < 2; ++sh) { const size_t ei = (((size_t)((b0 + 4 * it) * NG + g) * NCH + 2 * ch + hh) * NP + sh * 32 + n) * 2; E[ei] = hr[it][sh]; E[ei + 1] = hi[it][sh]; }
    }
}
template <bool PASS2> __device__ __forceinline__ void ssm_mfma_phase(const Args& a, int l, PG8_LAS unsigned char* lds) {
    const bf16_t* U = (const bf16_t*)(a.ws + WS_U); bf16_t* GY = (bf16_t*)(a.ws + WS_GY);
    const float* ABAR = (const float*)(a.ws + WS_ABAR); const float* APOW = (const float*)(a.ws + WS_APOW); float* E = (float*)(a.ws + WS_E);
    const u32x4* BBF = (const u32x4*)(a.ws + WS_BBF); const u32x4* CMF = (const u32x4*)(a.ws + WS_CMF);
    int tx_ = threadIdx.x; asm volatile("" : "+v"(tx_)); const int lane = tx_ & 63, wid = tx_ >> 6, gw = blockIdx.x * 8 + wid, nw = gridDim.x * 8;
    const int n = lane & 31, hh = lane >> 5, t16 = lane & 15, q = lane >> 4;
    PG8_LAS unsigned char* hl = lds + wid * SSM_WAVE_LDS;
    PG8_LAS float* Elds = (PG8_LAS float*)(lds + 81920);
    (void)gw; (void)nw; (void)E;
#pragma unroll 1
    for (int kk = 0; kk < 2; ++kk) {
        const int b = blockIdx.x >> 5, g = blockIdx.x & 31, ch = 2 * wid + kk, lg = l * NG + g;
        float ar[2], ai[2], hr[2] = {0.f, 0.f}, hi[2] = {0.f, 0.f};
#pragma unroll
        for (int sh = 0; sh < 2; ++sh) { const int i = lg * NP + sh * 32 + n; ar[sh] = ABAR[2 * i]; ai[sh] = ABAR[2 * i + 1]; }
        pg8::bf16x8 bf[4];
#pragma unroll
        for (int ct = 0; ct < 4; ++ct) bf[ct] = __builtin_bit_cast(pg8::bf16x8, BBF[((size_t)lg * 4 + ct) * 64 + lane]);
        pg8::bf16x8 cm[5];
        if (PASS2) {
#pragma unroll
            for (int ks = 0; ks < 5; ++ks) cm[ks] = __builtin_bit_cast(pg8::bf16x8, CMF[((size_t)lg * 5 + ks) * 64 + lane]);
            const int sc = 2 * ch + hh; float pr[2], pi[2];
#pragma unroll
            for (int sh = 0; sh < 2; ++sh) { const int i = lg * NP + sh * 32 + n; pr[sh] = APOW[2 * i]; pi[sh] = APOW[2 * i + 1]; }
            typedef float f32x2_ __attribute__((ext_vector_type(2)));
            const PG8_LAS f32x2_* Eb = (const PG8_LAS f32x2_*)Elds + n;
            for (int jb = 0; jb < 2 * ch + 1; jb += 8) {
                f32x2_ e0[8], e1[8];
#pragma unroll
                for (int jj = 0; jj < 8; ++jj) { e0[jj] = Eb[(jb + jj) * NP]; e1[jj] = Eb[(jb + jj) * NP + 32]; }
#pragma unroll
                for (int jj = 0; jj < 8; ++jj) if (jb + jj < sc) {
                    const float tr0 = pr[0] * hr[0] - pi[0] * hi[0] + e0[jj].x, ti0 = pr[0] * hi[0] + pi[0] * hr[0] + e0[jj].y; hr[0] = tr0; hi[0] = ti0;
                    const float tr1 = pr[1] * hr[1] - pi[1] * hi[1] + e1[jj].x, ti1 = pr[1] * hi[1] + pi[1] * hr[1] + e1[jj].y; hr[1] = tr1; hi[1] = ti1; }
            }
        }
        const int row0 = b * SEQ + ch * 128;
        u32x4 afr4[4], uw4[4][2];
#pragma unroll
        for (int rt = 0; rt < 4; ++rt) {
            const int tau = 64 * ((n >> 2) & 1) + 16 * rt + 4 * (n >> 3) + (n & 3);
            afr4[rt] = *(const u32x4*)(U + (size_t)(row0 + tau) * 512 + g * 16 + 8 * hh);
            if (PASS2) {
#pragma unroll
                for (int tb = 0; tb < 2; ++tb) { uw4[rt][tb] = (u32x4){0u, 0u, 0u, 0u}; if (q < 2) uw4[rt][tb] = *(const u32x4*)(U + (size_t)(row0 + 64 * tb + 16 * rt + t16) * 512 + g * 16 + 8 * q); } }
        }
#pragma unroll
        for (int rt = 0; rt < 4; ++rt) {
            const pg8::bf16x8 afr = __builtin_bit_cast(pg8::bf16x8, afr4[rt]);
            f32x16 acc[4];
#pragma unroll
            for (int ct = 0; ct < 4; ++ct) { f32x16 z;
#pragma unroll
                for (int i = 0; i < 16; ++i) z[i] = 0.f;
                acc[ct] = __builtin_amdgcn_mfma_f32_32x32x16_bf16(afr, bf[ct], z, 0, 0, 0); }
#pragma unroll
            for (int sh = 0; sh < 2; ++sh)
#pragma unroll
                for (int i = 0; i < 16; ++i) { const float nr = ar[sh] * hr[sh] - ai[sh] * hi[sh] + acc[2 * sh][i], ni = ar[sh] * hi[sh] + ai[sh] * hr[sh] + acc[2 * sh + 1][i]; hr[sh] = nr; hi[sh] = ni;
                    if (PASS2) *(PG8_LAS unsigned*)(hl + (16 * hh + i) * SSM_HP + sh * 128 + 4 * n) = cvt_pk_bf16(nr, ni); }
            if (PASS2) {
                asm volatile("s_waitcnt lgkmcnt(0)" ::: "memory");
#pragma unroll
                for (int tb = 0; tb < 2; ++tb) {
                    f32x4 y = (f32x4){0.f, 0.f, 0.f, 0.f};
#pragma unroll
                    for (int ks = 0; ks < 4; ++ks) { const pg8::bf16x8 hf = __builtin_bit_cast(pg8::bf16x8, *(const PG8_LAS u32x4*)(hl + (16 * tb + t16) * SSM_HP + (32 * ks + 8 * q) * 2)); y = __builtin_amdgcn_mfma_f32_16x16x32_bf16(cm[ks], hf, y, 0, 0, 0); }
                    const size_t trow = (size_t)(row0 + 64 * tb + 16 * rt + t16) * 512 + g * 16;
                    y = __builtin_amdgcn_mfma_f32_16x16x32_bf16(cm[4], __builtin_bit_cast(pg8::bf16x8, uw4[rt][tb]), y, 0, 0, 0);
                    const pg8::f32x2 ga = pg8::gelu_pk((pg8::f32x2){y[0], y[1]}), gb = pg8::gelu_pk((pg8::f32x2){y[2], y[3]});
                    u32x2 w; w.x = cvt_pk_bf16(ga.x, ga.y); w.y = cvt_pk_bf16(gb.x, gb.y); *(u32x2*)(GY + trow + 4 * q) = w;
                }
                asm volatile("s_waitcnt lgkmcnt(0)" ::: "memory");
            }
        }
        if (!PASS2) {
#pragma unroll
            for (int sh = 0; sh < 2; ++sh) { const int ei = ((2 * ch + hh) * NP + sh * 32 + n) * 2; Elds[ei] = hr[sh]; Elds[ei + 1] = hi[sh]; }
        } else if (ch == 15 && hh == 1) {
#pragma unroll
            for (int sh = 0; sh < 2; ++sh) { const size_t oi = ((size_t)(l * NB + b) * NG + g) * NP + sh * 32 + n; a.out[O_PRE + oi] = hr[sh]; a.out[O_PIM + oi] = hi[sh]; }
        }
    }
}
#define XB_TMO      128
#define XB_XCNT(j)  (256  + 64 * (j))
#define XB_XSUB(j)  (1280 + 64 * (j))
#define XB_XGEN(j)  (2304 + 64 * (j))
#define XB_TOP      3328
#define XB_TOPGEN   3392
#define XCD_BAR_WORDS 3456
#define XB_SPIN_CAP (1u << 18)

__device__ __forceinline__ unsigned xb_ld(unsigned* p)              { return __hip_atomic_load(p, __ATOMIC_RELAXED, __HIP_MEMORY_SCOPE_AGENT); }
__device__ __forceinline__ unsigned xb_add(unsigned* p, unsigned v) { return __hip_atomic_fetch_add(p, v, __ATOMIC_RELAXED, __HIP_MEMORY_SCOPE_AGENT); }
__device__ __forceinline__ unsigned xb_xcc_id() { return (unsigned)__builtin_amdgcn_s_getreg((3 << 11) | 20) & 0xFu; }
#define XB_SPIN(cond, bar) do { unsigned _sp = 0; while (cond) { __builtin_amdgcn_s_sleep(1); \
    if ((++_sp & 255u) == 0u) { if (xb_ld(&(bar)[XB_TMO])) break; if (_sp > XB_SPIN_CAP) { atomicAdd(&(bar)[XB_TMO], 1u); break; } } } } while (0)

struct XcdBarrier {
    unsigned* bar; unsigned x;
    volatile PG8_LAS unsigned* st;
};

__device__ __forceinline__ XcdBarrier xcd_barrier_post(unsigned* bar, volatile PG8_LAS unsigned* st) {
    XcdBarrier b; b.bar = bar; b.x = xb_xcc_id(); b.st = st;
    if (threadIdx.x == 0) { st[2] = xb_add(&bar[XB_XCNT(b.x)], 1u); st[3] = b.x; }
    return b;
}
__device__ __forceinline__ void xcd_barrier_complete(unsigned* bar, unsigned x, unsigned& nloc, unsigned& nx) {
    const unsigned G = gridDim.x * gridDim.y * gridDim.z;
    unsigned sum, cnt, mine, sp = 0u;
    for (;;) {
        sum = 0u; cnt = 0u; mine = 0u;
#pragma unroll
        for (unsigned j = 0; j < 16; ++j) { const unsigned c = xb_ld(&bar[XB_XCNT(j)]); sum += c; cnt += (c > 0u) ? 1u : 0u; mine = (j == x) ? c : mine; }
        if (sum == G) break;
        __builtin_amdgcn_s_sleep(1);
        if ((++sp & 255u) == 0u) { if (xb_ld(&bar[XB_TMO])) break; if (sp > XB_SPIN_CAP) { atomicAdd(&bar[XB_TMO], 1u); break; } }
    }
    nloc = mine > 0u ? mine : 1u; nx = cnt > 0u ? cnt : 1u;
}

__device__ __forceinline__ void xcd_barrier(const XcdBarrier& b) {
    asm volatile("s_waitcnt vmcnt(0)" ::: "memory");
    __syncthreads();
    if (threadIdx.x == 0) {
        unsigned* bar = b.bar;
        __builtin_amdgcn_s_waitcnt(0);
        unsigned nloc = b.st[0], nx = b.st[1];
        if (nloc == 0u) { xcd_barrier_complete(bar, b.x, nloc, nx); b.st[0] = nloc; b.st[1] = nx; }
        const unsigned old = xb_add(&bar[XB_XSUB(b.x)], 1u);
        const unsigned gen = old / nloc;
        if (old + 1u == (gen + 1u) * nloc) {
            __builtin_amdgcn_fence(__ATOMIC_RELEASE, "agent");
            asm volatile("s_waitcnt vmcnt(0)" ::: "memory");
            const unsigned og = xb_add(&bar[XB_TOP], 1u);
            const unsigned tg = og / nx;
            if (og + 1u == (tg + 1u) * nx) xb_add(&bar[XB_TOPGEN], 1u);
            else XB_SPIN(xb_ld(&bar[XB_TOPGEN]) == tg, bar);
            __builtin_amdgcn_fence(__ATOMIC_ACQUIRE, "agent");
            xb_add(&bar[XB_XGEN(b.x)], 1u);
            asm volatile("s_waitcnt vmcnt(0)" ::: "memory");
        } else {
            XB_SPIN(xb_ld(&bar[XB_XGEN(b.x)]) == gen, bar);
            __builtin_amdgcn_fence(__ATOMIC_ACQUIRE, "agent");
            asm volatile("s_waitcnt vmcnt(0)" ::: "memory");
        }
    }
    __syncthreads();
}

#ifndef PROBE
#define PROBE 0
#endif
#ifndef PM
#define PM 511
#endif
#ifndef ONE_LAUNCH
#define ONE_LAUNCH 1
#endif
constexpr int LDS_X = pg8::STAGE_BYTES + 64, LDS_BYTES = LDS_X + 8192;
constexpr size_t WS_BAR = (WS_END + 255) & ~(size_t)255, WS_TOTAL = WS_BAR + (size_t)XCD_BAR_WORDS * 4;
constexpr int N_PHASES = 2 + 8 * NL;

__global__ void __launch_bounds__(512, 2) mk_fwd(Args a) {
    extern __shared__ __attribute__((aligned(16))) unsigned char lds_raw[];
    PG8_LAS unsigned char* lds = (PG8_LAS unsigned char*)lds_raw;
    volatile PG8_LAS unsigned* bst = (volatile PG8_LAS unsigned*)(lds + pg8::STAGE_BYTES);
    if (threadIdx.x < 16) bst[threadIdx.x] = 0u;
    __syncthreads();
    const XcdBarrier gbar = xcd_barrier_post((unsigned*)(a.ws + WS_BAR), bst);
    if (a.ph_hi > 1000) cg::this_grid().sync();
    for (int ph = a.ph_lo; ph < a.ph_hi; ++ph) {
        if (ph > 0 && ph < N_PHASES - 1 && ((ph - 1) & 7) == 2) continue;
        size_t zoff_ = 0; int G = gridDim.x, bx = blockIdx.x; asm volatile("" : "+s"(zoff_), "+s"(G), "+s"(bx)); unsigned char* ws = a.ws + zoff_;
        bf16_t* XB = (bf16_t*)(ws + WS_XB); rsum_t* RS = (rsum_t*)(ws + WS_ROWSS);
        for (int rep = 0; rep < (((PROBE == 2 && ph == 0) || (PROBE == 3 && ph > 0 && ph < N_PHASES - 1 && (((ph - 1) & 7) == 0 || ((ph - 1) & 7) == 6)) || (PROBE == 7 && ph > 0 && ph < N_PHASES - 1 && ((ph - 1) & 7) == 6) || (PROBE == 8 && ph > 0 && ph < N_PHASES - 1 && ((ph - 1) & 7) == 0) || (PROBE == 4 && ph > 0 && ph < N_PHASES - 1 && (((ph - 1) & 7) == 1 || ((ph - 1) & 7) == 2))) ? 2 : 1); ++rep) {
        if (rep) __syncthreads();
        if ((PM & 1) && ph == 0) { p0_weights(a, (float*)lds_raw, 0, P0_PER, bx, G); p0_ssm(a); p0_x(a); }
        else if ((PM & 2) && ph == N_PHASES - 1) { final_norm(a); }
        else {
            const int l = (ph - 1) >> 3, s = (ph - 1) & 7;
            if ((PM & 4) && s == 0) {
                pg8::Gemm g{XB, (const bf16_t*)(ws + WS_WIN + l * SZ_WIN), TP, 4096, 1024}; pg8::StaticOrder S; S.init(TP, 4096, G, bx);
                EpiIn E{ws, RS + (size_t)(2 * l) * MP, lds + LDS_X};
                if (PROBE == 11) { EpiNull EN{(float*)(ws + WS_E)}; pg8::gemm_phase<EpiNull, pg8::StaticOrder, false>(lds, g, S, EN, nullptr); }
                pg8::gemm_phase<EpiIn, pg8::StaticOrder, false>(lds, g, S, E, nullptr); __syncthreads();
                if (bx < 224) {
                    const int su = bx; int n0, n1, kind, dc;
                    if (su < 32) { kind = 0; dc = 16 * su; n0 = dc; n1 = n0; } else if (su < 64) { kind = 1; dc = 16 * (su - 32); n0 = 512 + (dc >> 7) * 256 + (dc & 127); n1 = n0 + 128; }
                    else if (su < 96) { kind = 2; dc = 16 * (su - 64); n0 = 1536 + dc; n1 = n0; } else if (su < 160) { kind = 3; dc = 16 * (su - 96); n0 = 2048 + dc; n1 = n0; } else { kind = 4; dc = 16 * (su - 160); n0 = 3072 + dc; n1 = n0; }
                    const rsum_t* rowss = RS + (size_t)(2 * l) * MP;
                    skinny_unit<true, 8>(lds, XB + (size_t)TP * 1024, (const bf16_t*)(ws + WS_WIN + l * SZ_WIN), 1024, n0, n1, 0, otid(), [=](const f32x4 s0, const f32x4 s1, int row, int c4) {
                        const float rs = rsqrtf(rs_ms(rowss[row])); f32x4 v = s0 * rs;
                        if (kind == 1) v = v * (s1 * rs);
                        if (kind >= 3) { _Pragma("unroll") for (int j = 0; j < 4; ++j) v[j] = sigm(v[j]); }
                        bf16_t* dst = kind == 0 ? (bf16_t*)(ws + WS_ZB) + (size_t)row * 512 : kind == 1 ? (bf16_t*)(ws + WS_CV) + (size_t)row * 512 : kind == 2 ? (bf16_t*)(ws + WS_U) + (size_t)row * 512 : kind == 3 ? (bf16_t*)(ws + WS_SGA) + (size_t)row * 1024 : (bf16_t*)(ws + WS_SGS) + (size_t)row * 1024;
                        *(u32x2*)(dst + dc + c4) = pack4(v); });
                }
            } else if ((PM & 8) && s == 1) { if (!rep) conv_phase(a, l); ssm_sample_phase(a, l); __syncthreads(); ssm_mfma_phase<false>(a, l, lds); __syncthreads(); ssm_mfma_phase<true>(a, l, lds); }
            else if ((PM & 16) && s == 2) { }
            else if ((PM & 32) && s == 3) {
                { pg8::Gemm g{(const bf16_t*)(ws + WS_ZB), (const bf16_t*)(ws + WS_WBA + l * SZ_WB), TP, 1024, 512}; pg8::StaticOrder S; S.init(TP, 1024, G, bx);
                  EpiBr<false> E{ws}; if (PROBE == 11) { EpiNull EN{(float*)(ws + WS_E)}; pg8::gemm_phase<EpiNull, pg8::StaticOrder, false>(lds, g, S, EN, nullptr); } pg8::gemm_phase<EpiBr<false>, pg8::StaticOrder, false>(lds, g, S, E, nullptr); __syncthreads(); }
                { pg8::Gemm g{(const bf16_t*)(ws + WS_GY), (const bf16_t*)(ws + WS_WGLU + l * SZ_WGLU), TP, 512, 512}; pg8::StaticOrder S; S.init(TP, 512, G, bx);
                  EpiGlu E{ws, a.in[I_BGLU] + (size_t)l * 512}; if (PROBE == 11) { EpiNull EN{(float*)(ws + WS_E)}; pg8::gemm_phase<EpiNull, pg8::StaticOrder, false>(lds, g, S, EN, nullptr); } pg8::gemm_phase<EpiGlu, pg8::StaticOrder, false>(lds, g, S, E, nullptr); __syncthreads(); }
                if (bx >= 128 && bx < 192) {
                    const int dc = 16 * (bx - 128);
                    skinny_unit<false, 8>(lds, (const bf16_t*)(ws + WS_ZB) + (size_t)TP * 512, (const bf16_t*)(ws + WS_WBA + l * SZ_WB), 512, dc, dc, 0, otid(), [=](const f32x4 s0, const f32x4 s1, int row, int c4) {
                        u32x2* p = (u32x2*)((bf16_t*)(ws + WS_SGA) + (size_t)row * 1024 + dc + c4); *p = pack4(unpack4(*p) * s0); });
                } else if (bx >= 192 && bx < 224) {
                    const int dc = 16 * (bx - 192); const float* bias = a.in[I_BGLU] + (size_t)l * 512;
                    skinny_unit<false, 8>(lds, (const bf16_t*)(ws + WS_GY) + (size_t)TP * 512, (const bf16_t*)(ws + WS_WGLU + l * SZ_WGLU), 512, dc, dc, 0, otid(), [=](const f32x4 s0, const f32x4 s1, int row, int c4) {
                        const f32x4 gy = unpack4(*(const u32x2*)((const bf16_t*)(ws + WS_GY) + (size_t)row * 512 + dc + c4)); f32x4 v = s0 + *(const f32x4*)(bias + dc + c4);
                        _Pragma("unroll") for (int j = 0; j < 4; ++j) v[j] = gy[j] * sigm(v[j]);
                        *(u32x2*)((bf16_t*)(ws + WS_YS2) + (size_t)row * 512 + dc + c4) = pack4(v); });
                }
                if (l + 1 < NL && bx >= 128) { __syncthreads(); p0_weights(a, (float*)lds_raw, (l + 1) * P0_PER, (l + 1) * P0_PER + 340, bx - 128, 128); }
            } else if ((PM & 64) && s == 4) {
                pg8::Gemm g{(const bf16_t*)(ws + WS_YS2), (const bf16_t*)(ws + WS_WBB + l * SZ_WB), TP, 1024, 512}; pg8::StaticOrder S; S.init(TP, 1024, G, bx);
                EpiBr<true> E{ws}; if (PROBE == 11) { EpiNull EN{(float*)(ws + WS_E)}; pg8::gemm_phase<EpiNull, pg8::StaticOrder, false>(lds, g, S, EN, nullptr); } pg8::gemm_phase<EpiBr<true>, pg8::StaticOrder, false>(lds, g, S, E, nullptr); __syncthreads();
                {
                    const int dc = 16 * (bx & 63);
                    skinny_unit<false, 2>(lds, (const bf16_t*)(ws + WS_YS2) + (size_t)TP * 512, (const bf16_t*)(ws + WS_WBB + l * SZ_WB), 512, dc, dc, 32 * (bx >> 6), otid(), [=](const f32x4 s0, const f32x4 s1, int row, int c4) {
                        const size_t off = (size_t)row * 1024 + dc + c4; u32x2* p = (u32x2*)((bf16_t*)(ws + WS_SGS) + off); const f32x4 t = unpack4(*(const u32x2*)((const bf16_t*)(ws + WS_SGA) + off));
                        *p = pack4(t + unpack4(*p) * s0); });
                }
            } else if ((PM & 128) && (s == 5 || s == 7)) {
                const bool dn = s == 7;
                pg8::Gemm g{(const bf16_t*)(dn ? ws + WS_FF : ws + WS_SGS), (const bf16_t*)(dn ? ws + WS_WDN + l * SZ_WDN : ws + WS_WOUT + l * SZ_WOUT), TP, 1024, dn ? DFF : 1024}; pg8::StaticOrder S; S.init(TP, 1024, G, bx);
                EpiRes E{a.out, ws, RS + (size_t)(2 * l + (dn ? 2 : 1)) * MP};
                if (PROBE == 5) { EpiProbe<1> EN{ws, (float*)(ws + WS_E)}; pg8::gemm_phase<EpiProbe<1>, pg8::StaticOrder, false>(lds, g, S, EN, nullptr); }
                if (PROBE == 11) { EpiNull EN{(float*)(ws + WS_E)}; pg8::gemm_phase<EpiNull, pg8::StaticOrder, false>(lds, g, S, EN, nullptr); }
                pg8::gemm_phase<EpiRes, pg8::StaticOrder, false>(lds, g, S, E, nullptr); __syncthreads();
                {
                    const int dc = 16 * (bx & 63), Ks = dn ? DFF : 1024; rsum_t* rso = RS + (size_t)(2 * l + (dn ? 2 : 1)) * MP; float* X = a.out;
                    skinny_unit<false, 2>(lds, (const bf16_t*)(dn ? ws + WS_FF : ws + WS_SGS) + (size_t)TP * Ks, (const bf16_t*)(dn ? ws + WS_WDN + l * SZ_WDN : ws + WS_WOUT + l * SZ_WOUT), Ks, dc, dc, 32 * (bx >> 6), otid(), [=](const f32x4 s0, const f32x4 s1, int row, int c4) {
                        const size_t off = (size_t)row * 1024 + dc + c4; const f32x4 x = *(const f32x4*)(X + off) + s0; *(f32x4*)(X + off) = x; *(u32x2*)(XB + off) = pack4(x);
                        float ss = (x[0] * x[0] + x[1] * x[1]) + (x[2] * x[2] + x[3] * x[3]); ss += __shfl_xor(ss, 16); ss += __shfl_xor(ss, 32);
                        if (c4 == 0) atomicAdd(rso + row, rs_enc(ss)); });
                }
            } else if (PM & 256) {
                pg8::Gemm g{XB, (const bf16_t*)(ws + WS_WGU + l * SZ_WGU), TP, 2 * DFF, 1024}; pg8::StaticOrder S; S.init(TP, 2 * DFF, G, bx);
                EpiGU E{ws, RS + (size_t)(2 * l + 1) * MP, lds + LDS_X};
                if (PROBE == 11) { EpiNull EN{(float*)(ws + WS_E)}; pg8::gemm_phase<EpiNull, pg8::StaticOrder, false>(lds, g, S, EN, nullptr); }
                if (PROBE == 20) { EpiProbe<0> EP{ws, (float*)(ws + WS_E)}; pg8::gemm_phase<EpiProbe<0>, pg8::StaticOrder, false>(lds, g, S, EP, nullptr); }
                if (PROBE == 21) { EpiProbe<1> EP{ws, (float*)(ws + WS_E)}; pg8::gemm_phase<EpiProbe<1>, pg8::StaticOrder, false>(lds, g, S, EP, nullptr); }
                if (PROBE == 22 || PROBE == 24 || PROBE == 26) { pg8::gemm_phase<EpiGU, pg8::StaticOrder, false>(lds, g, S, E, nullptr); __syncthreads(); if (PROBE == 26) __syncthreads(); }
                pg8::gemm_phase<EpiGU, pg8::StaticOrder, false>(lds, g, S, E, nullptr); __syncthreads();
                if (bx >= 80) {
                    const int dc = 16 * (255 - bx), n0 = (dc >> 7) * 256 + (dc & 127); const rsum_t* rowss = RS + (size_t)(2 * l + 1) * MP;
                    skinny_unit<true, 8>(lds, XB + (size_t)TP * 1024, (const bf16_t*)(ws + WS_WGU + l * SZ_WGU), 1024, n0, n0 + 128, 0, otid(), [=](const f32x4 s0, const f32x4 s1, int row, int c4) {
                        const float rs = rsqrtf(rs_ms(rowss[row])); const f32x4 g = s0 * rs, up = s1 * rs; f32x4 v;
                        _Pragma("unroll") for (int j = 0; j < 4; ++j) v[j] = g[j] * sigm(g[j]) * up[j];
                        *(u32x2*)((bf16_t*)(ws + WS_FF) + (size_t)row * DFF + dc + c4) = pack4(v); });
                }
                if (l + 1 < NL && bx >= 128) { __syncthreads(); p0_weights(a, (float*)lds_raw, (l + 1) * P0_PER + 340, (l + 2) * P0_PER, bx - 128, 128); }
            }
        }
        }
        if (ph + 1 < a.ph_hi) { xcd_barrier(gbar); if (PROBE == 1) xcd_barrier(gbar); }
        if (ph == a.ph_lo) {
            if (threadIdx.x == 0) { bool ok = true; unsigned* bw = (unsigned*)(a.ws + WS_BAR);
                for (unsigned j = 0; j < 16; ++j) { const unsigned cnt = xb_ld(&bw[XB_XCNT(j)]); ok = ok && (j < 8 ? cnt == 32u : cnt == 0u); }
                bst[4] = ok ? (bst[2] * 8u + bst[3]) : (unsigned)blockIdx.x; }
            __syncthreads();
        }
    }
}

extern "C" void kernel_launch(void* const* d_in, const int* in_sizes, int n_in, void* d_out, int out_size, void* d_ws, size_t ws_size, hipStream_t stream) {
    static int grid = 0;
    if (grid == 0) {
        if (n_in != 25 || (size_t)out_size != O_END || ws_size < WS_TOTAL) { fprintf(stderr, "kernel_launch: unexpected shapes: n_in %d out %d ws %zu (need %zu)\n", n_in, out_size, ws_size, (size_t)WS_TOTAL); grid = -1; return; }
        int dev = 0, cus = 0, per_cu = 0;
        hipGetDevice(&dev); hipDeviceGetAttribute(&cus, hipDeviceAttributeMultiprocessorCount, dev);
        if (hipFuncSetAttribute((const void*)mk_fwd, hipFuncAttributeMaxDynamicSharedMemorySize, LDS_BYTES) != hipSuccess) { fprintf(stderr, "kernel_launch: hipFuncSetAttribute failed\n"); grid = -1; return; }
        if (hipOccupancyMaxActiveBlocksPerMultiprocessor(&per_cu, (const void*)mk_fwd, 512, LDS_BYTES) != hipSuccess || per_cu < 1) { fprintf(stderr, "kernel_launch: occupancy query says %d\n", per_cu); per_cu = 1; }
        (void)hipGetLastError();
        grid = 256;
        if (cus < 256) fprintf(stderr, "kernel_launch: %d CUs, need 256\n", cus);
    }
    if (grid < 0) return;
    if (hipMemsetAsync((char*)d_ws + WS_BAR, 0, (size_t)XCD_BAR_WORDS * 4, stream) != hipSuccess) { fprintf(stderr, "kernel_launch: memset of the barrier words failed\n"); return; }
    Args a{};
    for (int i = 0; i < 25; ++i) a.in[i] = (const float*)d_in[i];
    a.out = (float*)d_out; a.ws = (unsigned char*)d_ws;
#if ONE_LAUNCH
    a.ph_lo = 0; a.ph_hi = N_PHASES;
    void* args[] = {&a};
    hipError_t e = hipLaunchCooperativeKernel((const void*)mk_fwd, dim3(grid), dim3(512), args, LDS_BYTES, stream);
    if (e != hipSuccess) fprintf(stderr, "cooperative launch failed: %s (grid %d)\n", hipGetErrorString(e), grid);
#else
    for (int ph = 0; ph < N_PHASES; ++ph) { a.ph_lo = ph; a.ph_hi = ph + 1; hipLaunchKernelGGL(mk_fwd, dim3(grid), dim3(512), LDS_BYTES, stream, a); }
#endif
}
```
